# Optimizing an MI355X kernel written in HIP

```python
import math
import jax
import jax.numpy as jnp
from jax import lax
import numpy as np

D_MODEL = 2048
BATCH = 4
SEQ = 4096
DEPTH = 2

HEAD_DIM = 128
N_HEADS = D_MODEL // HEAD_DIM
N_HEADS_SB = N_HEADS // 2
N_HEADS_MOBA = N_HEADS - N_HEADS_SB
ATTN_WIDTH = N_HEADS * HEAD_DIM
ROPE_DIM = HEAD_DIM // 4
ROPE_THETA = 500000.0
SB_Q_BLOCK = 128
MOBA_BLOCK = 256
MOBA_TOPK = 3
MOBA_Q_CHUNK = 64
LRU_WIDTH = D_MODEL
LRU_BLOCKS = 8
LRU_BLOCK_DIM = LRU_WIDTH // LRU_BLOCKS
LRU_C = 8.0
CONV_WIDTH = 4
D_FF = 7 * D_MODEL // 2
N_EXPERTS = 8
TOP_K = 2
D_EXPERT = 7 * D_MODEL // 2
NORM_EPS = 1e-6
NEG_INF = -1e30
N_EVEN = (DEPTH + 1) // 2
N_ODD = DEPTH // 2

kernel_name = "hybrid_sb_moba_rglru_moe"


def rms_norm(x, g):
    x32 = x.astype(jnp.float32)
    y = x32 * lax.rsqrt(jnp.mean(x32 * x32, axis=-1, keepdims=True) + NORM_EPS)
    return (y * g.astype(jnp.float32)).astype(x.dtype)


def split_heads(t, n_heads):
    b, s, _ = t.shape
    return t.reshape(b, s, n_heads, HEAD_DIM).transpose(0, 2, 1, 3)


def rope_tables(seq_len, dtype):
    inv_freq = ROPE_THETA ** (-jnp.arange(0, ROPE_DIM, 2, dtype=jnp.float32) / ROPE_DIM)
    ang = jnp.arange(seq_len, dtype=jnp.float32)[:, None] * inv_freq[None, :]
    return jnp.cos(ang).astype(dtype), jnp.sin(ang).astype(dtype)


def apply_partial_rope(t, cos, sin):
    half = ROPE_DIM // 2
    t1 = t[..., :half]
    t2 = t[..., half:ROPE_DIM]
    return jnp.concatenate([t1 * cos - t2 * sin, t2 * cos + t1 * sin, t[..., ROPE_DIM:]], axis=-1)


def stick_breaking_attention(q, k, v):
    b, h, s, dh = q.shape
    scale = dh ** -0.5
    kpos = jnp.arange(s)

    def block(i):
        start = i * SB_Q_BLOCK
        qb = lax.dynamic_slice_in_dim(q, start, SB_Q_BLOCK, axis=2)
        qpos = start + jnp.arange(SB_Q_BLOCK)
        past = kpos[None, :] < qpos[:, None]
        z = jnp.einsum('bhqd,bhkd->bhqk', qb, k, preferred_element_type=jnp.float32) * scale
        log_beta = jax.nn.log_sigmoid(z)
        log_keep = jnp.where(past, log_beta - z, 0.0)
        later = lax.cumsum(log_keep, axis=3, reverse=True) - log_keep
        w = jnp.where(past, jnp.exp(log_beta + later), 0.0)
        return jnp.einsum('bhqk,bhkd->bhqd', w.astype(v.dtype), v)

    out = lax.map(block, jnp.arange(s // SB_Q_BLOCK))
    return out.transpose(1, 2, 0, 3, 4).reshape(b, h, s, dh)


def moba_attention(q, k, v):
    b, h, s, dh = q.shape
    scale = dh ** -0.5
    pad = (-s) % MOBA_BLOCK
    if pad:
        k = jnp.pad(k, ((0, 0), (0, 0), (0, pad), (0, 0)))
        v = jnp.pad(v, ((0, 0), (0, 0), (0, pad), (0, 0)))
    n_blocks = (s + pad) // MOBA_BLOCK
    k_sel = min(MOBA_TOPK, n_blocks - 1)
    kb = k.reshape(b, h, n_blocks, MOBA_BLOCK, dh)
    vb = v.reshape(b, h, n_blocks, MOBA_BLOCK, dh)
    k_mean = jnp.mean(kb.astype(jnp.float32), axis=3)
    b_ix = jnp.arange(b)[:, None, None, None]
    h_ix = jnp.arange(h)[None, :, None, None]
    blk_ids = jnp.arange(n_blocks)

    def chunk(c):
        start = c * MOBA_Q_CHUNK
        qc = lax.dynamic_slice_in_dim(q, start, MOBA_Q_CHUNK, axis=2)
        qpos = start + jnp.arange(MOBA_Q_CHUNK)
        own = start // MOBA_BLOCK
        k_own = lax.dynamic_index_in_dim(kb, own, axis=2, keepdims=False)
        v_own = lax.dynamic_index_in_dim(vb, own, axis=2, keepdims=False)
        kpos_own = own * MOBA_BLOCK + jnp.arange(MOBA_BLOCK)
        s_own = jnp.einsum('bhqd,bhkd->bhqk', qc, k_own, preferred_element_type=jnp.float32) * scale
        s_own = jnp.where(kpos_own[None, :] <= qpos[:, None], s_own, NEG_INF)
        if k_sel == 0:
            p_own = jax.nn.softmax(s_own, axis=-1).astype(v.dtype)
            return jnp.einsum('bhqk,bhkd->bhqd', p_own, v_own)
        gate = jnp.einsum('bhqd,bhnd->bhqn', qc.astype(jnp.float32), k_mean)
        gate = jnp.where(blk_ids < own, gate, NEG_INF)
        _, sel = lax.top_k(gate, k_sel)
        valid = jnp.arange(k_sel) < own
        k_g = kb[b_ix, h_ix, sel]
        v_g = vb[b_ix, h_ix, sel]
        s_g = jnp.einsum('bhqd,bhqnkd->bhqnk', qc, k_g, preferred_element_type=jnp.float32) * scale
        s_g = jnp.where(valid[:, None], s_g, NEG_INF).reshape(b, h, MOBA_Q_CHUNK, k_sel * MOBA_BLOCK)
        p = jax.nn.softmax(jnp.concatenate([s_g, s_own], axis=-1), axis=-1).astype(v.dtype)
        p_g = p[..., :k_sel * MOBA_BLOCK].reshape(b, h, MOBA_Q_CHUNK, k_sel, MOBA_BLOCK)
        p_own = p[..., k_sel * MOBA_BLOCK:]
        return (jnp.einsum('bhqnk,bhqnkd->bhqd', p_g, v_g)
                + jnp.einsum('bhqk,bhkd->bhqd', p_own, v_own))

    out = lax.map(chunk, jnp.arange(s // MOBA_Q_CHUNK))
    return out.transpose(1, 2, 0, 3, 4).reshape(b, h, s, dh)


def attention_mixer(x, norm_g, w_in, qn_sb, kn_sb, qn_mb, kn_mb, w_o):
    b, s, _ = x.shape
    hdn = rms_norm(x, norm_g)
    proj = hdn @ w_in
    wa = N_HEADS_SB * HEAD_DIM
    wb = N_HEADS_MOBA * HEAD_DIM
    q_sb, k_sb, v_sb, q_mb, k_mb, v_mb = jnp.split(
        proj, [wa, 2 * wa, 3 * wa, 3 * wa + wb, 3 * wa + 2 * wb], axis=-1)
    q_sb = rms_norm(split_heads(q_sb, N_HEADS_SB), qn_sb)
    k_sb = rms_norm(split_heads(k_sb, N_HEADS_SB), kn_sb)
    v_sb = split_heads(v_sb, N_HEADS_SB)
    cos, sin = rope_tables(s, x.dtype)
    q_mb = apply_partial_rope(rms_norm(split_heads(q_mb, N_HEADS_MOBA), qn_mb), cos, sin)
    k_mb = apply_partial_rope(rms_norm(split_heads(k_mb, N_HEADS_MOBA), kn_mb), cos, sin)
    v_mb = split_heads(v_mb, N_HEADS_MOBA)
    o_sb = stick_breaking_attention(q_sb, k_sb, v_sb)
    o_mb = moba_attention(q_mb, k_mb, v_mb)
    o = jnp.concatenate([o_sb, o_mb], axis=1).transpose(0, 2, 1, 3).reshape(b, s, ATTN_WIDTH)
    return o @ w_o


def rg_lru(x, w_a, b_a, w_i, b_i, lam):
    b, s, _ = x.shape
    xblk = x.reshape(b, s, LRU_BLOCKS, LRU_BLOCK_DIM)
    r = jax.nn.sigmoid(jnp.einsum('bsnd,nde->bsne', xblk, w_a).reshape(b, s, LRU_WIDTH) + b_a)
    i = jax.nn.sigmoid(jnp.einsum('bsnd,nde->bsne', xblk, w_i).reshape(b, s, LRU_WIDTH) + b_i)
    log_a = (-LRU_C * r.astype(jnp.float32)) * jax.nn.softplus(-lam.astype(jnp.float32))
    a = jnp.exp(log_a)
    u = jnp.sqrt(-jnp.expm1(2.0 * log_a)) * (i * x).astype(jnp.float32)

    def combine(left, right):
        a1, b1 = left
        a2, b2 = right
        return a1 * a2, a2 * b1 + b2

    _, hs = lax.associative_scan(combine, (a, u), axis=1)
    return hs.astype(x.dtype)


def recurrent_mixer(x, norm_g, w_in, conv_w, conv_b, w_a, b_a, w_i, b_i, lam, w_o):
    s = x.shape[1]
    hdn = rms_norm(x, norm_g)
    xb, gate = jnp.split(hdn @ w_in, 2, axis=-1)
    xp = jnp.pad(xb, ((0, 0), (CONV_WIDTH - 1, 0), (0, 0)))
    xc = conv_b + xp[:, 0:s] * conv_w[0]
    for tap in range(1, CONV_WIDTH):
        xc = xc + xp[:, tap:tap + s] * conv_w[tap]
    y = rg_lru(xc, w_a, b_a, w_i, b_i, lam)
    return (y * jax.nn.gelu(gate)) @ w_o


def swiglu(h, w_gate, w_up, w_down):
    return (jax.nn.silu(h @ w_gate) * (h @ w_up)) @ w_down


def moe_swiglu(h, router, we_gate, we_up, we_down):
    b, s, d = h.shape
    t = h.reshape(b * s, d)
    logits = jnp.matmul(t, router, preferred_element_type=jnp.float32)
    top_val, top_idx = lax.top_k(logits, TOP_K)
    top_w = jax.nn.softmax(top_val, axis=-1)
    gates = jnp.sum(jax.nn.one_hot(top_idx, N_EXPERTS, dtype=jnp.float32) * top_w[..., None], axis=1)
    out = jnp.zeros_like(t)
    for e in range(N_EXPERTS):
        out = out + gates[:, e:e + 1].astype(t.dtype) * swiglu(t, we_gate[e], we_up[e], we_down[e])
    return out.reshape(b, s, d)


def setup_inputs(seed: int = 0) -> dict:
    key = jax.random.key(seed)
    ks = jax.random.split(key, 32)
    f32 = jnp.float32

    def nrm(k, shape, scale):
        return jax.random.normal(k, shape, f32) * scale

    def gain(k, shape):
        return 1.0 + 0.01 * jax.random.normal(k, shape, f32)

    u = jax.random.uniform(ks[20], (N_ODD, LRU_WIDTH), f32, minval=0.9, maxval=0.999)
    a0 = u ** (1.0 / LRU_C)
    od_lambda = jnp.log(a0) - jnp.log1p(-a0)
    return {
        "x": nrm(ks[0], (BATCH, SEQ, D_MODEL), 1.0),
        "ev_attn_norm": gain(ks[1], (N_EVEN, D_MODEL)),
        "ev_w_in": nrm(ks[2], (N_EVEN, D_MODEL, 3 * ATTN_WIDTH), D_MODEL ** -0.5),
        "ev_q_norm_sb": gain(ks[3], (N_EVEN, HEAD_DIM)),
        "ev_k_norm_sb": gain(ks[4], (N_EVEN, HEAD_DIM)),
        "ev_q_norm_moba": gain(ks[5], (N_EVEN, HEAD_DIM)),
        "ev_k_norm_moba": gain(ks[6], (N_EVEN, HEAD_DIM)),
        "ev_w_o": nrm(ks[7], (N_EVEN, ATTN_WIDTH, D_MODEL), ATTN_WIDTH ** -0.5),
        "ev_ffn_norm": gain(ks[8], (N_EVEN, D_MODEL)),
        "ev_w_gate": nrm(ks[9], (N_EVEN, D_MODEL, D_FF), D_MODEL ** -0.5),
        "ev_w_up": nrm(ks[10], (N_EVEN, D_MODEL, D_FF), D_MODEL ** -0.5),
        "ev_w_down": nrm(ks[11], (N_EVEN, D_FF, D_MODEL), D_FF ** -0.5),
        "od_rec_norm": gain(ks[12], (N_ODD, D_MODEL)),
        "od_w_in": nrm(ks[13], (N_ODD, D_MODEL, 2 * LRU_WIDTH), D_MODEL ** -0.5),
        "od_conv_w": nrm(ks[14], (N_ODD, CONV_WIDTH, LRU_WIDTH), CONV_WIDTH ** -0.5),
        "od_conv_b": nrm(ks[15], (N_ODD, LRU_WIDTH), 0.01),
        "od_w_a": nrm(ks[16], (N_ODD, LRU_BLOCKS, LRU_BLOCK_DIM, LRU_BLOCK_DIM), LRU_BLOCK_DIM ** -0.5),
        "od_b_a": nrm(ks[17], (N_ODD, LRU_WIDTH), 0.01),
        "od_w_i": nrm(ks[18], (N_ODD, LRU_BLOCKS, LRU_BLOCK_DIM, LRU_BLOCK_DIM), LRU_BLOCK_DIM ** -0.5),
        "od_b_i": nrm(ks[19], (N_ODD, LRU_WIDTH), 0.01),
        "od_lambda": od_lambda,
        "od_w_o": nrm(ks[21], (N_ODD, LRU_WIDTH, D_MODEL), LRU_WIDTH ** -0.5),
        "od_ffn_norm": gain(ks[22], (N_ODD, D_MODEL)),
        "od_router": nrm(ks[23], (N_ODD, D_MODEL, N_EXPERTS), D_MODEL ** -0.5),
        "od_we_gate": nrm(ks[24], (N_ODD, N_EXPERTS, D_MODEL, D_EXPERT), D_MODEL ** -0.5),
        "od_we_up": nrm(ks[25], (N_ODD, N_EXPERTS, D_MODEL, D_EXPERT), D_MODEL ** -0.5),
        "od_we_down": nrm(ks[26], (N_ODD, N_EXPERTS, D_EXPERT, D_MODEL), D_EXPERT ** -0.5),
    }


def reference(x, ev_attn_norm, ev_w_in, ev_q_norm_sb, ev_k_norm_sb, ev_q_norm_moba, ev_k_norm_moba,
              ev_w_o, ev_ffn_norm, ev_w_gate, ev_w_up, ev_w_down,
              od_rec_norm, od_w_in, od_conv_w, od_conv_b, od_w_a, od_b_a, od_w_i, od_b_i, od_lambda,
              od_w_o, od_ffn_norm, od_router, od_we_gate, od_we_up, od_we_down):
    for layer in range(DEPTH):
        j = layer // 2
        if layer % 2 == 0:
            x = x + attention_mixer(x, ev_attn_norm[j], ev_w_in[j], ev_q_norm_sb[j], ev_k_norm_sb[j],
                                    ev_q_norm_moba[j], ev_k_norm_moba[j], ev_w_o[j])
            x = x + swiglu(rms_norm(x, ev_ffn_norm[j]), ev_w_gate[j], ev_w_up[j], ev_w_down[j])
        else:
            x = x + recurrent_mixer(x, od_rec_norm[j], od_w_in[j], od_conv_w[j], od_conv_b[j],
                                    od_w_a[j], od_b_a[j], od_w_i[j], od_b_i[j], od_lambda[j], od_w_o[j])
            x = x + moe_swiglu(rms_norm(x, od_ffn_norm[j]), od_router[j],
                               od_we_gate[j], od_we_up[j], od_we_down[j])
    return x
```

```cpp
#include <hip/hip_runtime.h>
#include <cstdio>
#include <cstdint>

#define LAS __attribute__((address_space(3)))
#define GAS __attribute__((address_space(1)))
typedef unsigned short bf16;
typedef short bf16x8 __attribute__((ext_vector_type(8)));
typedef short s16x4 __attribute__((ext_vector_type(4)));
typedef float f32x2 __attribute__((ext_vector_type(2)));
typedef float f32x4 __attribute__((ext_vector_type(4)));
typedef float f32x16 __attribute__((ext_vector_type(16)));
typedef unsigned u32x2 __attribute__((ext_vector_type(2)));
typedef unsigned u32x4 __attribute__((ext_vector_type(4)));
typedef GAS unsigned gu32;

constexpr int NB = 4, SEQ = 4096, DM = 2048, T = NB * SEQ;
constexpr int HD = 128, NQKV = 6144, DFF = 7168, NEXP = 8, NSLOT_PAD = 2 * T + NEXP * 256;
constexpr float EPS = 1e-6f;
constexpr int NWAVES = 8, NTHR = 512;

__device__ __forceinline__ unsigned f2bf(float f) { unsigned u = __builtin_bit_cast(unsigned, f); return (u + 0x7fffu + ((u >> 16) & 1u)) >> 16; }
__device__ __forceinline__ unsigned pk2(float lo, float hi) { return f2bf(lo) | (f2bf(hi) << 16); }
__device__ __forceinline__ float bf2f(unsigned short h) { return __builtin_bit_cast(float, (unsigned)h << 16); }
__device__ __forceinline__ float bflo(unsigned w) { return __builtin_bit_cast(float, w << 16); }
__device__ __forceinline__ float bfhi(unsigned w) { return __builtin_bit_cast(float, w & 0xffff0000u); }
__device__ __forceinline__ unsigned cvt_pk_bf16(float lo, float hi) { unsigned r; asm volatile("v_cvt_pk_bf16_f32 %0, %1, %2" : "=v"(r) : "v"(lo), "v"(hi)); return r; }
__device__ __forceinline__ float wave_sum(float v) {
#pragma unroll
    for (int o = 1; o < 64; o <<= 1) v += __shfl_xor(v, o);
    return v;
}
__device__ __forceinline__ float fast_exp(float x) { return __builtin_amdgcn_exp2f(x * 1.4426950408889634f); }
__device__ __forceinline__ float fast_sigmoid(float x) { return __builtin_amdgcn_rcpf(1.0f + fast_exp(-x)); }

namespace pg8 {
constexpr int BM = 256, BK = 64, HALF = 128, HTB = HALF * BK * 2, STAGE_BYTES = 8 * HTB, NXCD = 8, WGM = 8;
__host__ __device__ __forceinline__ int lds_byte(int r, int c) { const int st = (r >> 4) * 2 + (c >> 5), rr = r & 15, cc = c & 31, ob = rr * 64 + cc * 2; return st * 1024 + (ob ^ (((ob >> 9) & 1) << 5)); }
__host__ __device__ __forceinline__ void stage_rc(int b, int& R, int& C) { const int st = b / 1024, sb = b % 1024, swz = sb ^ (((sb >> 9) & 1) << 5); R = (st >> 1) * 16 + swz / 64; C = (st & 1) * 32 + (swz % 64) / 2; }
__host__ __device__ __forceinline__ int perm_a64(int r) { return (r & ~63) + 4 * (r & 15) + ((r >> 4) & 3); }
template <class E, class = void> struct aperm_of { static constexpr bool v = false; };
template <class E> struct aperm_of<E, decltype((void)E::APERM)> { static constexpr bool v = E::APERM; };
__host__ __device__ __forceinline__ int perm32(int rho) { const int n = rho >> 4, i = rho & 15; return 8 * (i >> 2) + 4 * n + (i & 3); }

struct Unit { int pm, pn, e, ks, ti; };

struct StaticOrder {
    int nM, nN, nwg, G, c, i0 = 0, i1 = 1 << 30;
    __device__ __forceinline__ void init(int nM_, int nN_, int G_, int c_) { nM = nM_; nN = nN_; nwg = nM * nN; G = G_; c = c_; }
    __device__ __forceinline__ bool unit_at(long L, Unit& u) const {
        if (L >= nwg) return false;
        int wgid = (int)L; { const int q = nwg / NXCD, r = nwg % NXCD, xcd = wgid % NXCD, off = wgid / NXCD; wgid = (xcd < r ? xcd * (q + 1) : r * (q + 1) + (xcd - r) * q) + off; }
        const int nig = WGM * nN, gid = wgid / nig, fm = gid * WGM, gsz = (nM - fm) < WGM ? (nM - fm) : WGM;
        u.pm = fm + ((wgid % nig) % gsz); u.pn = (wgid % nig) / gsz; u.e = 0; u.ks = 0; u.ti = 0; return true;
    }
    __device__ __forceinline__ bool next(int i, Unit& u) const {
        i += i0; if (i >= i1) return false;
        return unit_at((long)i * G + c, u);
    }
};
struct MoeOrder {
    StaticOrder so; int pf[9]; int tail_first = -1, tail_n = 0;
    __device__ __forceinline__ bool next(int i, Unit& u) const {
        if (tail_first >= 0) { const long L2 = (long)i * so.G + so.c; if (L2 >= 4L * tail_n) return false; if (!so.unit_at(tail_first + (L2 >> 2), u)) return false; u.ks = (int)(L2 & 3); }
        else if (!so.next(i, u)) return false;
        int e = 0;
#pragma unroll
        for (int k = 1; k < 8; ++k) e += (u.pm >= pf[k]) ? 1 : 0;
        u.e = e; return true;
    }
};
struct MoeTailOrder {
    StaticOrder so; int pf[9]; int nj;
    __device__ __forceinline__ bool next(int i, Unit& u) const {
        if (i != 0) return false;
        const int x = so.c & 7, r = so.c >> 3; if (r >= 4 * nj) return false;
        if (!so.unit_at(8L * (128 + (r >> 2)) + x, u)) return false;
        u.ks = r & 3; u.ti = x * 8 + (r >> 2);
        int e = 0;
#pragma unroll
        for (int k = 1; k < 8; ++k) e += (u.pm >= pf[k]) ? 1 : 0;
        u.e = e; return true;
    }
};

struct ProbPlain {
    static constexpr bool FP8 = false;
    const char* A; const char* B; unsigned lda, ldb; int nt;
    __device__ __forceinline__ const char* a_base(const Unit& u) const { return A + (size_t)u.pm * BM * lda; }
    __device__ __forceinline__ const char* b_base(const Unit& u) const { return B + (size_t)u.pn * BM * ldb; }
};
struct ProbPlainF8 {
    static constexpr bool FP8 = true;
    const char* A; const char* B; unsigned lda, ldb; int nt;
    __device__ __forceinline__ const char* a_base(const Unit& u) const { return A + (size_t)u.pm * BM * lda; }
    __device__ __forceinline__ const char* b_base(const Unit& u) const { return B + (size_t)u.pn * BM * ldb; }
};
struct ProbGates {
    static constexpr bool FP8 = false;
    const char* A; const char* B; unsigned lda, ldb; int nt;
    __device__ __forceinline__ const char* a_base(const Unit& u) const { return A + (size_t)u.pm * BM * lda + (size_t)(u.pn >> 1) * 512; }
    __device__ __forceinline__ const char* b_base(const Unit& u) const { return B + (size_t)u.pn * BM * ldb; }
};
struct ProbMoeUp {
    static constexpr bool FP8 = true;
    const char* A; const char* B; unsigned lda, ldb; int nt;
    __device__ __forceinline__ const char* a_base(const Unit& u) const { return A + (size_t)u.pm * BM * lda; }
    __device__ __forceinline__ const char* b_base(const Unit& u) const { return B + ((size_t)u.e * (2 * DFF) + (size_t)u.pn * BM) * ldb; }
};
struct ProbMoeDown {
    static constexpr bool FP8 = true;
    const char* A; const char* B; unsigned lda, ldb; int nt;
    __device__ __forceinline__ const char* a_base(const Unit& u) const { return A + (size_t)u.pm * BM * lda + (size_t)u.ks * nt * 128; }
    __device__ __forceinline__ const char* b_base(const Unit& u) const { return B + ((size_t)u.e * DM + (size_t)u.pn * BM) * ldb + (size_t)u.ks * nt * 128; }
};
typedef int v8i32 __attribute__((ext_vector_type(8)));
typedef short s16x16 __attribute__((ext_vector_type(16)));
__device__ __forceinline__ v8i32 cat8(bf16x8 lo, bf16x8 hi) { const s16x16 v = __builtin_shufflevector(lo, hi, 0, 1, 2, 3, 4, 5, 6, 7, 8, 9, 10, 11, 12, 13, 14, 15); return __builtin_bit_cast(v8i32, v); }

template <class Epi, class Sched, class Prob>
__device__ __forceinline__ void gemm_phase(LAS unsigned char* lds, LAS unsigned char* lds_epi, const Prob g, const Sched& S, const Epi& E, int wid) {
    const int lane = (int)__builtin_amdgcn_mbcnt_hi(~0u, __builtin_amdgcn_mbcnt_lo(~0u, 0u)), tid = wid * 64 + lane, wr = wid >> 2, wc = wid & 3, fr = lane & 15, fq = lane >> 4;
    const int nt = g.nt;
    int R0, C0, R1, C1; stage_rc(tid * 16, R0, C0); stage_rc(tid * 16 + 8192, R1, C1);
    const unsigned lda2 = g.lda, ldb2 = g.ldb;
    const int Rb0 = Epi::PERM ? ((R0 & ~31) + perm32(R0 & 31)) : R0, Rb1 = Epi::PERM ? ((R1 & ~31) + perm32(R1 & 31)) : R1;
    const unsigned vB0 = (unsigned)Rb0 * ldb2 + (unsigned)C0 * 2u, vB1 = (unsigned)Rb1 * ldb2 + (unsigned)C1 * 2u;
    const unsigned hstepB = (unsigned)HALF * ldb2;
    const size_t kstep = (size_t)(BK * 2);
    const unsigned ldsw = (unsigned)wid * 1024u;
    const int aoff = lds_byte(wr * 64 + fr, fq * 8), boff = lds_byte(wc * 32 + fr, fq * 8);
#define PG8_SA(b, h) (((b) * 2 + (h)) * HTB)
#define PG8_SB(b, h) ((4 + (b) * 2 + (h)) * HTB)
#define PG8_STAGE(bufoff, gbase, o0, o1) do { \
        __builtin_amdgcn_global_load_lds((const unsigned*)((const char*)(gbase) + (o0)), (LAS unsigned*)(lds + (bufoff) + ldsw), 16, 0, 0); \
        __builtin_amdgcn_global_load_lds((const unsigned*)((const char*)(gbase) + (o1)), (LAS unsigned*)(lds + (bufoff) + ldsw + 8192), 16, 0, 0); } while (0)
#define PG8_LDA(dst, b, h) do { _Pragma("unroll") for (int m = 0; m < 4; ++m) _Pragma("unroll") for (int k = 0; k < 2; ++k) dst[m][k] = *(const LAS bf16x8*)(lds + PG8_SA(b, h) + aoff + m * 2048 + k * 1024); } while (0)
#define PG8_LDB(dst, b, h) do { _Pragma("unroll") for (int n = 0; n < 2; ++n) _Pragma("unroll") for (int k = 0; k < 2; ++k) dst[n][k] = *(const LAS bf16x8*)(lds + PG8_SB(b, h) + boff + n * 2048 + k * 1024); } while (0)
#define PG8_MMA(ai, bj, At, Bt) do { __builtin_amdgcn_s_setprio(1); \
        if constexpr (Prob::FP8) { _Pragma("unroll") for (int m = 0; m < 4; ++m) _Pragma("unroll") for (int n = 0; n < 2; ++n) \
            asm volatile("v_mfma_f32_16x16x128_f8f6f4 %0, %1, %2, %0" : "+v"(acc[ai][bj][m][n]) : "v"(cat8(Bt[n][0], Bt[n][1])), "v"(cat8(At[m][0], At[m][1]))); } \
        else { _Pragma("unroll") for (int m = 0; m < 4; ++m) _Pragma("unroll") for (int n = 0; n < 2; ++n) _Pragma("unroll") for (int k = 0; k < 2; ++k) \
            acc[ai][bj][m][n] = __builtin_amdgcn_mfma_f32_16x16x32_bf16(Bt[n][k], At[m][k], acc[ai][bj][m][n], 0, 0, 0); } \
        __builtin_amdgcn_s_setprio(0); } while (0)
#define PG8_WAIT_V(n) asm volatile("s_waitcnt vmcnt(" #n ")" ::: "memory")
#define PG8_WAIT_L(n) asm volatile("s_waitcnt lgkmcnt(" #n ")" ::: "memory")
#define PG8_BAR __builtin_amdgcn_s_barrier()
#define PG8_SCHED __builtin_amdgcn_sched_barrier(0)
    Unit cur, nxt; int ui = 0; int epi_pm = -1;
    if (!S.next(0, cur)) return;
    const int Ra0 = aperm_of<Epi>::v ? perm_a64(R0) : R0, Ra1 = aperm_of<Epi>::v ? perm_a64(R1) : R1;
    const unsigned cA00 = (unsigned)Ra0 * lda2 + (unsigned)C0 * 2u, cA01 = (unsigned)Ra1 * lda2 + (unsigned)C1 * 2u, cA10 = cA00 + (unsigned)HALF * lda2, cA11 = cA01 + (unsigned)HALF * lda2;
    f32x4 acc[2][2][4][2];
#define PG8_ACC_INIT(unit) do { if constexpr (Epi::ACC_INIT) { E.init(acc, unit, wr, wc, fr, fq); } else { \
        _Pragma("unroll") for (int a = 0; a < 2; ++a) _Pragma("unroll") for (int b = 0; b < 2; ++b) _Pragma("unroll") for (int m = 0; m < 4; ++m) _Pragma("unroll") for (int n = 0; n < 2; ++n) acc[a][b][m][n] = (f32x4){0.f, 0.f, 0.f, 0.f}; } } while (0)
    PG8_ACC_INIT(cur);
    bf16x8 At[4][2], B0[2][2], B1[2][2];
    const char* cA = g.a_base(cur); const char* cB = g.b_base(cur);
    PG8_STAGE(PG8_SB(0, 0), cB, vB0, vB1); PG8_STAGE(PG8_SB(0, 1), cB + hstepB, vB0, vB1); PG8_STAGE(PG8_SA(0, 0), cA, cA00, cA01); PG8_STAGE(PG8_SA(0, 1), cA, cA10, cA11);
    if (wr == 1) PG8_BAR;
    PG8_WAIT_V(2); PG8_BAR;
    PG8_STAGE(PG8_SB(1, 0), cB + kstep, vB0, vB1); PG8_STAGE(PG8_SA(1, 0), cA + kstep, cA00, cA01); PG8_STAGE(PG8_SB(1, 1), cB + hstepB + kstep, vB0, vB1);
    PG8_WAIT_V(6); PG8_BAR;
    for (;;) {
        const bool has_next = S.next(ui + 1, nxt);
        const char* nA = has_next ? g.a_base(nxt) : cA; const char* nB = has_next ? g.b_base(nxt) : cB;
_Pragma("clang loop unroll(disable)")
        for (int t = 0; t < nt; t += 2) {
            const bool last = (t == nt - 2);
            const char* a1 = cA + (size_t)(t + 1) * kstep;
            const char* a2 = last ? nA : cA + (size_t)(t + 2) * kstep; const char* b2 = last ? nB : cB + (size_t)(t + 2) * kstep;
            const char* a3 = a2 + kstep; const char* b3 = b2 + kstep;
            PG8_LDB(B0, 0, 0); PG8_LDB(B1, 0, 1); PG8_SCHED; PG8_LDA(At, 0, 0); PG8_STAGE(PG8_SA(1, 1), a1, cA10, cA11);
            PG8_WAIT_V(8); PG8_WAIT_L(0); PG8_BAR; PG8_MMA(0, 0, At, B0); PG8_MMA(0, 1, At, B1); PG8_BAR; PG8_SCHED;
            PG8_LDA(At, 0, 1); PG8_STAGE(PG8_SB(0, 0), b2, vB0, vB1); PG8_STAGE(PG8_SB(0, 1), b2 + hstepB, vB0, vB1); PG8_STAGE(PG8_SA(0, 0), a2, cA00, cA01);
            PG8_WAIT_V(8); PG8_WAIT_L(0); PG8_BAR; PG8_MMA(1, 0, At, B0); PG8_MMA(1, 1, At, B1); PG8_BAR; PG8_SCHED;
            PG8_LDB(B0, 1, 0); PG8_LDB(B1, 1, 1); PG8_SCHED; PG8_LDA(At, 1, 0); PG8_STAGE(PG8_SA(0, 1), a2, cA10, cA11);
            PG8_WAIT_V(8); PG8_WAIT_L(0); PG8_BAR; PG8_MMA(0, 0, At, B0); PG8_MMA(0, 1, At, B1); PG8_BAR; PG8_SCHED;
            PG8_LDA(At, 1, 1); PG8_STAGE(PG8_SB(1, 0), b3, vB0, vB1); PG8_STAGE(PG8_SB(1, 1), b3 + hstepB, vB0, vB1); PG8_STAGE(PG8_SA(1, 0), a3, cA00, cA01);
            PG8_WAIT_V(8); PG8_WAIT_L(0); PG8_BAR; PG8_MMA(1, 0, At, B0); PG8_MMA(1, 1, At, B1); PG8_BAR; PG8_SCHED;
        }
        if constexpr (Prob::FP8) asm volatile("s_nop 7\n\ts_nop 7\n\ts_nop 7" ::: "memory");
        if (wr == 0) PG8_BAR;
        E(acc, cur, wr, wc, fr, fq, lds_epi, wid, lane, epi_pm);
        if (!has_next) break;
        PG8_ACC_INIT(nxt);
        cur = nxt; cA = nA; cB = nB; ++ui;
        if (wr == 1) PG8_BAR;
    }
    PG8_WAIT_V(0);
    PG8_BAR;
#undef PG8_ACC_INIT
#undef PG8_SA
#undef PG8_SB
#undef PG8_STAGE
#undef PG8_LDA
#undef PG8_LDB
#undef PG8_MMA
#undef PG8_WAIT_V
#undef PG8_WAIT_L
#undef PG8_BAR
#undef PG8_SCHED
}
}
namespace att {
constexpr int PITCH = NQKV;
constexpr int SHM_V = 64 * 128 * 2, SHM_K = 64 * 128 * 2;
constexpr int LDS_Q = 2 * SHM_V + 2 * SHM_K, LDS_BYTES = LDS_Q + NWAVES * 8192;
constexpr int EPI_WS = 0, EPI_FLAG = NWAVES * 64 * 4;
constexpr float SCALE = 0.08838834764831845f;
constexpr float C2 = 1.4426950408889634f * SCALE;
#define KSWZ(row, colB) ((row) * 256 + ((colB) ^ (((row) & 7) << 4)))
#define SBAR() __builtin_amdgcn_sched_barrier(0)
__device__ __forceinline__ int v_st(int k, int c) { const int kk = (k & ~0xC) | ((k & 4) << 1) | ((k & 8) >> 1); return ((kk >> 3) * 4 + (c >> 5)) * 512 + ((kk & 7) * 32 + (c & 31)) * 2; }
__device__ __forceinline__ int v_rd_base(int lane) { return ((lane & 3) << 3) | (((lane >> 2) & 3) << 6) | (((lane >> 4) & 1) << 5) | (((lane >> 5) & 1) << 8); }
constexpr int v_rd_off(int d0, int ks, int half) { return d0 * 512 + ks * 4096 + half * 2048; }
__device__ __forceinline__ int crow(int r, int hi) { return (r & 3) + 8 * (r >> 2) + 4 * hi; }

template <int KB>
__device__ __forceinline__ void qkt(f32x16& p0, f32x16& p1, LAS const unsigned char* K_lds, LAS const unsigned char* q_lds, int r32, int hi) {
    p0 = f32x16{}; p1 = f32x16{};
    LAS const unsigned char* kb[4];
#pragma unroll
    for (int dd = 0; dd < 4; ++dd) kb[dd] = K_lds + KB * SHM_K + KSWZ(r32, (dd * 16 + hi * 8) * 2);
#pragma unroll
    for (int d0 = 0; d0 < 8; ++d0) { LAS const unsigned char* a = kb[d0 & 3] + (d0 >> 2) * 128;
        const bf16x8 b0 = *(LAS const bf16x8*)(a);
        const bf16x8 b1 = *(LAS const bf16x8*)(a + 32 * 256);
        const bf16x8 qv = *(LAS const bf16x8*)(q_lds + d0 * 1024);
        p0 = __builtin_amdgcn_mfma_f32_32x32x16_bf16(b0, qv, p0, 0, 0, 0);
        p1 = __builtin_amdgcn_mfma_f32_32x32x16_bf16(b1, qv, p1, 0, 0, 0);
        if ((d0 & 3) == 3) SBAR(); }
}
template <int VB>
__device__ __forceinline__ void pv_tile(f32x16* o, int vb0, bf16x8 pa0, bf16x8 pa1, bf16x8 pa2, bf16x8 pa3) {
#define TRRD(dst, off) asm volatile("ds_read_b64_tr_b16 %0, %1 offset:%2" : "=&v"(dst) : "v"(vb0), "i"(off) : "memory")
#define PV_D0(d0) do { s16x4 l0, l1, l2, l3, h0, h1, h2, h3; constexpr int b_ = VB * SHM_V + v_rd_off(d0, 0, 0); \
        TRRD(l0, b_); TRRD(h0, b_ + 2048); TRRD(l1, b_ + 4096); TRRD(h1, b_ + 6144); TRRD(l2, b_ + 8192); TRRD(h2, b_ + 10240); TRRD(l3, b_ + 12288); TRRD(h3, b_ + 14336); \
        asm volatile("s_waitcnt lgkmcnt(0)" ::: "memory"); SBAR(); \
        o[d0] = __builtin_amdgcn_mfma_f32_32x32x16_bf16(pa0, (bf16x8){l0[0], l0[1], l0[2], l0[3], h0[0], h0[1], h0[2], h0[3]}, o[d0], 0, 0, 0);   \
        o[d0] = __builtin_amdgcn_mfma_f32_32x32x16_bf16(pa1, (bf16x8){l1[0], l1[1], l1[2], l1[3], h1[0], h1[1], h1[2], h1[3]}, o[d0], 0, 0, 0);   \
        o[d0] = __builtin_amdgcn_mfma_f32_32x32x16_bf16(pa2, (bf16x8){l2[0], l2[1], l2[2], l2[3], h2[0], h2[1], h2[2], h2[3]}, o[d0], 0, 0, 0);   \
        o[d0] = __builtin_amdgcn_mfma_f32_32x32x16_bf16(pa3, (bf16x8){l3[0], l3[1], l3[2], l3[3], h3[0], h3[1], h3[2], h3[3]}, o[d0], 0, 0, 0); } while (0)
    PV_D0(0); PV_D0(1); PV_D0(2); PV_D0(3);
#undef PV_D0
#undef TRRD
}
__device__ __forceinline__ void pack_p(const f32x16& p0, const f32x16& p1, bf16x8& pa0, bf16x8& pa1, bf16x8& pa2, bf16x8& pa3) {
#define PK4(P, B_, OUT) do { unsigned a0 = cvt_pk_bf16(P[B_+0], P[B_+1]), a1 = cvt_pk_bf16(P[B_+2], P[B_+3]);                          \
        unsigned b0 = cvt_pk_bf16(P[B_+4], P[B_+5]), b1 = cvt_pk_bf16(P[B_+6], P[B_+7]);                                             \
        auto r0 = __builtin_amdgcn_permlane32_swap(a0, b0, false, false); auto r1 = __builtin_amdgcn_permlane32_swap(a1, b1, false, false); \
        u32x4 w = {r0[0], r1[0], r0[1], r1[1]}; OUT = *reinterpret_cast<bf16x8*>(&w); } while (0)
    PK4(p0, 0, pa0); PK4(p0, 8, pa1); PK4(p1, 0, pa2); PK4(p1, 8, pa3);
#undef PK4
}
__device__ __forceinline__ float lane_pair_sum(float v) {
    auto rr = __builtin_amdgcn_permlane32_swap(__float_as_uint(v), __float_as_uint(v), false, false);
    return __uint_as_float(rr[0]) + __uint_as_float(rr[1]);
}
__device__ __forceinline__ float lane_pair_max(float v) {
    auto rr = __builtin_amdgcn_permlane32_swap(__float_as_uint(v), __float_as_uint(v), false, false);
    return fmaxf(__uint_as_float(rr[0]), __uint_as_float(rr[1]));
}

#ifndef SB_EXIT_L2
#define SB_EXIT_L2 48.0f
#endif

template <int MODE>
__device__ __forceinline__ void attn_unit(const bf16* __restrict__ qkv, bf16* __restrict__ O, const float* __restrict__ kmean, int b, int h, int qb, LAS unsigned char* ldsl, LAS unsigned char* lepi, int wid) {
    const int lane = (int)__builtin_amdgcn_mbcnt_hi(~0u, __builtin_amdgcn_mbcnt_lo(~0u, 0u)), tid = wid * 64 + lane, r32 = lane & 31, hi = lane >> 5;
    const size_t rowbase = (size_t)b * SEQ;
    const bf16* Qp = qkv + (MODE == 0 ? 0 : 3 * 1024) + h * HD;
    const bf16* Kp = Qp + 1024 + rowbase * PITCH; const bf16* Vp = Qp + 2048 + rowbase * PITCH;
    LAS const unsigned char* K_lds = ldsl + 2 * SHM_V;
    LAS float* ws = (LAS float*)(lepi + EPI_WS) + wid * 64; LAS float* li_l = ws; LAS float* al_l = ws + 32;
    volatile LAS int* flags = (volatile LAS int*)(lepi + EPI_FLAG);
    LAS unsigned char* q_lds = ldsl + LDS_Q + wid * 8192 + lane * 16;
    const int qlo = qb * 256 + wid * 32, qpos = qlo + r32;
#pragma unroll
    for (int d0 = 0; d0 < 8; ++d0) *(LAS bf16x8*)(q_lds + d0 * 1024) = *(const bf16x8*)(Qp + (rowbase + qpos) * PITCH + d0 * 16 + hi * 8);
    const int NT = 4 * (qb + 1);
    const int vb0 = (int)(unsigned)(uintptr_t)ldsl + v_rd_base(lane);
    unsigned koff0, koff1, voff0, voff1;
    { const int b0 = tid * 16, b1 = b0 + 8192;
      { const int row = b0 >> 8, cb = b0 & 255, colB = cb ^ ((row & 7) << 4); koff0 = (unsigned)(row * PITCH + (colB >> 1)) * 2u; }
      { const int row = b1 >> 8, cb = b1 & 255, colB = cb ^ ((row & 7) << 4); koff1 = (unsigned)(row * PITCH + (colB >> 1)) * 2u; }
      { const int st = b0 >> 9, wb = b0 & 511, kk = (st >> 2) * 8 + (wb >> 6), c = (st & 3) * 32 + ((wb & 63) >> 1), k = (kk & ~0xC) | ((kk & 4) << 1) | ((kk & 8) >> 1); voff0 = (unsigned)(k * PITCH + c) * 2u; }
      { const int st = b1 >> 9, wb = b1 & 511, kk = (st >> 2) * 8 + (wb >> 6), c = (st & 3) * 32 + ((wb & 63) >> 1), k = (kk & ~0xC) | ((kk & 4) << 1) | ((kk & 8) >> 1); voff1 = (unsigned)(k * PITCH + c) * 2u; } }
    const unsigned ldsw = (unsigned)wid * 1024u;
#define TILE_KB(t) (MODE == 0 ? 64 * (NT - 1 - (t)) : 64 * (t))
#define DMA_TILE(kb_, bf) do { const char* kg_ = (const char*)(Kp + (size_t)(kb_) * PITCH); const char* vg_ = (const char*)(Vp + (size_t)(kb_) * PITCH); \
        __builtin_amdgcn_global_load_lds((const unsigned*)(vg_ + voff0), (LAS unsigned*)(ldsl + (bf) * SHM_V + ldsw), 16, 0, 0); \
        __builtin_amdgcn_global_load_lds((const unsigned*)(vg_ + voff1), (LAS unsigned*)(ldsl + (bf) * SHM_V + ldsw + 8192), 16, 0, 0); \
        __builtin_amdgcn_global_load_lds((const unsigned*)(kg_ + koff0), (LAS unsigned*)(ldsl + 2 * SHM_V + (bf) * SHM_K + ldsw), 16, 0, 0); \
        __builtin_amdgcn_global_load_lds((const unsigned*)(kg_ + koff1), (LAS unsigned*)(ldsl + 2 * SHM_V + (bf) * SHM_K + ldsw + 8192), 16, 0, 0); } while (0)
    DMA_TILE(TILE_KB(0), 0);
    unsigned selmask = 0u;
    if constexpr (MODE == 1) {
        float gate[15]; float m1 = -__builtin_inff(), m2 = m1, m3 = m1;
#pragma unroll
        for (int j = 0; j < 15; ++j) {
            gate[j] = -__builtin_inff();
            if (j < qb) {
                const float* km = kmean + ((size_t)((b * 8 + h) * 16 + j)) * HD + hi * 8;
                float a = 0.f;
#pragma unroll
                for (int d0 = 0; d0 < 8; ++d0) {
                    const f32x4 k0 = *(const f32x4*)(km + d0 * 16), k1 = *(const f32x4*)(km + d0 * 16 + 4);
                    const u32x4 qw = *(LAS const u32x4*)(q_lds + d0 * 1024);
                    a += bflo(qw[0]) * k0[0] + bfhi(qw[0]) * k0[1] + bflo(qw[1]) * k0[2] + bfhi(qw[1]) * k0[3]
                       + bflo(qw[2]) * k1[0] + bfhi(qw[2]) * k1[1] + bflo(qw[3]) * k1[2] + bfhi(qw[3]) * k1[3];
                }
                const float g = lane_pair_sum(a);
                gate[j] = g;
                const float t1 = fminf(m1, g); m1 = fmaxf(m1, g); const float t2 = fminf(m2, t1); m2 = fmaxf(m2, t1); m3 = fmaxf(m3, t2);
            }
        }
#pragma unroll
        for (int j = 0; j < 15; ++j) if (j < qb && gate[j] >= m3) selmask |= (1u << j);
    }
    float m_reg = -1e30f, l_reg = 0.f, cacc = 0.f; f32x16 o[4] = {};
    asm volatile("s_waitcnt vmcnt(0)" ::: "memory");
    __syncthreads();
    bool stop = false;
#define STEP(t, BUF) do { \
        const int kb_ = TILE_KB(t); const bool more_ = ((t) + 1 < NT); \
        if (more_) DMA_TILE(TILE_KB((t) + 1), (BUF) ^ 1); \
        SBAR(); \
        if constexpr (MODE == 1) { \
            const int jb_ = kb_ >> 8; bool act_; bool own_ = (jb_ == qb); const bool sel_ = ((selmask >> jb_) & 1u) != 0u; \
            if (own_) act_ = (kb_ <= qlo + 31); else act_ = __any(sel_); \
            if (act_) { \
                f32x16 p0, p1; qkt<BUF>(p0, p1, K_lds, q_lds, r32, hi); SBAR(); \
                const float NEG = -__builtin_inff(); \
                if (own_) { if (kb_ + 63 > qlo) { const int dq = qpos - kb_ - 4 * hi; \
                        _Pragma("unroll") for (int r = 0; r < 16; ++r) { const int c = (r & 3) + 8 * (r >> 2); if (c > dq) p0[r] = NEG; if (c + 32 > dq) p1[r] = NEG; } } } \
                else if (!sel_) { _Pragma("unroll") for (int r = 0; r < 16; ++r) { p0[r] = NEG; p1[r] = NEG; } } \
                float pmax = p0[0]; _Pragma("unroll") for (int r = 1; r < 16; ++r) pmax = fmaxf(pmax, p0[r]); _Pragma("unroll") for (int r = 0; r < 16; ++r) pmax = fmaxf(pmax, p1[r]); \
                pmax = lane_pair_max(pmax); \
                float mn, alpha; \
                if (__all((pmax - m_reg) * SCALE <= 8.0f)) { mn = m_reg; alpha = 1.f; } \
                else { mn = fmaxf(m_reg, pmax); alpha = __builtin_amdgcn_exp2f((m_reg - mn) * C2); m_reg = mn; } \
                if (__any(alpha < 1.f)) { if (hi == 0) al_l[r32] = alpha; asm volatile("s_waitcnt lgkmcnt(0)" ::: "memory"); \
                    _Pragma("unroll") for (int d_ = 0; d_ < 4; ++d_) _Pragma("unroll") for (int r = 0; r < 16; ++r) o[d_][r] *= al_l[crow(r, hi)]; } \
                const float mnL = -mn * C2; float ps = 0.f; \
                _Pragma("unroll") for (int r = 0; r < 16; ++r) { p0[r] = __builtin_amdgcn_exp2f(fmaf(p0[r], C2, mnL)); p1[r] = __builtin_amdgcn_exp2f(fmaf(p1[r], C2, mnL)); ps += p0[r] + p1[r]; } \
                ps = lane_pair_sum(ps); l_reg = l_reg * alpha + ps; \
                bf16x8 pa0, pa1, pa2, pa3; pack_p(p0, p1, pa0, pa1, pa2, pa3); SBAR(); \
                pv_tile<BUF>(o, vb0, pa0, pa1, pa2, pa3); \
            } \
        } else { \
            const bool act_ = (kb_ < qlo + 31); \
            if (act_) { \
                f32x16 p0, p1; qkt<BUF>(p0, p1, K_lds, q_lds, r32, hi); SBAR(); \
                f32x16 k0, k1; \
                _Pragma("unroll") for (int r = 0; r < 16; ++r) { \
                    { const float z = p0[r] * C2, e = __builtin_amdgcn_exp2f(-fabsf(z)), sp = fmaxf(z, 0.f) + __builtin_amdgcn_logf(1.0f + e); k0[r] = -sp; p0[r] = z - sp; } \
                    { const float z = p1[r] * C2, e = __builtin_amdgcn_exp2f(-fabsf(z)), sp = fmaxf(z, 0.f) + __builtin_amdgcn_logf(1.0f + e); k1[r] = -sp; p1[r] = z - sp; } } \
                if (kb_ + 63 >= qlo) { const int dq = qpos - kb_ - 4 * hi; const float NEG = -__builtin_inff(); \
                    _Pragma("unroll") for (int r = 0; r < 16; ++r) { const int c = (r & 3) + 8 * (r >> 2); if (c >= dq) { p0[r] = NEG; k0[r] = 0.f; } if (c + 32 >= dq) { p1[r] = NEG; k1[r] = 0.f; } } } \
                SBAR(); float run = cacc; \
                _Pragma("unroll") for (int k = 7; k >= 0; --k) { const int g4 = 4 * (k & 3); \
                    const float s_ = (k < 4) ? ((k0[g4] + k0[g4 + 1]) + (k0[g4 + 2] + k0[g4 + 3])) : ((k1[g4] + k1[g4 + 1]) + (k1[g4 + 2] + k1[g4 + 3])); \
                    auto rr = __builtin_amdgcn_permlane32_swap(__float_as_uint(s_), __float_as_uint(s_), false, false); \
                    const float lo_ = __uint_as_float(rr[0]), hi_ = __uint_as_float(rr[1]); const float sg = run + (hi ? 0.f : hi_); \
                    if (k < 4) { const float e3 = sg, e2 = e3 + k0[g4 + 3], e1 = e2 + k0[g4 + 2], e0 = e1 + k0[g4 + 1]; \
                        p0[g4 + 3] = __builtin_amdgcn_exp2f(p0[g4 + 3] + e3); p0[g4 + 2] = __builtin_amdgcn_exp2f(p0[g4 + 2] + e2); p0[g4 + 1] = __builtin_amdgcn_exp2f(p0[g4 + 1] + e1); p0[g4] = __builtin_amdgcn_exp2f(p0[g4] + e0); } \
                    else { const float e3 = sg, e2 = e3 + k1[g4 + 3], e1 = e2 + k1[g4 + 2], e0 = e1 + k1[g4 + 1]; \
                        p1[g4 + 3] = __builtin_amdgcn_exp2f(p1[g4 + 3] + e3); p1[g4 + 2] = __builtin_amdgcn_exp2f(p1[g4 + 2] + e2); p1[g4 + 1] = __builtin_amdgcn_exp2f(p1[g4 + 1] + e1); p1[g4] = __builtin_amdgcn_exp2f(p1[g4] + e0); } \
                    run += lo_ + hi_; } \
                cacc = run; \
                bf16x8 pa0, pa1, pa2, pa3; pack_p(p0, p1, pa0, pa1, pa2, pa3); SBAR(); \
                pv_tile<BUF>(o, vb0, pa0, pa1, pa2, pa3); \
            } \
            if (SB_EXIT_L2 > 0.f) { const bool done_ = __all(cacc < -SB_EXIT_L2); if (lane == 0) flags[((t) & 1) * 8 + wid] = done_ ? 1 : 0; } \
        } \
        asm volatile("s_waitcnt vmcnt(0)" ::: "memory"); \
        __syncthreads(); \
        if (MODE == 0 && SB_EXIT_L2 > 0.f) { int all_ = 1; _Pragma("unroll") for (int w_ = 0; w_ < 8; ++w_) all_ &= flags[((t) & 1) * 8 + w_]; stop = (all_ != 0); } \
    } while (0)
    for (int t = 0; t < NT; t += 2) {
        STEP(t, 0);
        if (stop) break;
        STEP(t + 1, 1);
        if (stop) break;
    }
#undef STEP
#undef DMA_TILE
#undef TILE_KB
    float rli[16];
    if constexpr (MODE == 1) {
        if (hi == 0) li_l[r32] = l_reg; asm volatile("s_waitcnt lgkmcnt(0)" ::: "memory");
#pragma unroll
        for (int r = 0; r < 16; ++r) rli[r] = __builtin_amdgcn_rcpf(li_l[crow(r, hi)]);
    } else {
#pragma unroll
        for (int r = 0; r < 16; ++r) rli[r] = 1.0f;
    }
    int r32o = r32; asm volatile("" : "+v"(r32o));
    bf16* Ow = O + (rowbase + qlo) * DM + (MODE == 0 ? 0 : 1024) + h * HD + r32o;
#pragma unroll
    for (int r = 0; r < 16; ++r) { const int orow = crow(r, hi);
#pragma unroll
        for (int d0 = 0; d0 < 4; ++d0) { const float v = o[d0][r] * rli[r]; const float vn = __shfl_xor(v, 1);
            if ((r32 & 1) == 0) *(unsigned*)(Ow + (size_t)orow * DM + d0 * 32) = cvt_pk_bf16(v, vn); } }
    __syncthreads();
}
#undef KSWZ
}
namespace epi {
using pg8::Unit;
typedef f32x4 Acc[2][2][4][2];
#define NEXT_ROW(roff, m, LD) do { roff += (size_t)((m) == 3 ? 80 : 16) * (LD); asm volatile("" : "+v"(roff) :: "memory"); } while (0)
#define ST_NT(ptr, val) (*(ptr) = (val))
#define EPI_BAR() do { asm volatile("s_waitcnt lgkmcnt(0)" ::: "memory"); __builtin_amdgcn_s_barrier(); asm volatile("" ::: "memory"); } while (0)

template <int NPARTS>
__device__ __forceinline__ void row_rstd_to_lds(LAS float* S, const float* parts, int pm, int tid, int& cpm) {
    if (cpm == pm) return;
    cpm = pm;
    if (tid < 256) { float v[NPARTS];
#pragma unroll
        for (int p = 0; p < NPARTS; ++p) v[p] = parts[(size_t)p * T + pm * 256 + tid];
        float s = v[0];
#pragma unroll
        for (int p = 1; p < NPARTS; ++p) s += v[p];
        S[tid] = 1.0f / sqrtf(s * (1.0f / DM) + EPS); }
    EPI_BAR();
}

struct EpiQKV {
    static constexpr bool PERM = true, ACC_INIT = false;
    bf16* out; const float* ssq0; const float* gains; const float* rope; float* kmean;
    __device__ __forceinline__ void operator()(Acc& acc, const Unit& u, int wr, int wc, int fr, int fq, LAS unsigned char* le, int wid, int lane, int& cpm) const {
        LAS float* S = (LAS float*)le; LAS float* P = (LAS float*)(le + 1024);
        const int tid = wid * 64 + lane, row0 = u.pm * 256;
        row_rstd_to_lds<1>(S, ssq0, u.pm, tid, cpm);
        const int type = u.pn >> 2;
        const bool is_v = (type == 2 || type == 5);
        float rs[2][4];
#pragma unroll
        for (int ai = 0; ai < 2; ++ai)
#pragma unroll
            for (int m = 0; m < 4; ++m) rs[ai][m] = S[ai * 128 + wr * 64 + m * 16 + fr];
#pragma unroll
        for (int ai = 0; ai < 2; ++ai)
#pragma unroll
            for (int bj = 0; bj < 2; ++bj)
#pragma unroll
                for (int m = 0; m < 4; ++m)
#pragma unroll
                    for (int n = 0; n < 2; ++n) acc[ai][bj][m][n] = acc[ai][bj][m][n] * rs[ai][m];
        if (!is_v) {
#pragma unroll
            for (int ai = 0; ai < 2; ++ai)
#pragma unroll
                for (int m = 0; m < 4; ++m)
#pragma unroll
                    for (int bj = 0; bj < 2; ++bj) {
                        const f32x4 a = acc[ai][bj][m][0], b = acc[ai][bj][m][1];
                        float s = (a[0] * a[0] + a[1] * a[1]) + (a[2] * a[2] + a[3] * a[3]) + (b[0] * b[0] + b[1] * b[1]) + (b[2] * b[2] + b[3] * b[3]);
                        s += __shfl_xor(s, 16); s += __shfl_xor(s, 32);
                        if (fq == 0) P[((ai * 128 + wr * 64 + m * 16 + fr) * 2 + bj) * 4 + wc] = s;
                    }
            EPI_BAR();
            const float* gn = gains + ((type == 0) ? 0 : (type == 1) ? 128 : (type == 3) ? 256 : 384) + wc * 32 + fq * 8;
            const f32x4 g0 = *(const f32x4*)gn, g1 = *(const f32x4*)(gn + 4);
#pragma unroll
            for (int ai = 0; ai < 2; ++ai)
#pragma unroll
                for (int m = 0; m < 4; ++m)
#pragma unroll
                    for (int bj = 0; bj < 2; ++bj) {
                        const f32x4 pp = *(const LAS f32x4*)(P + ((ai * 128 + wr * 64 + m * 16 + fr) * 2 + bj) * 4);
                        const float rn = 1.0f / sqrtf(((pp[0] + pp[1]) + (pp[2] + pp[3])) * (1.0f / HD) + EPS);
                        acc[ai][bj][m][0] = acc[ai][bj][m][0] * rn * g0; acc[ai][bj][m][1] = acc[ai][bj][m][1] * rn * g1;
                    }
            if (type >= 3 && wc == 0) {
#pragma unroll
                for (int ai = 0; ai < 2; ++ai)
#pragma unroll
                    for (int m = 0; m < 4; ++m) {
                        const int pos = (row0 + ai * 128 + wr * 64 + m * 16 + fr) & (SEQ - 1);
                        const float* cp = rope + (size_t)pos * 16 + (fq & 1) * 8;
                        const f32x4 c0 = *(const f32x4*)cp, c1 = *(const f32x4*)(cp + 4), s0 = *(const f32x4*)(cp + SEQ * 16), s1 = *(const f32x4*)(cp + SEQ * 16 + 4);
#pragma unroll
                        for (int bj = 0; bj < 2; ++bj) {
                            f32x4 a = acc[ai][bj][m][0], b = acc[ai][bj][m][1], oa, ob;
#pragma unroll
                            for (int j = 0; j < 4; ++j) { oa[j] = __shfl_xor(a[j], 32); ob[j] = __shfl_xor(b[j], 32); }
                            if (fq < 2) { a = a * c0 - oa * s0; b = b * c1 - ob * s1; } else { a = a * c0 + oa * s0; b = b * c1 + ob * s1; }
                            acc[ai][bj][m][0] = a; acc[ai][bj][m][1] = b;
                        }
                    }
            }
        }
        if (type == 4) {
            float cs[2][2][4];
#pragma unroll
            for (int bj = 0; bj < 2; ++bj)
#pragma unroll
                for (int n = 0; n < 2; ++n)
#pragma unroll
                    for (int j = 0; j < 4; ++j) { float s = 0.f;
#pragma unroll
                        for (int ai = 0; ai < 2; ++ai)
#pragma unroll
                            for (int m = 0; m < 4; ++m) s += acc[ai][bj][m][n][j];
                        s += __shfl_xor(s, 1); s += __shfl_xor(s, 2); s += __shfl_xor(s, 4); s += __shfl_xor(s, 8);
                        cs[bj][n][j] = s; }
            LAS float* KM = P;
            EPI_BAR();
            if (wr == 1 && fr == 0) {
#pragma unroll
                for (int bj = 0; bj < 2; ++bj)
#pragma unroll
                    for (int n = 0; n < 2; ++n) *(LAS f32x4*)(KM + ((wc * 4 + fq) * 16 + bj * 8 + n * 4)) = (f32x4){cs[bj][n][0], cs[bj][n][1], cs[bj][n][2], cs[bj][n][3]}; }
            EPI_BAR();
            if (wr == 0 && fr == 0) { const int b = u.pm >> 4, blk = u.pm & 15;
#pragma unroll
                for (int bj = 0; bj < 2; ++bj) { const int h = 2 * (u.pn - 16) + bj; float* kp = kmean + ((size_t)((b * 8 + h) * 16 + blk)) * HD + wc * 32 + fq * 8;
#pragma unroll
                    for (int n = 0; n < 2; ++n) { const f32x4 o = *(const LAS f32x4*)(KM + ((wc * 4 + fq) * 16 + bj * 8 + n * 4));
                        *(f32x4*)(kp + n * 4) = (f32x4){(cs[bj][n][0] + o[0]) * (1.0f / 256.0f), (cs[bj][n][1] + o[1]) * (1.0f / 256.0f), (cs[bj][n][2] + o[2]) * (1.0f / 256.0f), (cs[bj][n][3] + o[3]) * (1.0f / 256.0f)}; } } }
        }
        size_t roff = (size_t)(row0 + wr * 64 + fr) * NQKV + u.pn * 256 + wc * 32 + fq * 8;
#pragma unroll
        for (int ai = 0; ai < 2; ++ai)
#pragma unroll
            for (int m = 0; m < 4; ++m) { bf16* rowp = out + roff;
#pragma unroll
                for (int bj = 0; bj < 2; ++bj) { const f32x4 v0 = acc[ai][bj][m][0], v1 = acc[ai][bj][m][1];
                    u32x4 w; w.x = cvt_pk_bf16(v0[0], v0[1]); w.y = cvt_pk_bf16(v0[2], v0[3]); w.z = cvt_pk_bf16(v1[0], v1[1]); w.w = cvt_pk_bf16(v1[2], v1[3]);
                    ST_NT((u32x4*)(rowp + bj * 128), w); }
                NEXT_ROW(roff, m, NQKV); }
    }
};

template <bool NEXT, bool F8 = false> struct EpiResid {
    static constexpr bool PERM = false, ACC_INIT = true;
    const bf16* base; float* out; bf16* outb; float* ssq_part;
    __device__ __forceinline__ void init(Acc& acc, const Unit& u, int wr, int wc, int fr, int fq) const {
        const bf16* bp = base + (size_t)(u.pm * 256 + wr * 64 + fr) * DM + u.pn * 256 + wc * 32 + fq * 4;
#pragma unroll
        for (int ai = 0; ai < 2; ++ai)
#pragma unroll
            for (int m = 0; m < 4; ++m)
#pragma unroll
                for (int bj = 0; bj < 2; ++bj)
#pragma unroll
                    for (int n = 0; n < 2; ++n) { const u32x2 w = *(const u32x2*)(bp + (size_t)(ai * 128 + m * 16) * DM + bj * 128 + n * 16); acc[ai][bj][m][n] = (f32x4){bflo(w.x), bfhi(w.x), bflo(w.y), bfhi(w.y)}; if constexpr (F8) acc[ai][bj][m][n] = acc[ai][bj][m][n] * 4096.0f; }
    }
    __device__ __forceinline__ void operator()(Acc& acc, const Unit& u, int wr, int wc, int fr, int fq, LAS unsigned char* le, int wid, int lane, int& cpm) const {
        LAS float* P = (LAS float*)le;
        const int tid = wid * 64 + lane, row0 = u.pm * 256, col0 = u.pn * 256 + wc * 32 + fq * 4;
        size_t roff = (size_t)(row0 + wr * 64 + fr) * DM + col0;
#pragma unroll
        for (int ai = 0; ai < 2; ++ai)
#pragma unroll
            for (int m = 0; m < 4; ++m) { const int rt = ai * 128 + wr * 64 + m * 16 + fr; const size_t off = roff; float s = 0.f;
#pragma unroll
                for (int bj = 0; bj < 2; ++bj)
#pragma unroll
                    for (int n = 0; n < 2; ++n) { f32x4 v = acc[ai][bj][m][n]; if constexpr (F8) v = v * (1.0f / 4096.0f);
                        if constexpr (NEXT) { u32x2 w; w.x = cvt_pk_bf16(v[0], v[1]); w.y = cvt_pk_bf16(v[2], v[3]); *(u32x2*)(outb + off + bj * 128 + n * 16) = w;
                            const float r0 = bflo(w.x), r1 = bfhi(w.x), r2 = bflo(w.y), r3 = bfhi(w.y); s += (r0 * r0 + r1 * r1) + (r2 * r2 + r3 * r3); }
                        else { u32x2 w; w.x = cvt_pk_bf16(v[0], v[1]); w.y = cvt_pk_bf16(v[2], v[3]); *(u32x2*)(outb + off + bj * 128 + n * 16) = w; } }
                if constexpr (NEXT) { s += __shfl_xor(s, 16); s += __shfl_xor(s, 32); if (fq == 0) P[rt * 4 + wc] = s; }
                NEXT_ROW(roff, m, DM); }
        if constexpr (NEXT) { EPI_BAR();
        if (tid < 256) { const f32x4 pp = *(const LAS f32x4*)(P + tid * 4); ssq_part[(size_t)u.pn * T + row0 + tid] = (pp[0] + pp[1]) + (pp[2] + pp[3]); } }
    }
};

template <bool MOE> struct EpiSwiGLU {
    static constexpr bool PERM = true, ACC_INIT = false;
    bf16* out; const float* parts; int nparts; const float* slot_rstd;
    __device__ __forceinline__ void operator()(Acc& acc, const Unit& u, int wr, int wc, int fr, int fq, LAS unsigned char* le, int wid, int lane, int& cpm) const {
        LAS float* S = (LAS float*)le; const int tid = wid * 64 + lane, row0 = u.pm * 256;
        if constexpr (MOE) { if (cpm != u.pm) { cpm = u.pm; if (tid < 256) S[tid] = slot_rstd[row0 + tid]; EPI_BAR(); } }
        else row_rstd_to_lds<8>(S, parts, u.pm, tid, cpm);
        size_t roff = (size_t)(row0 + wr * 64 + fr) * DFF + u.pn * 128 + wc * 32 + fq * 8;
#pragma unroll
        for (int ai = 0; ai < 2; ++ai)
#pragma unroll
            for (int m = 0; m < 4; ++m) { const int rt = ai * 128 + wr * 64 + m * 16 + fr; const float rs = S[rt];
                const f32x4 ga = acc[ai][0][m][0] * rs, gb = acc[ai][0][m][1] * rs, ua = acc[ai][1][m][0] * rs, ub = acc[ai][1][m][1] * rs; f32x4 ha, hb;
#pragma unroll
                for (int j = 0; j < 4; ++j) { ha[j] = ga[j] * fast_sigmoid(ga[j]) * ua[j]; hb[j] = gb[j] * fast_sigmoid(gb[j]) * ub[j]; }
                u32x4 w; w.x = cvt_pk_bf16(ha[0], ha[1]); w.y = cvt_pk_bf16(ha[2], ha[3]); w.z = cvt_pk_bf16(hb[0], hb[1]); w.w = cvt_pk_bf16(hb[2], hb[3]);
                ST_NT((u32x4*)(out + roff), w);
                NEXT_ROW(roff, m, DFF); }
    }
};

__device__ __forceinline__ unsigned pk4_fp8(float a, float b, float c, float d) {
    a = __builtin_amdgcn_fmed3f(a, -448.f, 448.f); b = __builtin_amdgcn_fmed3f(b, -448.f, 448.f); c = __builtin_amdgcn_fmed3f(c, -448.f, 448.f); d = __builtin_amdgcn_fmed3f(d, -448.f, 448.f);
    unsigned w = 0u; w = __builtin_amdgcn_cvt_pk_fp8_f32(a, b, w, false); w = __builtin_amdgcn_cvt_pk_fp8_f32(c, d, w, true); return w;
}
constexpr float W_UP_SCALE = 256.f, W_DN_SCALE = 512.f, H_SCALE = 8.f, Y_SCALE = 16.f;
struct EpiSwiGLUFp8 {
    static constexpr bool PERM = true, ACC_INIT = false;
    unsigned char* out; const float* slot_rstd;
    __device__ __forceinline__ void operator()(Acc& acc, const Unit& u, int wr, int wc, int fr, int fq, LAS unsigned char* le, int wid, int lane, int& cpm) const {
        LAS float* S = (LAS float*)le; const int tid = wid * 64 + lane, row0 = u.pm * 256;
        if (cpm != u.pm) { cpm = u.pm; if (tid < 256) S[tid] = slot_rstd[row0 + tid] * (1.0f / W_UP_SCALE); EPI_BAR(); }
        size_t roff = (size_t)(row0 + wr * 64 + fr) * DFF + u.pn * 128 + wc * 32 + fq * 8;
#pragma unroll
        for (int ai = 0; ai < 2; ++ai)
#pragma unroll
            for (int m = 0; m < 4; ++m) { const int rt = ai * 128 + wr * 64 + m * 16 + fr; const float rs = S[rt];
                const float rl = rs * -1.4426950408889634f, kk = rs * rs * H_SCALE; f32x4 ha, hb;
#pragma unroll
                for (int j = 0; j < 4; ++j) { const float g0 = acc[ai][0][m][0][j], g1 = acc[ai][0][m][1][j];
                    ha[j] = (g0 * acc[ai][1][m][0][j]) * kk * __builtin_amdgcn_rcpf(1.0f + __builtin_amdgcn_exp2f(g0 * rl));
                    hb[j] = (g1 * acc[ai][1][m][1][j]) * kk * __builtin_amdgcn_rcpf(1.0f + __builtin_amdgcn_exp2f(g1 * rl)); }
                u32x2 w; w.x = pk4_fp8(ha[0], ha[1], ha[2], ha[3]); w.y = pk4_fp8(hb[0], hb[1], hb[2], hb[3]);
                ST_NT((u32x2*)(out + roff), w);
                NEXT_ROW(roff, m, DFF); }
    }
};

struct EpiRecIn {
    static constexpr bool PERM = true, ACC_INIT = false;
    bf16* xbr; bf16* gg; const float* parts;
    __device__ __forceinline__ void operator()(Acc& acc, const Unit& u, int wr, int wc, int fr, int fq, LAS unsigned char* le, int wid, int lane, int& cpm) const {
        LAS float* S = (LAS float*)le; const int tid = wid * 64 + lane, row0 = u.pm * 256;
        row_rstd_to_lds<8>(S, parts, u.pm, tid, cpm);
        const bool is_gate = u.pn >= 8; bf16* dst = is_gate ? gg : xbr; const int colt = (u.pn & 7) * 256 + wc * 32 + fq * 8;
        size_t roff = (size_t)(row0 + wr * 64 + fr) * DM + colt;
#pragma unroll
        for (int ai = 0; ai < 2; ++ai)
#pragma unroll
            for (int m = 0; m < 4; ++m) { const int rt = ai * 128 + wr * 64 + m * 16 + fr; const float rs = S[rt];
#pragma unroll
                for (int bj = 0; bj < 2; ++bj) { f32x4 v0 = acc[ai][bj][m][0] * rs, v1 = acc[ai][bj][m][1] * rs;
                    if (is_gate) {
#pragma unroll
                        for (int j = 0; j < 4; ++j) { { const float x = v0[j]; v0[j] = x * fast_sigmoid(1.5957691216057308f * (x + 0.044715f * x * x * x)); }
                                                      { const float x = v1[j]; v1[j] = x * fast_sigmoid(1.5957691216057308f * (x + 0.044715f * x * x * x)); } } }
                    u32x4 w; w.x = cvt_pk_bf16(v0[0], v0[1]); w.y = cvt_pk_bf16(v0[2], v0[3]); w.z = cvt_pk_bf16(v1[0], v1[1]); w.w = cvt_pk_bf16(v1[2], v1[3]);
                    ST_NT((u32x4*)(dst + roff + bj * 128), w); }
                NEXT_ROW(roff, m, DM); }
    }
};

#define DPP_SHR(x, ctrl) __builtin_bit_cast(float, __builtin_amdgcn_update_dpp(0, __builtin_bit_cast(int, (x)), (ctrl), 0xf, 0xf, true))
struct EpiGates {
    static constexpr bool PERM = false, ACC_INIT = false, APERM = true;
    const bf16* xc; const float* b_a; const float* b_i; const float* spl; unsigned* au; float* scanA; float* scanH;
    __device__ __forceinline__ void operator()(Acc& acc, const Unit& u, int wr, int wc, int fr, int fq, LAS unsigned char* le, int, int, int&) const {
        const int row0 = u.pm * 256, ch0 = (u.pn >> 1) * 256 + (u.pn & 1) * 128 + wc * 32 + fq * 4;
        size_t roff = (size_t)(row0 + wr * 64 + 4 * fr) * DM + ch0;
        LAS float* X = (LAS float*)le;
        u32x2 xpre[2][4][2];
#pragma unroll
        for (int ai = 0; ai < 2; ++ai)
#pragma unroll
            for (int m = 0; m < 4; ++m)
#pragma unroll
                for (int n = 0; n < 2; ++n) xpre[ai][m][n] = *(const u32x2*)(xc + roff + (size_t)(ai * 128 + m) * DM + n * 16);
        float RA[2][2][4], RH[2][2][4];
#pragma unroll
        for (int ai = 0; ai < 2; ++ai) {
#pragma unroll
            for (int m = 0; m < 4; ++m) {
#pragma unroll
                for (int n = 0; n < 2; ++n) { const size_t off = roff + n * 16;
                    const f32x4 ba = *(const f32x4*)(b_a + ch0 + n * 16), bi = *(const f32x4*)(b_i + ch0 + n * 16), sl = *(const f32x4*)(spl + ch0 + n * 16);
                    const u32x2 xw = xpre[ai][m][n]; const float xv[4] = {bflo(xw.x), bfhi(xw.x), bflo(xw.y), bfhi(xw.y)};
                    const f32x4 ra = acc[ai][0][m][n] + ba, ri = acc[ai][1][m][n] + bi; u32x4 pk;
#pragma unroll
                    for (int j = 0; j < 4; ++j) { const float r = fast_sigmoid(ra[j]), ig = fast_sigmoid(ri[j]);
                        const float la = bflo(cvt_pk_bf16(-8.0f * r * sl[j], 0.f));
                        const float a = fast_exp(la); const float x2 = 2.0f * la;
                        const float ser = -x2 * (1.0f + x2 * (0.5f + x2 * (1.0f / 6.0f + x2 * (1.0f / 24.0f + x2 * (1.0f / 120.0f)))));
                        const float om = (x2 > -0.3f) ? ser : (1.0f - a * a);
                        const unsigned w = cvt_pk_bf16(la, __builtin_amdgcn_sqrtf(om) * (ig * xv[j])); pk[j] = w;
                        const float uu = bfhi(w);
                        if (m == 0) { RA[ai][n][j] = a; RH[ai][n][j] = uu; } else { RH[ai][n][j] = a * RH[ai][n][j] + uu; RA[ai][n][j] = RA[ai][n][j] * a; } }
                    ST_NT((u32x4*)(au + off), pk); }
                roff += (size_t)(m == 3 ? 125 : 1) * DM; asm volatile("" : "+v"(roff) :: "memory"); }
#pragma unroll
            for (int n = 0; n < 2; ++n)
#pragma unroll
                for (int j = 0; j < 4; ++j) { float A = RA[ai][n][j], H = RH[ai][n][j];
                    { const float Ap = DPP_SHR(A, 0x111), Hp = DPP_SHR(H, 0x111); H = A * Hp + H; A = Ap * A; }
                    { const float Ap = DPP_SHR(A, 0x112), Hp = DPP_SHR(H, 0x112); H = A * Hp + H; A = Ap * A; }
                    { const float Ap = DPP_SHR(A, 0x114), Hp = DPP_SHR(H, 0x114); H = A * Hp + H; A = Ap * A; }
                    { const float Ap = DPP_SHR(A, 0x118), Hp = DPP_SHR(H, 0x118); H = A * Hp + H; A = Ap * A; }
                    RA[ai][n][j] = A; RH[ai][n][j] = H; }
            if (wr == 1 && fr == 15) {
#pragma unroll
                for (int n = 0; n < 2; ++n)
#pragma unroll
                    for (int j = 0; j < 4; ++j) { LAS float* xp = X + ((((ai * 4 + wc) * 4 + fq) * 2 + n) * 4 + j) * 2; xp[0] = RA[ai][n][j]; xp[1] = RH[ai][n][j]; } }
        }
        EPI_BAR();
        if (wr == 0 && fr == 15) { const int b = u.pm >> 4, c2 = (u.pm & 15) * 2;
#pragma unroll
            for (int ai = 0; ai < 2; ++ai)
#pragma unroll
                for (int n = 0; n < 2; ++n) { f32x4 oa, oh;
#pragma unroll
                    for (int j = 0; j < 4; ++j) { const LAS float* xp = X + ((((ai * 4 + wc) * 4 + fq) * 2 + n) * 4 + j) * 2; const float A2 = xp[0], H2 = xp[1];
                        oa[j] = RA[ai][n][j] * A2; oh[j] = A2 * RH[ai][n][j] + H2; }
                    const size_t o = (size_t)(b * 32 + c2 + ai) * DM + ch0 + n * 16; *(f32x4*)(scanA + o) = oa; *(f32x4*)(scanH + o) = oh; } }
    }
};
#define DPP_SHR_ID(x, idv, ctrl) __builtin_bit_cast(float, __builtin_amdgcn_update_dpp(__builtin_bit_cast(int, (float)(idv)), __builtin_bit_cast(int, (x)), (ctrl), 0xf, 0xf, false))
struct EpiGatesScan {
    static constexpr bool PERM = false, ACC_INIT = false, APERM = true;
    const bf16* xc; const float* b_a; const float* b_i; const float* spl; const bf16* gg; bf16* yb; float* agg; unsigned* flags;
    __device__ __forceinline__ void operator()(Acc& acc, const Unit& u, int wr, int wc, int fr_, int fq_, LAS unsigned char* le, int wid, int lane, int&) const {
        asm volatile("" : "+v"(lane));
        const int fr = lane & 15, fq = lane >> 4;
        const int row0 = u.pm * 256, chb = (u.pn >> 1) * 256 + (u.pn & 1) * 128, ch0 = chb + wc * 32 + fq * 4, tid = wid * 64 + lane;
        size_t roff = (size_t)(row0 + wr * 64 + 4 * fr) * DM + ch0;
        LAS float* X = (LAS float*)le;
        LAS float* C0 = X + 1024;
        u32x2 xpre[2][4][2];
#pragma unroll
        for (int ai = 0; ai < 2; ++ai)
#pragma unroll
            for (int m = 0; m < 4; ++m)
#pragma unroll
                for (int n = 0; n < 2; ++n) xpre[ai][m][n] = *(const u32x2*)(xc + roff + (size_t)(ai * 128 + m) * DM + n * 16);
        float EA[2][2][4], EH[2][2][4];
#pragma unroll
        for (int ai = 0; ai < 2; ++ai) {
#pragma unroll
            for (int m = 0; m < 4; ++m) {
#pragma unroll
                for (int n = 0; n < 2; ++n) {
                    const f32x4 ba = *(const f32x4*)(b_a + ch0 + n * 16), bi = *(const f32x4*)(b_i + ch0 + n * 16), sl = *(const f32x4*)(spl + ch0 + n * 16);
                    const u32x2 xw = xpre[ai][m][n]; const float xv[4] = {bflo(xw.x), bfhi(xw.x), bflo(xw.y), bfhi(xw.y)};
                    const f32x4 ra = acc[ai][0][m][n] + ba, ri = acc[ai][1][m][n] + bi;
#pragma unroll
                    for (int j = 0; j < 4; ++j) { const float r = fast_sigmoid(ra[j]), ig = fast_sigmoid(ri[j]);
                        const float la = -8.0f * r * sl[j];
                        const float a = fast_exp(la); const float x2 = 2.0f * la;
                        const float ser = -x2 * (1.0f + x2 * (0.5f + x2 * (1.0f / 6.0f + x2 * (1.0f / 24.0f + x2 * (1.0f / 120.0f)))));
                        const float om = (x2 > -0.3f) ? ser : (1.0f - a * a);
                        const float uu = __builtin_amdgcn_sqrtf(om) * (ig * xv[j]);
                        if (m == 0) { acc[ai][0][m][n][j] = a; acc[ai][1][m][n][j] = uu; }
                        else { acc[ai][1][m][n][j] = a * acc[ai][1][m - 1][n][j] + uu; acc[ai][0][m][n][j] = acc[ai][0][m - 1][n][j] * a; } } } }
#pragma unroll
            for (int n = 0; n < 2; ++n)
#pragma unroll
                for (int j = 0; j < 4; ++j) { float A = acc[ai][0][3][n][j], H = acc[ai][1][3][n][j];
                    { const float Ap = DPP_SHR_ID(A, 1.0f, 0x111), Hp = DPP_SHR_ID(H, 0.0f, 0x111); H = A * Hp + H; A = Ap * A; }
                    { const float Ap = DPP_SHR_ID(A, 1.0f, 0x112), Hp = DPP_SHR_ID(H, 0.0f, 0x112); H = A * Hp + H; A = Ap * A; }
                    { const float Ap = DPP_SHR_ID(A, 1.0f, 0x114), Hp = DPP_SHR_ID(H, 0.0f, 0x114); H = A * Hp + H; A = Ap * A; }
                    { const float Ap = DPP_SHR_ID(A, 1.0f, 0x118), Hp = DPP_SHR_ID(H, 0.0f, 0x118); H = A * Hp + H; A = Ap * A; }
                    EA[ai][n][j] = DPP_SHR_ID(A, 1.0f, 0x111); EH[ai][n][j] = DPP_SHR_ID(H, 0.0f, 0x111);
                    if (fr == 15) { LAS float* xp = X + (((ai * 2 + wr) * 128) + wc * 32 + n * 16 + fq * 4 + j) * 2; xp[0] = A; xp[1] = H; } }
        }
        u32x2 gpre[2][4][2];
#pragma unroll
        for (int m = 0; m < 4; ++m)
#pragma unroll
            for (int n = 0; n < 2; ++n) gpre[0][m][n] = *(const u32x2*)(gg + roff + (size_t)m * DM + n * 16);
        EPI_BAR();
        if (tid < 128) { float TA = 1.f, TH = 0.f;
#pragma unroll
            for (int blk = 0; blk < 4; ++blk) { const f32x2 ah = *(const LAS f32x2*)(X + (blk * 128 + tid) * 2); TH = ah.x * TH + ah.y; TA = TA * ah.x; }
            __hip_atomic_store((unsigned long long*)(agg + ((size_t)u.pm * DM + chb + tid) * 2), __builtin_bit_cast(unsigned long long, (f32x2){TA, TH}), __ATOMIC_RELAXED, __HIP_MEMORY_SCOPE_AGENT);
            asm volatile("s_waitcnt vmcnt(0)" ::: "memory"); }
        EPI_BAR();
        if (tid == 0) __hip_atomic_store(flags + u.pm * 16 + u.pn, 1u, __ATOMIC_RELAXED, __HIP_MEMORY_SCOPE_AGENT);
        if (tid < 128) { const int pm0 = u.pm & ~15, np = u.pm & 15; float h0 = 0.f;
            { const int q = lane & 15; unsigned sp = 0;
                for (;;) { const unsigned f = (q < np) ? __hip_atomic_load(flags + (pm0 + q) * 16 + u.pn, __ATOMIC_RELAXED, __HIP_MEMORY_SCOPE_AGENT) : 1u;
                    if (__builtin_amdgcn_ballot_w64(f == 0u) == 0ull) break;
                    __builtin_amdgcn_s_sleep(1); if (++sp > (1u << 14)) break; } }
            asm volatile("" ::: "memory");
            f32x2 ahs[15];
#pragma unroll
            for (int q = 0; q < 15; ++q) { const int qq = q < np ? q : 0;
                ahs[q] = __builtin_bit_cast(f32x2, __hip_atomic_load((unsigned long long*)(agg + ((size_t)(pm0 + qq) * DM + chb + tid) * 2), __ATOMIC_RELAXED, __HIP_MEMORY_SCOPE_AGENT)); }
#pragma unroll
            for (int q = 0; q < 15; ++q) if (q < np) h0 = ahs[q].x * h0 + ahs[q].y;
            C0[tid] = h0; }
        EPI_BAR();
#pragma unroll
        for (int ai = 0; ai < 2; ++ai) { float cl[2][4];
            if (ai == 0) {
#pragma unroll
                for (int m = 0; m < 4; ++m)
#pragma unroll
                    for (int n = 0; n < 2; ++n) gpre[1][m][n] = *(const u32x2*)(gg + roff + (size_t)(128 + m) * DM + n * 16); }
#pragma unroll
            for (int n = 0; n < 2; ++n)
#pragma unroll
                for (int j = 0; j < 4; ++j) { const int c = wc * 32 + n * 16 + fq * 4 + j; float s = C0[c];
                    if (ai == 1) { const f32x2 b0 = *(const LAS f32x2*)(X + (0 * 128 + c) * 2), b1 = *(const LAS f32x2*)(X + (1 * 128 + c) * 2); s = b0.x * s + b0.y; s = b1.x * s + b1.y; }
                    if (wr == 1) { const f32x2 b2 = *(const LAS f32x2*)(X + ((ai * 2) * 128 + c) * 2); s = b2.x * s + b2.y; }
                    cl[n][j] = EA[ai][n][j] * s + EH[ai][n][j]; }
#pragma unroll
            for (int m = 0; m < 4; ++m) {
#pragma unroll
                for (int n = 0; n < 2; ++n) { const u32x2 gw = gpre[ai][m][n]; const float gv[4] = {bflo(gw.x), bfhi(gw.x), bflo(gw.y), bfhi(gw.y)}; float y[4];
#pragma unroll
                    for (int j = 0; j < 4; ++j) y[j] = (acc[ai][0][m][n][j] * cl[n][j] + acc[ai][1][m][n][j]) * gv[j];
                    u32x2 w; w.x = cvt_pk_bf16(y[0], y[1]); w.y = cvt_pk_bf16(y[2], y[3]);
                    *(u32x2*)(yb + roff + n * 16) = w; }
                roff += (size_t)(m == 3 ? 125 : 1) * DM; asm volatile("" : "+v"(roff) :: "memory"); } }
    }
};

struct EpiSwiGLUDenseF8 {
    static constexpr bool PERM = true, ACC_INIT = false;
    unsigned char* out; const float* parts;
    __device__ __forceinline__ void operator()(Acc& acc, const Unit& u, int wr, int wc, int fr, int fq, LAS unsigned char* le, int wid, int lane, int& cpm) const {
        LAS float* S = (LAS float*)le; const int tid = wid * 64 + lane, row0 = u.pm * 256;
        row_rstd_to_lds<8>(S, parts, u.pm, tid, cpm);
        size_t roff = (size_t)(row0 + wr * 64 + fr) * DFF + u.pn * 128 + wc * 32 + fq * 8;
#pragma unroll
        for (int ai = 0; ai < 2; ++ai)
#pragma unroll
            for (int m = 0; m < 4; ++m) { const int rt = ai * 128 + wr * 64 + m * 16 + fr; const float rs = S[rt];
                const float rl = rs * -1.4426950408889634f, kk = rs * rs * H_SCALE; f32x4 ha, hb;
#pragma unroll
                for (int j = 0; j < 4; ++j) { const float g0 = acc[ai][0][m][0][j], g1 = acc[ai][0][m][1][j];
                    ha[j] = (g0 * acc[ai][1][m][0][j]) * kk * __builtin_amdgcn_rcpf(1.0f + __builtin_amdgcn_exp2f(g0 * rl));
                    hb[j] = (g1 * acc[ai][1][m][1][j]) * kk * __builtin_amdgcn_rcpf(1.0f + __builtin_amdgcn_exp2f(g1 * rl)); }
                u32x2 w; w.x = pk4_fp8(ha[0], ha[1], ha[2], ha[3]); w.y = pk4_fp8(hb[0], hb[1], hb[2], hb[3]);
                ST_NT((u32x2*)(out + roff), w);
                NEXT_ROW(roff, m, DFF); }
    }
};
struct EpiMoeDown {
    static constexpr bool PERM = true, ACC_INIT = false;
    unsigned char* y; float oscale;
    __device__ __forceinline__ void operator()(Acc& acc, const Unit& u, int wr, int wc, int fr, int fq, LAS unsigned char*, int, int, int&) const {
        size_t roff = (size_t)(u.pm * 256 + wr * 64 + fr) * DM + u.pn * 256 + wc * 32 + fq * 8;
#pragma unroll
        for (int ai = 0; ai < 2; ++ai)
#pragma unroll
            for (int m = 0; m < 4; ++m) {
#pragma unroll
                for (int bj = 0; bj < 2; ++bj) { const f32x4 v0 = acc[ai][bj][m][0] * oscale, v1 = acc[ai][bj][m][1] * oscale;
                    u32x2 w; w.x = pk4_fp8(v0[0], v0[1], v0[2], v0[3]); w.y = pk4_fp8(v1[0], v1[1], v1[2], v1[3]);
                    *(u32x2*)(y + roff + bj * 128) = w; }
                NEXT_ROW(roff, m, DM); }
    }
};
struct EpiMoeDownTail {
    static constexpr bool PERM = true, ACC_INIT = false;
    unsigned char* y; float oscale; float* part; unsigned* flg;
    __device__ __forceinline__ void operator()(Acc& acc, const Unit& u, int wr, int wc, int fr, int fq, LAS unsigned char*, int wid, int lane, int&) const {
        const int tid = wid * 64 + lane;
        if (u.ks < 3) { float* p = part + (size_t)(u.ti * 3 + u.ks) * (32 * 512 * 4) + tid * 4;
#pragma unroll
            for (int ai = 0; ai < 2; ++ai)
#pragma unroll
                for (int bj = 0; bj < 2; ++bj)
#pragma unroll
                    for (int m = 0; m < 4; ++m)
#pragma unroll
                        for (int n = 0; n < 2; ++n) *(f32x4*)(p + (size_t)(((ai * 2 + bj) * 4 + m) * 2 + n) * (512 * 4)) = acc[ai][bj][m][n];
            asm volatile("s_waitcnt vmcnt(0)" ::: "memory");
            EPI_BAR();
            if (tid == 0) __hip_atomic_fetch_add(flg + u.ti, 1u, __ATOMIC_RELAXED, __HIP_MEMORY_SCOPE_AGENT);
            return; }
        if (tid == 0) { unsigned sp = 0; while (__hip_atomic_load(flg + u.ti, __ATOMIC_RELAXED, __HIP_MEMORY_SCOPE_AGENT) < 3u) { __builtin_amdgcn_s_sleep(1); if (++sp > (1u << 14)) break; } }
        EPI_BAR();
        __builtin_amdgcn_fence(__ATOMIC_ACQUIRE, "agent");
#pragma unroll
        for (int q = 0; q < 3; ++q) { const float* p = part + (size_t)(u.ti * 3 + q) * (32 * 512 * 4) + tid * 4;
#pragma unroll
            for (int ai = 0; ai < 2; ++ai)
#pragma unroll
                for (int bj = 0; bj < 2; ++bj)
#pragma unroll
                    for (int m = 0; m < 4; ++m)
#pragma unroll
                        for (int n = 0; n < 2; ++n) acc[ai][bj][m][n] += *(const f32x4*)(p + (size_t)(((ai * 2 + bj) * 4 + m) * 2 + n) * (512 * 4)); }
        size_t roff = (size_t)(u.pm * 256 + wr * 64 + fr) * DM + u.pn * 256 + wc * 32 + fq * 8;
#pragma unroll
        for (int ai = 0; ai < 2; ++ai)
#pragma unroll
            for (int m = 0; m < 4; ++m) {
#pragma unroll
                for (int bj = 0; bj < 2; ++bj) { const f32x4 v0 = acc[ai][bj][m][0] * oscale, v1 = acc[ai][bj][m][1] * oscale;
                    u32x2 w; w.x = pk4_fp8(v0[0], v0[1], v0[2], v0[3]); w.y = pk4_fp8(v1[0], v1[1], v1[2], v1[3]);
                    *(u32x2*)(y + roff + bj * 128) = w; }
                NEXT_ROW(roff, m, DM); }
    }
};
}
constexpr size_t MiB = 1u << 20;
constexpr size_t WS_CTL = 0, CTL_ZERO_BYTES = 1 * MiB;
constexpr size_t WS_SSQ0 = 1 * MiB;
constexpr size_t WS_SSQ1 = WS_SSQ0 + 64 * 1024;
constexpr size_t WS_SSQ2 = WS_SSQ1 + 512 * 1024;
constexpr size_t WS_SSQ3 = WS_SSQ2 + 512 * 1024;
constexpr size_t WS_KMEAN = WS_SSQ3 + 512 * 1024;
constexpr size_t WS_ROPE = WS_KMEAN + 256 * 1024;
constexpr size_t WS_SPL = WS_ROPE + 512 * 1024;
constexpr size_t WS_RSTD3 = WS_SPL + 8 * 1024;
constexpr size_t WS_TOKE = WS_RSTD3 + 64 * 1024;
constexpr size_t WS_TOKW = WS_TOKE + 64 * 1024;
constexpr size_t WS_CNTC = WS_TOKW + 128 * 1024;
constexpr size_t WS_SLOTT = WS_CNTC + 8 * 1024;
constexpr size_t WS_SLOTW = WS_SLOTT + 144 * 1024;
constexpr size_t WS_TPREF = WS_SLOTW + 144 * 1024;
constexpr size_t WS_GAINS = WS_TPREF + 1024;
constexpr size_t WS_TOKS = WS_GAINS + 4096;
constexpr size_t WS_SLOTR = WS_TOKS + 128 * 1024;
constexpr size_t WS_SCANA = 8 * MiB, WS_SCANH = 9 * MiB, WS_SCANC = 10 * MiB;
static_assert(WS_SLOTR + 144 * 1024 <= WS_SCANA, "small arrays");
constexpr size_t WS_WQKV = 32 * MiB, WS_WO = 56 * MiB, WS_WGU = 64 * MiB, WS_WDN = 120 * MiB, WS_WIN = 148 * MiB, WS_WAI = 164 * MiB, WS_WO2 = 166 * MiB;
constexpr size_t WS_EGU = 176 * MiB, WS_EDN = 624 * MiB;
constexpr size_t WS_XB = 848 * MiB;
constexpr size_t WS_XR = 912 * MiB;
constexpr size_t WS_ARENA = 1040 * MiB;
constexpr size_t WS_QKV = WS_ARENA, WS_O = WS_ARENA + 192 * MiB;
constexpr size_t WS_H = WS_ARENA;
constexpr size_t WS_XBR = WS_ARENA, WS_GG = WS_ARENA + 64 * MiB, WS_XC = WS_ARENA + 128 * MiB, WS_AA = WS_ARENA + 192 * MiB, WS_UU = WS_ARENA + 320 * MiB, WS_Y = WS_ARENA + 448 * MiB;
constexpr size_t WS_PART = WS_ARENA + 256 * MiB;
constexpr size_t WS_HE = WS_ARENA;
constexpr size_t WS_XG = WS_ARENA + 512 * MiB;
constexpr size_t WS_END = WS_XG + 136 * MiB;
static_assert((size_t)NSLOT_PAD * DFF * 2 <= 512 * MiB && (size_t)T * DFF * 2 <= 512 * MiB && (size_t)NSLOT_PAD * DM * 2 <= 136 * MiB, "arena");
constexpr int CW_TMO = 0, CW_BAR = 4096, CW_XRANK = 8192, CW_SCANF = 12288, CW_TAILF = 13312;

constexpr int RING_OFF = 0, RING_BYTES = 131072, EPI_OFF = 131072, EPI_BYTES = 12288, MISC_OFF = EPI_OFF + EPI_BYTES, LDS_BYTES = 147456;
static_assert(MISC_OFF + 128 <= LDS_BYTES && att::LDS_BYTES <= RING_BYTES, "LDS map");

#define XB_TMO      128
#define XB_XCNT(j)  (256  + 64 * (j))
#define XB_XSUB(j)  (1280 + 64 * (j))
#define XB_XGEN(j)  (2304 + 64 * (j))
#define XB_TOP      3328
#define XB_TOPGEN   3392
#define XCD_BAR_WORDS 3456
#define XB_SPIN_CAP (1u << 18)
__device__ __forceinline__ unsigned xb_ld(unsigned* p)              { return __hip_atomic_load(p, __ATOMIC_RELAXED, __HIP_MEMORY_SCOPE_AGENT); }
__device__ __forceinline__ unsigned xb_add(unsigned* p, unsigned v) { return __hip_atomic_fetch_add(p, v, __ATOMIC_RELAXED, __HIP_MEMORY_SCOPE_AGENT); }
__device__ __forceinline__ unsigned xb_xcc_id() { return (unsigned)__builtin_amdgcn_s_getreg((3 << 11) | 20) & 0xFu; }
#define XB_SPIN(cond, bar) do { unsigned _sp = 0; while (cond) { __builtin_amdgcn_s_sleep(1); \
    if ((++_sp & 255u) == 0u) { if (xb_ld(&(bar)[XB_TMO])) break; if (_sp > XB_SPIN_CAP) { atomicAdd(&(bar)[XB_TMO], 1u); break; } } } } while (0)
struct XcdBarrier { unsigned* bar; unsigned x; volatile LAS unsigned* st; int wave; };
__device__ __forceinline__ bool xb_leader(int wave) { return wave == 0 && __builtin_amdgcn_mbcnt_hi(~0u, __builtin_amdgcn_mbcnt_lo(~0u, 0u)) == 0u; }
__device__ __forceinline__ XcdBarrier xcd_barrier_post(unsigned* bar, volatile LAS unsigned* st, int wave) {
    XcdBarrier b; b.bar = bar; b.x = xb_xcc_id(); b.st = st; b.wave = wave;
    if (xb_leader(wave)) (void)xb_add(&bar[XB_XCNT(b.x)], 1u);
    return b;
}
__device__ __forceinline__ void xcd_barrier_complete(unsigned* bar, unsigned x, unsigned& nloc, unsigned& nx) {
    const unsigned G = gridDim.x * gridDim.y * gridDim.z;
    unsigned sum, cnt, mine, sp = 0u;
    for (;;) {
        sum = 0u; cnt = 0u; mine = 0u;
#pragma unroll
        for (unsigned j = 0; j < 16; ++j) { const unsigned c = xb_ld(&bar[XB_XCNT(j)]); sum += c; cnt += (c > 0u) ? 1u : 0u; mine = (j == x) ? c : mine; }
        if (sum == G) break;
        __builtin_amdgcn_s_sleep(1);
        if ((++sp & 255u) == 0u) { if (xb_ld(&bar[XB_TMO])) break; if (sp > XB_SPIN_CAP) { atomicAdd(&bar[XB_TMO], 1u); break; } }
    }
    nloc = mine > 0u ? mine : 1u; nx = cnt > 0u ? cnt : 1u;
}
__device__ __forceinline__ void xcd_barrier(const XcdBarrier& b) {
    asm volatile("s_waitcnt vmcnt(0)" ::: "memory");
    __syncthreads();
    if (xb_leader(b.wave)) {
        unsigned* bar = b.bar;
        __builtin_amdgcn_s_waitcnt(0);
        unsigned nloc = b.st[0], nx = b.st[1];
        if (nloc == 0u) { xcd_barrier_complete(bar, b.x, nloc, nx); b.st[0] = nloc; b.st[1] = nx; }
        const unsigned old = xb_add(&bar[XB_XSUB(b.x)], 1u);
        const unsigned gen = old / nloc;
        if (old + 1u == (gen + 1u) * nloc) {
            __builtin_amdgcn_fence(__ATOMIC_RELEASE, "agent");
            asm volatile("s_waitcnt vmcnt(0)" ::: "memory");
            const unsigned og = xb_add(&bar[XB_TOP], 1u);
            const unsigned tg = og / nx;
            if (og + 1u == (tg + 1u) * nx) xb_add(&bar[XB_TOPGEN], 1u);
            else XB_SPIN(xb_ld(&bar[XB_TOPGEN]) == tg, bar);
            __builtin_amdgcn_fence(__ATOMIC_ACQUIRE, "agent");
            xb_add(&bar[XB_XGEN(b.x)], 1u);
            asm volatile("s_waitcnt vmcnt(0)" ::: "memory");
        } else {
            XB_SPIN(xb_ld(&bar[XB_XGEN(b.x)]) == gen, bar);
            __builtin_amdgcn_fence(__ATOMIC_ACQUIRE, "agent");
            asm volatile("s_waitcnt vmcnt(0)" ::: "memory");
        }
    }
    __syncthreads();
}

#define LDS_WAIT() asm volatile("s_waitcnt lgkmcnt(0)" ::: "memory")
__device__ __forceinline__ void transpose_item(const float* W, int ldw, int k0, int n0, const float* gain, bf16* WT, int ldwt, int drow0, LAS float* scr, int lane) {
    const int n4 = lane & 7, kr = lane >> 3;
#pragma unroll
    for (int i = 0; i < 8; ++i) { const int kk = 8 * i + kr; f32x4 v = *(const f32x4*)(W + (size_t)(k0 + kk) * ldw + n0 + 4 * n4);
        if (gain) v = v * gain[k0 + kk];
        LAS float* d = scr + kk * 33 + 4 * n4; d[0] = v[0]; d[1] = v[1]; d[2] = v[2]; d[3] = v[3]; }
    LDS_WAIT(); asm volatile("" ::: "memory");
    const int c = lane & 7;
#pragma unroll
    for (int j = 0; j < 4; ++j) { const int n = (lane >> 3) + 8 * j; const LAS float* s = scr + (8 * c) * 33 + n;
        u32x4 o; o.x = pk2(s[0 * 33], s[1 * 33]); o.y = pk2(s[2 * 33], s[3 * 33]); o.z = pk2(s[4 * 33], s[5 * 33]); o.w = pk2(s[6 * 33], s[7 * 33]);
        *(u32x4*)(WT + (size_t)(drow0 + n) * ldwt + k0 + 8 * c) = o; }
    LDS_WAIT(); asm volatile("" ::: "memory");
}
__device__ __forceinline__ void transpose_item_fp8(const float* W, int ldw, int k0, int n0, const float* gain, float scale, unsigned char* WT, int ldwt, int drow0, LAS float* scr, int lane) {
    const int n4 = lane & 7, kr = lane >> 3;
#pragma unroll
    for (int i = 0; i < 8; ++i) { const int kk = 8 * i + kr; f32x4 v = *(const f32x4*)(W + (size_t)(k0 + kk) * ldw + n0 + 4 * n4);
        v = v * (gain ? gain[k0 + kk] * scale : scale);
        LAS float* d = scr + kk * 33 + 4 * n4; d[0] = v[0]; d[1] = v[1]; d[2] = v[2]; d[3] = v[3]; }
    LDS_WAIT(); asm volatile("" ::: "memory");
    const int c = lane & 7;
#pragma unroll
    for (int j = 0; j < 4; ++j) { const int n = (lane >> 3) + 8 * j; const LAS float* s = scr + (8 * c) * 33 + n;
        u32x2 o; o.x = epi::pk4_fp8(s[0 * 33], s[1 * 33], s[2 * 33], s[3 * 33]); o.y = epi::pk4_fp8(s[4 * 33], s[5 * 33], s[6 * 33], s[7 * 33]);
        *(u32x2*)(WT + (size_t)(drow0 + n) * ldwt + k0 + 8 * c) = o; }
    LDS_WAIT(); asm volatile("" ::: "memory");
}
__device__ __forceinline__ bool transpose_group_fp8(int& it, const float* W, size_t wstride, int nmat, int K, int N, const float* gain, float scale, unsigned char* WT, size_t tstride, int mode, LAS float* scr, int lane) {
    const int nblk = N / 32, per = (K / 64) * nblk, tot = per * nmat;
    if (it >= tot) { it -= tot; return false; }
    const int mat = it / per, r = it % per, kb = r / nblk, nb = r % nblk, n0 = 32 * nb;
    const int drow0 = (mode == 0) ? n0 : (256 * (n0 / 128) + (n0 % 128) + (mode == 2 ? 128 : 0));
    transpose_item_fp8(W + (size_t)mat * wstride, N, 64 * kb, n0, gain, scale, WT + (size_t)mat * tstride, K, drow0, scr, lane);
    return true;
}
__device__ __forceinline__ bool transpose_group(int& it, const float* W, size_t wstride, int nmat, int K, int N, const float* gain, bf16* WT, size_t tstride, int mode, LAS float* scr, int lane) {
    const int nblk = N / 32, per = (K / 64) * nblk, tot = per * nmat;
    if (it >= tot) { it -= tot; return false; }
    const int mat = it / per, r = it % per, kb = r / nblk, nb = r % nblk, n0 = 32 * nb;
    const int drow0 = (mode == 0) ? n0 : (256 * (n0 / 128) + (n0 % 128) + (mode == 2 ? 128 : 0));
    transpose_item(W + (size_t)mat * wstride, N, 64 * kb, n0, gain, WT + (size_t)mat * tstride, K, drow0, scr, lane);
    return true;
}
__device__ __forceinline__ void sincos_f64(double x, double& s, double& c) {
    const double TWO_PI = 6.283185307179586476925286766559, INV_2PI = 0.15915494309189533576888376337251;
    const double n = __builtin_rint(x * INV_2PI); const double r = __builtin_fma(-n, TWO_PI, x), r2 = r * r;
    double ts = r, tc = 1.0; s = r; c = 1.0;
#pragma unroll
    for (int k = 1; k <= 14; ++k) { tc = -tc * r2 / (double)((2 * k - 1) * (2 * k)); ts = -ts * r2 / (double)((2 * k) * (2 * k + 1)); c += tc; s += ts; }
}

struct TItem { const float* src; const float* gain; unsigned char* dst; int ldw, ldwt, fp8; float scale; };
__device__ __forceinline__ bool titem_group(int& it, TItem& t, const float* W, size_t wstride, int nmat, int K, int N, const float* gain, float scale, void* WT, size_t tstride_bytes, int mode, int fp8) {
    const int nblk = N / 64, per = (K / 64) * nblk, tot = per * nmat;
    if (it >= tot) { it -= tot; return false; }
    const int mat = it / per, r = it % per, k0 = 64 * (r / nblk), n0 = 64 * (r % nblk), esz = fp8 ? 1 : 2;
    const int drow0 = (mode == 0) ? n0 : (256 * (n0 / 128) + (n0 % 128) + (mode == 2 ? 128 : 0));
    t.src = W + (size_t)mat * wstride + (size_t)k0 * N + n0; t.gain = gain ? gain + k0 : nullptr;
    t.dst = (unsigned char*)WT + (size_t)mat * tstride_bytes + ((size_t)drow0 * K + k0) * esz; t.ldw = N; t.ldwt = K * esz; t.fp8 = fp8; t.scale = scale; return true;
}
__device__ __forceinline__ void titem_load(const TItem& t, f32x4 (&v)[2][8], f32x4 (&g)[2], int lane) {
    const int n4 = lane & 7, kr = lane >> 3;
    const float* gp = t.gain ? t.gain : t.src;
#pragma unroll
    for (int h = 0; h < 2; ++h)
#pragma unroll
        for (int i = 0; i < 8; ++i) v[h][i] = *(const f32x4*)(t.src + (size_t)(8 * kr + i) * t.ldw + 32 * h + 4 * n4);
    g[0] = *(const f32x4*)(gp + 8 * kr); g[1] = *(const f32x4*)(gp + 8 * kr + 4);
}
__device__ __forceinline__ void titem_process(const TItem& t, const f32x4 (&v)[2][8], const f32x4 (&g)[2], int lane) {
    const int n4 = lane & 7, kr = lane >> 3;
    float s[8];
#pragma unroll
    for (int j = 0; j < 8; ++j) s[j] = t.gain ? g[j >> 2][j & 3] * t.scale : t.scale;
    if (t.fp8) {
#pragma unroll
        for (int h = 0; h < 2; ++h)
#pragma unroll
            for (int i = 0; i < 4; ++i) { u32x2 o; o.x = epi::pk4_fp8(v[h][0][i] * s[0], v[h][1][i] * s[1], v[h][2][i] * s[2], v[h][3][i] * s[3]); o.y = epi::pk4_fp8(v[h][4][i] * s[4], v[h][5][i] * s[5], v[h][6][i] * s[6], v[h][7][i] * s[7]);
                *(u32x2*)(t.dst + (size_t)(32 * h + 4 * n4 + i) * t.ldwt + 8 * kr) = o; }
    } else {
#pragma unroll
        for (int h = 0; h < 2; ++h)
#pragma unroll
            for (int i = 0; i < 4; ++i) { u32x4 o; o.x = cvt_pk_bf16(v[h][0][i] * s[0], v[h][1][i] * s[1]); o.y = cvt_pk_bf16(v[h][2][i] * s[2], v[h][3][i] * s[3]); o.z = cvt_pk_bf16(v[h][4][i] * s[4], v[h][5][i] * s[5]); o.w = cvt_pk_bf16(v[h][6][i] * s[6], v[h][7][i] * s[7]);
                *(u32x4*)(t.dst + (size_t)(32 * h + 4 * n4 + i) * t.ldwt + 16 * kr) = o; }
    }
}

struct Args { const float* in[27]; float* out; unsigned char* ws; int ph_lo, ph_hi; };
constexpr int NPHASE = 19;
#ifndef MK_PER_PHASE
#define MK_PER_PHASE 0
#endif

__global__ void __launch_bounds__(NTHR, 2) fwd_kernel(Args args) {
    extern __shared__ __attribute__((aligned(16))) unsigned char lds_raw[];
    LAS unsigned char* lds = (LAS unsigned char*)lds_raw;
    volatile LAS unsigned* MISC = (volatile LAS unsigned*)(lds + MISC_OFF);
    const int G = gridDim.x, wg = blockIdx.x, GT = G * NTHR, NGW = G * NWAVES;
    const int wave_s = __builtin_amdgcn_readfirstlane(threadIdx.x >> 6);
#define x_in (AP->in[0])
#define ev_attn_norm (AP->in[1])
#define ev_w_in (AP->in[2])
#define ev_qn_sb (AP->in[3])
#define ev_kn_sb (AP->in[4])
#define ev_qn_mb (AP->in[5])
#define ev_kn_mb (AP->in[6])
#define ev_w_o (AP->in[7])
#define ev_ffn_norm (AP->in[8])
#define ev_w_gate (AP->in[9])
#define ev_w_up (AP->in[10])
#define ev_w_down (AP->in[11])
#define od_rec_norm (AP->in[12])
#define od_w_in (AP->in[13])
#define od_conv_w (AP->in[14])
#define od_conv_b (AP->in[15])
#define od_w_a (AP->in[16])
#define od_b_a (AP->in[17])
#define od_w_i (AP->in[18])
#define od_b_i (AP->in[19])
#define od_lambda (AP->in[20])
#define od_w_o (AP->in[21])
#define od_ffn_norm (AP->in[22])
#define od_router (AP->in[23])
#define od_we_gate (AP->in[24])
#define od_we_up (AP->in[25])
#define od_we_down (AP->in[26])
#define ssq0 ((float*)(AP->ws + WS_SSQ0))
#define ssq1 ((float*)(AP->ws + WS_SSQ1))
#define ssq2 ((float*)(AP->ws + WS_SSQ2))
#define ssq3 ((float*)(AP->ws + WS_SSQ3))
#define kmean ((float*)(AP->ws + WS_KMEAN))
#define rope ((float*)(AP->ws + WS_ROPE))
#define spl ((float*)(AP->ws + WS_SPL))
#define rstd3 ((float*)(AP->ws + WS_RSTD3))
#define tok_e ((int*)(AP->ws + WS_TOKE))
#define tok_w ((float*)(AP->ws + WS_TOKW))
#define tok_slot ((int*)(AP->ws + WS_TOKS))
#define cnt_chunk ((int*)(AP->ws + WS_CNTC))
#define slot_tok ((int*)(AP->ws + WS_SLOTT))
#define slot_w ((float*)(AP->ws + WS_SLOTW))
#define tpref ((int*)(AP->ws + WS_TPREF))
#define gains ((float*)(AP->ws + WS_GAINS))
#define slot_rstd ((float*)(AP->ws + WS_SLOTR))
#define XG ((bf16*)(AP->ws + WS_XG))
#define scanA ((float*)(AP->ws + WS_SCANA))
#define scanH ((float*)(AP->ws + WS_SCANH))
#define scanC ((float*)(AP->ws + WS_SCANC))
#define Wqkv ((bf16*)(AP->ws + WS_WQKV))
#define Wo ((bf16*)(AP->ws + WS_WO))
#define Wgu ((bf16*)(AP->ws + WS_WGU))
#define Wdn ((bf16*)(AP->ws + WS_WDN))
#define Win ((bf16*)(AP->ws + WS_WIN))
#define Wai ((bf16*)(AP->ws + WS_WAI))
#define Wo2 ((bf16*)(AP->ws + WS_WO2))
#define Egu ((bf16*)(AP->ws + WS_EGU))
#define Edn ((bf16*)(AP->ws + WS_EDN))
#define XB ((bf16*)(AP->ws + WS_XB))
#define XR ((float*)(AP->ws + WS_XR))
#define QKV ((bf16*)(AP->ws + WS_QKV))
#define OB ((bf16*)(AP->ws + WS_O))
#define HB ((bf16*)(AP->ws + WS_H))
#define XBR ((bf16*)(AP->ws + WS_XBR))
#define GG ((bf16*)(AP->ws + WS_GG))
#define XC ((bf16*)(AP->ws + WS_XC))
#define AA ((float*)(AP->ws + WS_AA))
#define UU ((float*)(AP->ws + WS_UU))
#define YB ((bf16*)(AP->ws + WS_Y))
#define HE ((bf16*)(AP->ws + WS_HE))
#define out (AP->out)
    typedef const __attribute__((address_space(4))) Args* ArgsP;
#define PHASE_ARGS() ArgsP AP = (ArgsP)__builtin_amdgcn_kernarg_segment_ptr(); asm volatile("" : "+s"(AP))
    gu32* ctl; { PHASE_ARGS(); ctl = (gu32*)(AP->ws + WS_CTL); }
#define PHASE_IDS() const int lane = (int)__builtin_amdgcn_mbcnt_hi(~0u, __builtin_amdgcn_mbcnt_lo(~0u, 0u)), wave = wave_s, tid = wave * 64 + lane, gtid = wg * NTHR + tid, gw = wg * NWAVES + wave; (void)gtid; (void)gw
    for (int u = threadIdx.x; u < (LDS_BYTES - MISC_OFF) / 4; u += NTHR) ((LAS unsigned*)(lds + MISC_OFF))[u] = 0u;
    __syncthreads();
    XcdBarrier bar; bar.bar = (unsigned*)(ctl + CW_BAR); bar.x = 0; bar.st = nullptr; bar.wave = wave_s;
    if (!MK_PER_PHASE) bar = xcd_barrier_post((unsigned*)(ctl + CW_BAR), MISC + 8, wave_s);
    if (!MK_PER_PHASE && xb_leader(wave_s)) { const unsigned xcc = xb_xcc_id(); const unsigned rk = xb_add((unsigned*)(ctl + CW_XRANK + 64 * (xcc & 7u)), 1u); MISC[16] = rk * 8u + (xcc & 7u); }
    int vwg = wg; bool xloc = false;
    const int lo = args.ph_lo, hi = args.ph_hi;
#ifndef PHMASK
#define PHMASK 0x7ffff
#endif
#define IN(k) (((PHMASK >> (k)) & 1) && lo <= (k) && (k) < hi)
#ifndef PROBE_XBAR
#define PROBE_XBAR 0
#endif
#define SEAM(k) do { if (IN(k) && IN((k) + 1)) { xcd_barrier(bar); for (int xb_ = 0; xb_ < PROBE_XBAR; ++xb_) xcd_barrier(bar); } } while (0)
#ifndef PHREP
#define PHREP 0
#endif
#define NREP(k) ((((PHREP) >> (k)) & 1) ? 2 : 1)
    LAS unsigned char* ring = lds + RING_OFF; LAS unsigned char* lepi = lds + EPI_OFF;

    constexpr int PER_FF = (DM / 64) * (DFF / 64), PER_DN = (DFF / 64) * (DM / 64), NEXP_ITEMS = 16 * PER_FF + 8 * PER_DN;
    constexpr int NITEMS = (DM / 64) * (NQKV / 64) + (DM / 64) * (DM / 64) + 2 * PER_FF + PER_DN + (DM / 64) * (2 * DM / 64) + 16 * (256 / 64) * (256 / 64) + (DM / 64) * (DM / 64) + NEXP_ITEMS;
#define TDECODE(itv, t) do { int it_ = (itv); \
            if (titem_group(it_, t, od_we_gate, (size_t)DM * DFF, 8, DM, DFF, od_ffn_norm, epi::W_UP_SCALE, Egu, (size_t)2 * DFF * DM, 1, 1)) break; \
            if (titem_group(it_, t, od_we_up, (size_t)DM * DFF, 8, DM, DFF, od_ffn_norm, epi::W_UP_SCALE, Egu, (size_t)2 * DFF * DM, 2, 1)) break; \
            if (titem_group(it_, t, od_we_down, (size_t)DFF * DM, 8, DFF, DM, nullptr, epi::W_DN_SCALE, Edn, (size_t)DM * DFF, 0, 1)) break; \
            if (titem_group(it_, t, ev_w_in, 0, 1, DM, NQKV, ev_attn_norm, 1.0f, Wqkv, 0, 0, 0)) break; \
            if (titem_group(it_, t, ev_w_o, 0, 1, DM, DM, nullptr, 1.0f, Wo, 0, 0, 0)) break; \
            if (titem_group(it_, t, ev_w_gate, 0, 1, DM, DFF, ev_ffn_norm, 1.0f, Wgu, 0, 1, 0)) break; \
            if (titem_group(it_, t, ev_w_up, 0, 1, DM, DFF, ev_ffn_norm, 1.0f, Wgu, 0, 2, 0)) break; \
            if (titem_group(it_, t, ev_w_down, 0, 1, DFF, DM, nullptr, epi::W_DN_SCALE, Wdn, 0, 0, 1)) break; \
            if (titem_group(it_, t, od_w_in, 0, 1, DM, 2 * DM, od_rec_norm, 1.0f, Win, 0, 0, 0)) break; \
            if (titem_group(it_, t, od_w_a, (size_t)256 * 256, 8, 256, 256, nullptr, 1.0f, Wai, (size_t)512 * 256 * 2, 1, 0)) break; \
            if (titem_group(it_, t, od_w_i, (size_t)256 * 256, 8, 256, 256, nullptr, 1.0f, Wai, (size_t)512 * 256 * 2, 2, 0)) break; \
            titem_group(it_, t, od_w_o, 0, 1, DM, DM, nullptr, 1.0f, Wo2, 0, 0, 0); } while (0)
#define CONVERT_RANGE(first_, last_) do { \
            TItem tA, tB; f32x4 vA[2][8], vB[2][8]; f32x4 gA[2], gB[2]; \
            int it = (first_) + gw; \
            if (it < (last_)) { \
                TDECODE(it, tA); titem_load(tA, vA, gA, lane); \
                for (;;) {                                                     \
                    int itB = it + NGW; const bool hasB = itB < (last_); if (!hasB) itB = it; \
                    TDECODE(itB, tB); titem_load(tB, vB, gB, lane); \
                    titem_process(tA, vA, gA, lane); \
                    if (!hasB) break; \
                    it = itB + NGW; const bool hasA = it < (last_); if (!hasA) it = itB; \
                    TDECODE(it, tA); titem_load(tA, vA, gA, lane); \
                    titem_process(tB, vB, gB, lane); \
                    if (!hasA) break; \
                } } } while (0)
    for (int rep_ = 0; rep_ < NREP(0); ++rep_) { if (rep_ > 0 && !MK_PER_PHASE) xcd_barrier(bar);
    if (IN(0)) { PHASE_ARGS(); PHASE_IDS();
#ifdef PROBE_CONV_IN_P0
        CONVERT_RANGE(0, NITEMS);
#else
        CONVERT_RANGE(NEXP_ITEMS, NITEMS);
#endif
        for (int m = gw; m < T; m += NGW) {
            const f32x4* xr = (const f32x4*)(x_in + (size_t)m * DM) + lane; f32x4 v[8]; float s = 0.f;
#pragma unroll
            for (int j = 0; j < 8; ++j) { v[j] = xr[64 * j]; s += (v[j][0] * v[j][0] + v[j][1] * v[j][1]) + (v[j][2] * v[j][2] + v[j][3] * v[j][3]); }
            s = wave_sum(s); if (lane == 0) ssq0[m] = s;
            u32x2* o8 = (u32x2*)(XB + (size_t)m * DM) + lane;
#pragma unroll
            for (int j = 0; j < 8; ++j) { u32x2 w; w.x = cvt_pk_bf16(v[j][0], v[j][1]); w.y = cvt_pk_bf16(v[j][2], v[j][3]); o8[64 * j] = w; }
        }
        for (int idx = gtid; idx < SEQ * 16; idx += GT) {
            const double invf[16] = {1.0, 0.44036660267178046, 0.19392274474868576, 0.08539710028576561, 0.03760603093086393, 0.016560440080994446, 0.007292664737217109, 0.003211445994752591,
                                     0.001414213562373095, 0.000622772421914596, 0.0002742481756762073, 0.00012076973741146504, 5.318295896944988e-05, 2.341999896140934e-05, 1.031338537721246e-05, 4.5416704806078695e-06};
            const int pos = idx >> 4, i = idx & 15; double f = invf[0];
#pragma unroll
            for (int k = 1; k < 16; ++k) f = (i == k) ? invf[k] : f;
            double s, c; sincos_f64((double)pos * f, s, c);
            rope[idx] = (float)c; rope[SEQ * 16 + idx] = (float)s;
        }
        for (int c = gtid; c < DM; c += GT) { const float l = od_lambda[c]; spl[c] = (l > 15.f) ? expf(-l) : log1pf(expf(-l)); }
        if (gtid < HD) { gains[gtid] = ev_qn_sb[gtid]; gains[128 + gtid] = ev_kn_sb[gtid]; gains[256 + gtid] = ev_qn_mb[gtid]; gains[384 + gtid] = ev_kn_mb[gtid]; }
    }
    }
    SEAM(0);
    if (!MK_PER_PHASE && lo == 0) {
        bool ok = (G % 8) == 0;
#pragma unroll
        for (int j = 0; j < 8; ++j) ok = ok && (__hip_atomic_load((unsigned*)(ctl + CW_XRANK + 64 * j), __ATOMIC_RELAXED, __HIP_MEMORY_SCOPE_AGENT) == (unsigned)(G / 8));
        const int cand = __builtin_amdgcn_readfirstlane((int)MISC[16]);
        vwg = (ok && cand < G) ? cand : wg; xloc = ok && cand < G;
    }

    for (int rep_ = 0; rep_ < NREP(1); ++rep_) { if (rep_ > 0 && !MK_PER_PHASE) xcd_barrier(bar);
    if (IN(1)) { PHASE_ARGS();
        pg8::ProbPlain g{(const char*)XB, (const char*)Wqkv, (unsigned)DM * 2u, (unsigned)DM * 2u, DM / 64}; pg8::StaticOrder S; S.init(T / 256, NQKV / 256, G, vwg);
        epi::EpiQKV E{QKV, ssq0, gains, rope, kmean};
        pg8::gemm_phase(ring, lepi, g, S, E, wave_s);
    }
    }
    SEAM(1);

    for (int rep_ = 0; rep_ < NREP(3); ++rep_) { if (rep_ > 0 && !MK_PER_PHASE) xcd_barrier(bar);
    if (IN(3)) { PHASE_ARGS(); PHASE_IDS();
        const int half = (wg >> 3) & 1;
#ifndef PROBE_CONV_IN_P0
        if (half == 1) { CONVERT_RANGE(0, NEXP_ITEMS); __syncthreads(); }
#endif
#ifdef PROBE_ATT2
        int nrp_ = 2; asm volatile("" : "+s"(nrp_));
        for (int rp_ = 0; rp_ < nrp_; ++rp_) {
#endif
        for (int p = wg; p < 256; p += G) { const int bh = p >> 3, k = p & 7, b = bh >> 3, h = bh & 7;
            for (int s = 0; s < 2; ++s) att::attn_unit<1>(QKV, OB, kmean, b, h, s ? 15 - k : k, ring, lepi, wave_s); }
        for (int p = wg; p < 256; p += G) { const int bh = p >> 3, k = p & 7, b = bh >> 3, h = bh & 7;
            for (int s = 0; s < 2; ++s) att::attn_unit<0>(QKV, OB, kmean, b, h, s ? 15 - k : k, ring, lepi, wave_s); }
#ifdef PROBE_ATT2
        }
#endif
#ifndef PROBE_CONV_IN_P0
        if (half == 0) { __syncthreads(); CONVERT_RANGE(0, NEXP_ITEMS); }
#endif
    }
    }
    SEAM(3);

    for (int rep_ = 0; rep_ < NREP(4); ++rep_) { if (rep_ > 0 && !MK_PER_PHASE) xcd_barrier(bar);
    if (IN(4)) { PHASE_ARGS();
        pg8::ProbPlain g{(const char*)OB, (const char*)Wo, (unsigned)DM * 2u, (unsigned)DM * 2u, DM / 64}; pg8::StaticOrder S; S.init(T / 256, DM / 256, G, vwg);
        epi::EpiResid<true> E{XB, nullptr, XB, ssq1};
        pg8::gemm_phase(ring, lepi, g, S, E, wave_s);
    }
    }
    SEAM(4);

    for (int rep_ = 0; rep_ < NREP(5); ++rep_) { if (rep_ > 0 && !MK_PER_PHASE) xcd_barrier(bar);
    if (IN(5)) { PHASE_ARGS();
        pg8::ProbPlain g{(const char*)XB, (const char*)Wgu, (unsigned)DM * 2u, (unsigned)DM * 2u, DM / 64}; pg8::StaticOrder S; S.init(T / 256, 2 * DFF / 256, G, vwg);
        epi::EpiSwiGLUDenseF8 E{(unsigned char*)HB, ssq1};
#ifdef PROBE_SPLIT5
        S.i1 = 7; pg8::gemm_phase(ring, lepi, g, S, E, wave_s); if (PROBE_SPLIT5 == 1) xcd_barrier(bar); S.i0 = 7; S.i1 = 1 << 30; pg8::gemm_phase(ring, lepi, g, S, E, wave_s);
#else
        pg8::gemm_phase(ring, lepi, g, S, E, wave_s);
#endif
    }
    }
    SEAM(5);

    for (int rep_ = 0; rep_ < NREP(6); ++rep_) { if (rep_ > 0 && !MK_PER_PHASE) xcd_barrier(bar);
    if (IN(6)) { PHASE_ARGS();
        pg8::ProbPlainF8 g{(const char*)HB, (const char*)Wdn, (unsigned)DFF, (unsigned)DFF, DFF / 128}; pg8::StaticOrder S; S.init(T / 256, DM / 256, G, vwg);
        epi::EpiResid<true, true> E{XB, nullptr, XB, ssq2};
        pg8::gemm_phase(ring, lepi, g, S, E, wave_s);
    }
    }
    SEAM(6);

    for (int rep_ = 0; rep_ < NREP(7); ++rep_) { if (rep_ > 0 && !MK_PER_PHASE) xcd_barrier(bar);
    if (IN(7)) { PHASE_ARGS();
        pg8::ProbPlain g{(const char*)XB, (const char*)Win, (unsigned)DM * 2u, (unsigned)DM * 2u, DM / 64}; pg8::StaticOrder S; S.init(T / 256, 2 * DM / 256, G, vwg);
        epi::EpiRecIn E{XBR, GG, ssq2};
        pg8::gemm_phase(ring, lepi, g, S, E, wave_s);
    }
    }
    SEAM(7);

    for (int rep_ = 0; rep_ < NREP(8); ++rep_) { if (rep_ > 0 && !MK_PER_PHASE) xcd_barrier(bar);
    if (IN(8)) { PHASE_ARGS(); PHASE_IDS();
        for (int idx = gtid; idx < (T / 32) * 256; idx += GT) { const int cg = idx & 255, row0 = (idx >> 8) * 32, c0 = cg * 8;
            float cw[4][8], cb[8], xm3[8], xm2[8], xm1[8];
#pragma unroll
            for (int tp = 0; tp < 4; ++tp) { const f32x4 a = *(const f32x4*)(od_conv_w + tp * DM + c0), b = *(const f32x4*)(od_conv_w + tp * DM + c0 + 4);
#pragma unroll
                for (int j = 0; j < 4; ++j) { cw[tp][j] = a[j]; cw[tp][4 + j] = b[j]; } }
            { const f32x4 a = *(const f32x4*)(od_conv_b + c0), b = *(const f32x4*)(od_conv_b + c0 + 4);
#pragma unroll
              for (int j = 0; j < 4; ++j) { cb[j] = a[j]; cb[4 + j] = b[j]; } }
            const bool first = (row0 & (SEQ - 1)) == 0;
#define LD8(dst, r_) do { const u32x4 w_ = *(const u32x4*)(XBR + (size_t)(r_) * DM + c0); dst[0] = bflo(w_.x); dst[1] = bfhi(w_.x); dst[2] = bflo(w_.y); dst[3] = bfhi(w_.y); dst[4] = bflo(w_.z); dst[5] = bfhi(w_.z); dst[6] = bflo(w_.w); dst[7] = bfhi(w_.w); } while (0)
            if (first) {
#pragma unroll
                for (int j = 0; j < 8; ++j) { xm3[j] = 0.f; xm2[j] = 0.f; xm1[j] = 0.f; }
            } else { LD8(xm3, row0 - 3); LD8(xm2, row0 - 2); LD8(xm1, row0 - 1); }
#pragma unroll 4
            for (int r = 0; r < 32; ++r) { float xt[8], y[8]; LD8(xt, row0 + r);
#pragma unroll
                for (int j = 0; j < 8; ++j) { y[j] = cb[j] + cw[0][j] * xm3[j] + cw[1][j] * xm2[j] + cw[2][j] * xm1[j] + cw[3][j] * xt[j]; xm3[j] = xm2[j]; xm2[j] = xm1[j]; xm1[j] = xt[j]; }
                u32x4 w; w.x = pk2(y[0], y[1]); w.y = pk2(y[2], y[3]); w.z = pk2(y[4], y[5]); w.w = pk2(y[6], y[7]); *(u32x4*)(XC + (size_t)(row0 + r) * DM + c0) = w; }
#undef LD8
        }
    }
    }
    SEAM(8);

    for (int rep_ = 0; rep_ < NREP(9); ++rep_) { if (rep_ > 0 && !MK_PER_PHASE) xcd_barrier(bar);
    if (IN(9)) { PHASE_ARGS();
        pg8::ProbGates g{(const char*)XC, (const char*)Wai, (unsigned)DM * 2u, 512u, 4}; pg8::StaticOrder S; S.init(T / 256, 16, G, vwg);
        epi::EpiGatesScan E{XC, od_b_a, od_b_i, spl, GG, YB, scanA, (unsigned*)(ctl + CW_SCANF)};
        pg8::gemm_phase(ring, lepi, g, S, E, wave_s);
    }
    }
    SEAM(9);


    for (int rep_ = 0; rep_ < NREP(13); ++rep_) { if (rep_ > 0 && !MK_PER_PHASE) xcd_barrier(bar);
    if (IN(13)) { PHASE_ARGS();
        pg8::ProbPlain g{(const char*)YB, (const char*)Wo2, (unsigned)DM * 2u, (unsigned)DM * 2u, DM / 64}; pg8::StaticOrder S; S.init(T / 256, DM / 256, G, vwg);
        epi::EpiResid<false> E{XB, nullptr, XB, nullptr};
        pg8::gemm_phase(ring, lepi, g, S, E, wave_s);
    }
    }
    SEAM(13);

    for (int rep_ = 0; rep_ < NREP(14); ++rep_) { if (rep_ > 0 && !MK_PER_PHASE) xcd_barrier(bar);
    if (IN(14)) { PHASE_ARGS(); PHASE_IDS();
        LAS float* Rg = (LAS float*)ring;
        LAS int* lcnt = (LAS int*)lepi;
        for (int i = tid; i < DM * 8; i += NTHR) { const int k = i >> 3, e = i & 7; Rg[e * DM + k] = od_ffn_norm[k] * od_router[i]; }
        for (int c = wg; c < T / 64; c += G) {
            if (tid < 8) lcnt[tid] = 0;
            __syncthreads();
            const int t0 = c * 64 + wave * 8;
            float acc[8][8], ssq[8];
#pragma unroll
            for (int q = 0; q < 8; ++q) { ssq[q] = 0.f;
#pragma unroll
                for (int e = 0; e < 8; ++e) acc[q][e] = 0.f; }
#pragma unroll 2
            for (int i = 0; i < 16; ++i) { const int k = 2 * lane + 128 * i; f32x2 rv[8]; unsigned xw[8];
#pragma unroll
                for (int e = 0; e < 8; ++e) rv[e] = *(const LAS f32x2*)(Rg + e * DM + k);
#pragma unroll
                for (int q = 0; q < 8; ++q) xw[q] = *(const unsigned*)(XB + (size_t)(t0 + q) * DM + k);
#pragma unroll
                for (int q = 0; q < 8; ++q) { const float x0 = bflo(xw[q]), x1 = bfhi(xw[q]); ssq[q] += x0 * x0 + x1 * x1;
#pragma unroll
                    for (int e = 0; e < 8; ++e) acc[q][e] += x0 * rv[e].x + x1 * rv[e].y; } }
#pragma unroll
            for (int q = 0; q < 8; ++q) { const float sq = wave_sum(ssq[q]); const float rs = 1.0f / sqrtf(sq * (1.0f / DM) + EPS);
                float lg[8];
#pragma unroll
                for (int e = 0; e < 8; ++e) lg[e] = wave_sum(acc[q][e]) * rs;
                int i0 = 0; float v0 = lg[0];
#pragma unroll
                for (int e = 1; e < 8; ++e) if (lg[e] > v0) { v0 = lg[e]; i0 = e; }
                int i1 = -1; float v1 = -__builtin_inff();
#pragma unroll
                for (int e = 0; e < 8; ++e) if (e != i0 && lg[e] > v1) { v1 = lg[e]; i1 = e; }
                if (lane == 0) { const int t = t0 + q; const float w0 = 1.0f / (1.0f + expf(v1 - v0));
                    tok_e[t] = i0 | (i1 << 8); tok_w[2 * t] = w0; tok_w[2 * t + 1] = 1.0f - w0; rstd3[t] = rs;
                    atomicAdd((int*)&lcnt[i0], 1); atomicAdd((int*)&lcnt[i1], 1); } }
            __syncthreads();
            if (tid < 8) cnt_chunk[c * 8 + tid] = lcnt[tid];
            __syncthreads();
        }
    }
    }
    SEAM(14);

    for (int rep_ = 0; rep_ < NREP(15); ++rep_) { if (rep_ > 0 && !MK_PER_PHASE) xcd_barrier(bar);
    if (IN(15)) { PHASE_ARGS(); PHASE_IDS();
        LAS int* li = (LAS int*)lepi;
        for (int c = wg; c < T / 64; c += G) {
            LAS int* lcnt = li + 256; LAS int* lte = li + 2304; LAS float* ltw = (LAS float*)(li + 2368); LAS float* lrs = (LAS float*)(li + 2496);
            for (int i = tid; i < (T / 64) * 8; i += NTHR) lcnt[i] = cnt_chunk[i];
            if (tid < 64) { lte[tid] = tok_e[c * 64 + tid]; lrs[tid] = rstd3[c * 64 + tid]; } else if (tid < 192) ltw[tid - 64] = tok_w[c * 128 + tid - 64];
            __syncthreads();
            if (tid < 8) { int run = 0, mine = 0; for (int cc = 0; cc < T / 64; ++cc) { if (cc == c) mine = run; run += lcnt[cc * 8 + tid]; } li[tid] = run; li[8 + tid] = mine; }
            __syncthreads();
            if (tid == 0) { int s = 0; for (int e = 0; e < 8; ++e) { li[16 + e] = s; s += ((li[e] + 255) >> 8) << 8; } li[24] = s; }
            __syncthreads();
            LAS int* lslot = li + 32;
            if (tid < 8) { const int e = tid; int pos = li[16 + e] + li[8 + e];
                for (int q = 0; q < 64; ++q) { const int t = c * 64 + q; const int pe = lte[q];
                    if ((pe & 255) == e) { slot_tok[pos] = t; slot_w[pos] = ltw[2 * q]; slot_rstd[pos] = lrs[q]; lslot[2 * q] = pos; ++pos; }
                    if ((pe >> 8) == e) { slot_tok[pos] = t; slot_w[pos] = ltw[2 * q + 1]; slot_rstd[pos] = lrs[q]; lslot[2 * q + 1] = pos; ++pos; } } }
            __syncthreads();
            if (tid < 128) tok_slot[c * 128 + tid] = lslot[tid];
            for (int q = wave; q < 64; q += NWAVES) {
                const u32x4* src = (const u32x4*)(XB + (size_t)(c * 64 + q) * DM) + lane; u32x2* d0 = (u32x2*)((unsigned char*)XG + (size_t)lslot[2 * q] * DM) + lane; u32x2* d1 = (u32x2*)((unsigned char*)XG + (size_t)lslot[2 * q + 1] * DM) + lane;
#pragma unroll
                for (int j = 0; j < 4; ++j) { const u32x4 v = src[64 * j]; u32x2 w; w.x = epi::pk4_fp8(bflo(v.x), bfhi(v.x), bflo(v.y), bfhi(v.y)); w.y = epi::pk4_fp8(bflo(v.z), bfhi(v.z), bflo(v.w), bfhi(v.w)); d0[64 * j] = w; d1[64 * j] = w; } }
            if (c == 0) {
                if (tid < 9) tpref[tid] = li[16 + tid] >> 8;
                for (int e = 0; e < 8; ++e) { const int a = li[16 + e] + li[e], z = li[16 + e + 1]; for (int s = a + tid; s < z; s += NTHR) { slot_tok[s] = 0; slot_w[s] = 0.f; slot_rstd[s] = 0.f; } }
            }
            __syncthreads();
        }
    }
    }
    SEAM(15);

    for (int rep_ = 0; rep_ < NREP(16); ++rep_) { if (rep_ > 0 && !MK_PER_PHASE) xcd_barrier(bar);
    if (IN(16)) { PHASE_ARGS();
        pg8::MoeOrder S;
#pragma unroll
        for (int k = 0; k < 9; ++k) S.pf[k] = __builtin_amdgcn_readfirstlane(tpref[k]);
        S.so.init(S.pf[8], 2 * DFF / 256, G, vwg);
        pg8::ProbMoeUp g{(const char*)XG, (const char*)Egu, (unsigned)DM, (unsigned)DM, DM / 128};
        epi::EpiSwiGLUFp8 E{(unsigned char*)HE, slot_rstd};
        pg8::gemm_phase(ring, lepi, g, S, E, wave_s);
    }
    }
    SEAM(16);

    for (int rep_ = 0; rep_ < NREP(17); ++rep_) { if (rep_ > 0 && !MK_PER_PHASE) xcd_barrier(bar);
    if (IN(17)) { PHASE_ARGS();
        pg8::MoeOrder S;
#pragma unroll
        for (int k = 0; k < 9; ++k) S.pf[k] = __builtin_amdgcn_readfirstlane(tpref[k]);
        S.so.init(S.pf[8], DM / 256, G, vwg);
        pg8::ProbMoeDown g{(const char*)HE, (const char*)Edn, (unsigned)DFF, (unsigned)DFF, DFF / 128};
        epi::EpiMoeDown E{(unsigned char*)XG, epi::Y_SCALE / (epi::W_DN_SCALE * epi::H_SCALE)};
        const int nj = S.pf[8] - 128;
        const bool use_tail = xloc && G == 256 && nj >= 1 && nj <= 8 && !MK_PER_PHASE;
        if (use_tail) S.so.i1 = 4;
        pg8::gemm_phase(ring, lepi, g, S, E, wave_s);
        if (use_tail) {
            pg8::MoeTailOrder ST; ST.so = S.so; ST.so.i1 = 1 << 30; ST.nj = nj;
#pragma unroll
            for (int k = 0; k < 9; ++k) ST.pf[k] = S.pf[k];
            pg8::ProbMoeDown g4{(const char*)HE, (const char*)Edn, (unsigned)DFF, (unsigned)DFF, DFF / 128 / 4};
            epi::EpiMoeDownTail ET{(unsigned char*)XG, epi::Y_SCALE / (epi::W_DN_SCALE * epi::H_SCALE), (float*)(AP->ws + WS_PART), (unsigned*)(ctl + CW_TAILF)};
            pg8::gemm_phase(ring, lepi, g4, ST, ET, wave_s);
        }
    }
    }
    SEAM(17);

    if (IN(18)) { PHASE_ARGS(); PHASE_IDS();
        for (int idx = gtid; idx < T * (DM / 8); idx += GT) { const int t = idx >> 8, c0 = (idx & 255) * 8;
            const int s0 = tok_slot[2 * t], s1 = tok_slot[2 * t + 1]; const float w0 = tok_w[2 * t] * (1.0f / epi::Y_SCALE), w1 = tok_w[2 * t + 1] * (1.0f / epi::Y_SCALE);
            const u32x2 a = *(const u32x2*)((const unsigned char*)XG + (size_t)s0 * DM + c0), b = *(const u32x2*)((const unsigned char*)XG + (size_t)s1 * DM + c0); const u32x4 x = *(const u32x4*)(XB + (size_t)t * DM + c0);
            const f32x2 a0 = __builtin_amdgcn_cvt_pk_f32_fp8((int)a.x, false), a1 = __builtin_amdgcn_cvt_pk_f32_fp8((int)a.x, true), a2 = __builtin_amdgcn_cvt_pk_f32_fp8((int)a.y, false), a3 = __builtin_amdgcn_cvt_pk_f32_fp8((int)a.y, true);
            const f32x2 b0 = __builtin_amdgcn_cvt_pk_f32_fp8((int)b.x, false), b1 = __builtin_amdgcn_cvt_pk_f32_fp8((int)b.x, true), b2 = __builtin_amdgcn_cvt_pk_f32_fp8((int)b.y, false), b3 = __builtin_amdgcn_cvt_pk_f32_fp8((int)b.y, true);
            f32x4 o0, o1;
            o0[0] = bflo(x.x) + (w0 * a0[0] + w1 * b0[0]); o0[1] = bfhi(x.x) + (w0 * a0[1] + w1 * b0[1]); o0[2] = bflo(x.y) + (w0 * a1[0] + w1 * b1[0]); o0[3] = bfhi(x.y) + (w0 * a1[1] + w1 * b1[1]);
            o1[0] = bflo(x.z) + (w0 * a2[0] + w1 * b2[0]); o1[1] = bfhi(x.z) + (w0 * a2[1] + w1 * b2[1]); o1[2] = bflo(x.w) + (w0 * a3[0] + w1 * b3[0]); o1[3] = bfhi(x.w) + (w0 * a3[1] + w1 * b3[1]);
            float* op = out + (size_t)t * DM + c0; *(f32x4*)op = o0; *(f32x4*)(op + 4) = o1; }
    }
#undef IN
#undef SEAM
#undef PHASE_IDS
#undef tok_slot
#undef TDECODE
#undef CONVERT_RANGE
#undef PHASE_ARGS
#undef x_in
#undef ev_attn_norm
#undef ev_w_in
#undef ev_qn_sb
#undef ev_kn_sb
#undef ev_qn_mb
#undef ev_kn_mb
#undef ev_w_o
#undef ev_ffn_norm
#undef ev_w_gate
#undef ev_w_up
#undef ev_w_down
#undef od_rec_norm
#undef od_w_in
#undef od_conv_w
#undef od_conv_b
#undef od_w_a
#undef od_b_a
#undef od_w_i
#undef od_b_i
#undef od_lambda
#undef od_w_o
#undef od_ffn_norm
#undef od_router
#undef od_we_gate
#undef od_we_up
#undef od_we_down
#undef ssq0
#undef ssq1
#undef ssq2
#undef ssq3
#undef kmean
#undef rope
#undef spl
#undef rstd3
#undef tok_e
#undef tok_w
#undef cnt_chunk
#undef slot_tok
#undef slot_w
#undef tpref
#undef gains
#undef slot_rstd
#undef XG
#undef scanA
#undef scanH
#undef scanC
#undef Wqkv
#undef Wo
#undef Wgu
#undef Wdn
#undef Win
#undef Wai
#undef Wo2
#undef Egu
#undef Edn
#undef XB
#undef XR
#undef QKV
#undef OB
#undef HB
#undef XBR
#undef GG
#undef XC
#undef AA
#undef UU
#undef YB
#undef HE
#undef out
}

extern "C" void kernel_launch(void* const* d_in, const int* in_sizes, int n_in, void* d_out, int out_size, void* d_ws, size_t ws_size, hipStream_t stream) {
    static int grid = 0;
    if (grid == 0) {
        if (n_in != 27 || in_sizes[0] != T * DM || out_size != T * DM || ws_size < WS_END) {
            fprintf(stderr, "kernel_launch: built for 27 inputs, x/out of %d floats, >= %zu bytes of workspace; got n_in %d, in0 %d, out %d, ws %zu; nothing launched\n", T * DM, (size_t)WS_END, n_in, n_in > 0 ? in_sizes[0] : -1, out_size, ws_size);
            grid = -1; return; }
        int dev = 0, cus = 0, per_cu = 0;
        if (hipGetDevice(&dev) != hipSuccess || hipDeviceGetAttribute(&cus, hipDeviceAttributeMultiprocessorCount, dev) != hipSuccess) { fprintf(stderr, "kernel_launch: device query failed\n"); grid = -1; return; }
        if (hipFuncSetAttribute((const void*)fwd_kernel, hipFuncAttributeMaxDynamicSharedMemorySize, LDS_BYTES) != hipSuccess) { fprintf(stderr, "kernel_launch: hipFuncSetAttribute failed\n"); grid = -1; return; }
        if (hipOccupancyMaxActiveBlocksPerMultiprocessor(&per_cu, (const void*)fwd_kernel, NTHR, LDS_BYTES) != hipSuccess || per_cu < 1)
            fprintf(stderr, "kernel_launch: note: occupancy query reports %d workgroups per CU\n", per_cu);
        (void)hipGetLastError();
        grid = cus;
    }
    if (grid < 0) return;
    if (hipMemsetAsync((char*)d_ws + WS_CTL, 0, CTL_ZERO_BYTES, stream) != hipSuccess) { fprintf(stderr, "kernel_launch: memset failed\n"); return; }
    Args a{};
    for (int i = 0; i < 27; ++i) a.in[i] = (const float*)d_in[i];
    a.out = (float*)d_out; a.ws = (unsigned char*)d_ws;
#if MK_PER_PHASE
    for (int p = 0; p < NPHASE; ++p) { a.ph_lo = p; a.ph_hi = p + 1; hipLaunchKernelGGL(fwd_kernel, dim3(grid), dim3(NTHR), LDS_BYTES, stream, a); }
#else
    a.ph_lo = 0; a.ph_hi = NPHASE;
    hipLaunchKernelGGL(fwd_kernel, dim3(grid), dim3(NTHR), LDS_BYTES, stream, a);
#endif
    const hipError_t le = hipPeekAtLastError();
    if (le != hipSuccess) fprintf(stderr, "kernel_launch: launch failed: %s\n", hipGetErrorName(le));
}
```

```cpp
#include <hip/hip_runtime.h>
#include <cstdio>
#include <cstdint>

#define LAS __attribute__((address_space(3)))
#define GAS __attribute__((address_space(1)))
typedef unsigned short bf16;
typedef short bf16x8 __attribute__((ext_vector_type(8)));
typedef short s16x4 __attribute__((ext_vector_type(4)));
typedef float f32x2 __attribute__((ext_vector_type(2)));
typedef float f32x4 __attribute__((ext_vector_type(4)));
typedef float f32x16 __attribute__((ext_vector_type(16)));
typedef unsigned u32x2 __attribute__((ext_vector_type(2)));
typedef unsigned u32x4 __attribute__((ext_vector_type(4)));
typedef GAS unsigned gu32;

constexpr int NB = 4, SEQ = 4096, DM = 2048, T = NB * SEQ;
constexpr int HD = 128, NQKV = 6144, DFF = 7168, NEXP = 8, NSLOT_PAD = 2 * T + NEXP * 256;
constexpr float EPS = 1e-6f;
constexpr int NWAVES = 8, NTHR = 512;

__device__ __forceinline__ unsigned f2bf(float f) { unsigned u = __builtin_bit_cast(unsigned, f); return (u + 0x7fffu + ((u >> 16) & 1u)) >> 16; }
__device__ __forceinline__ unsigned pk2(float lo, float hi) { return f2bf(lo) | (f2bf(hi) << 16); }
__device__ __forceinline__ float bf2f(unsigned short h) { return __builtin_bit_cast(float, (unsigned)h << 16); }
__device__ __forceinline__ float bflo(unsigned w) { return __builtin_bit_cast(float, w << 16); }
__device__ __forceinline__ float bfhi(unsigned w) { return __builtin_bit_cast(float, w & 0xffff0000u); }
__device__ __forceinline__ unsigned cvt_pk_bf16(float lo, float hi) { unsigned r; asm volatile("v_cvt_pk_bf16_f32 %0, %1, %2" : "=v"(r) : "v"(lo), "v"(hi)); return r; }
__device__ __forceinline__ float wave_sum(float v) {
#pragma unroll
    for (int o = 1; o < 64; o <<= 1) v += __shfl_xor(v, o);
    return v;
}
__device__ __forceinline__ float fast_exp(float x) { return __builtin_amdgcn_exp2f(x * 1.4426950408889634f); }
__device__ __forceinline__ float fast_sigmoid(float x) { return __builtin_amdgcn_rcpf(1.0f + fast_exp(-x)); }

namespace pg8 {
constexpr int BM = 256, BK = 64, HALF = 128, HTB = HALF * BK * 2, STAGE_BYTES = 8 * HTB, NXCD = 8, WGM = 8;
__host__ __device__ __forceinline__ int lds_byte(int r, int c) { const int st = (r >> 4) * 2 + (c >> 5), rr = r & 15, cc = c & 31, ob = rr * 64 + cc * 2; return st * 1024 + (ob ^ (((ob >> 9) & 1) << 5)); }
__host__ __device__ __forceinline__ void stage_rc(int b, int& R, int& C) { const int st = b / 1024, sb = b % 1024, swz = sb ^ (((sb >> 9) & 1) << 5); R = (st >> 1) * 16 + swz / 64; C = (st & 1) * 32 + (swz % 64) / 2; }
__host__ __device__ __forceinline__ int perm_a64(int r) { return (r & ~63) + 4 * (r & 15) + ((r >> 4) & 3); }
template <class E, class = void> struct aperm_of { static constexpr bool v = false; };
template <class E> struct aperm_of<E, decltype((void)E::APERM)> { static constexpr bool v = E::APERM; };
__host__ __device__ __forceinline__ int perm32(int rho) { const int n = rho >> 4, i = rho & 15; return 8 * (i >> 2) + 4 * n + (i & 3); }

struct Unit { int pm, pn, e, ks, ti; };

struct StaticOrder {
    int nM, nN, nwg, G, c, i0 = 0, i1 = 1 << 30;
    __device__ __forceinline__ void init(int nM_, int nN_, int G_, int c_) { nM = nM_; nN = nN_; nwg = nM * nN; G = G_; c = c_; }
    __device__ __forceinline__ bool unit_at(long L, Unit& u) const {
        if (L >= nwg) return false;
        int wgid = (int)L; { const int q = nwg / NXCD, r = nwg % NXCD, xcd = wgid % NXCD, off = wgid / NXCD; wgid = (xcd < r ? xcd * (q + 1) : r * (q + 1) + (xcd - r) * q) + off; }
        const int nig = WGM * nN, gid = wgid / nig, fm = gid * WGM, gsz = (nM - fm) < WGM ? (nM - fm) : WGM;
        u.pm = fm + ((wgid % nig) % gsz); u.pn = (wgid % nig) / gsz; u.e = 0; u.ks = 0; u.ti = 0; return true;
    }
    __device__ __forceinline__ bool next(int i, Unit& u) const {
        i += i0; if (i >= i1) return false;
        return unit_at((long)i * G + c, u);
    }
};
struct MoeOrder {
    StaticOrder so; int pf[9]; int tail_first = -1, tail_n = 0;
    __device__ __forceinline__ bool next(int i, Unit& u) const {
        if (tail_first >= 0) { const long L2 = (long)i * so.G + so.c; if (L2 >= 4L * tail_n) return false; if (!so.unit_at(tail_first + (L2 >> 2), u)) return false; u.ks = (int)(L2 & 3); }
        else if (!so.next(i, u)) return false;
        int e = 0;
#pragma unroll
        for (int k = 1; k < 8; ++k) e += (u.pm >= pf[k]) ? 1 : 0;
        u.e = e; return true;
    }
};
struct MoeTailOrder {
    StaticOrder so; int pf[9]; int nj;
    __device__ __forceinline__ bool next(int i, Unit& u) const {
        if (i != 0) return false;
        const int x = so.c & 7, r = so.c >> 3; if (r >= 4 * nj) return false;
        if (!so.unit_at(8L * (128 + (r >> 2)) + x, u)) return false;
        u.ks = r & 3; u.ti = x * 8 + (r >> 2);
        int e = 0;
#pragma unroll
        for (int k = 1; k < 8; ++k) e += (u.pm >= pf[k]) ? 1 : 0;
        u.e = e; return true;
    }
};

struct ProbPlain {
    static constexpr bool FP8 = false;
    const char* A; const char* B; unsigned lda, ldb; int nt;
    __device__ __forceinline__ const char* a_base(const Unit& u) const { return A + (size_t)u.pm * BM * lda; }
    __device__ __forceinline__ const char* b_base(const Unit& u) const { return B + (size_t)u.pn * BM * ldb; }
};
struct ProbPlainF8 {
    static constexpr bool FP8 = true;
    const char* A; const char* B; unsigned lda, ldb; int nt;
    __device__ __forceinline__ const char* a_base(const Unit& u) const { return A + (size_t)u.pm * BM * lda; }
    __device__ __forceinline__ const char* b_base(const Unit& u) const { return B + (size_t)u.pn * BM * ldb; }
};
struct ProbGates {
    static constexpr bool FP8 = false;
    const char* A; const char* B; unsigned lda, ldb; int nt;
    __device__ __forceinline__ const char* a_base(const Unit& u) const { return A + (size_t)u.pm * BM * lda + (size_t)(u.pn >> 1) * 512; }
    __device__ __forceinline__ const char* b_base(const Unit& u) const { return B + (size_t)u.pn * BM * ldb; }
};
struct ProbMoeUp {
    static constexpr bool FP8 = true;
    const char* A; const char* B; unsigned lda, ldb; int nt;
    __device__ __forceinline__ const char* a_base(const Unit& u) const { return A + (size_t)u.pm * BM * lda; }
    __device__ __forceinline__ const char* b_base(const Unit& u) const { return B + ((size_t)u.e * (2 * DFF) + (size_t)u.pn * BM) * ldb; }
};
struct ProbMoeDown {
    static constexpr bool FP8 = true;
    const char* A; const char* B; unsigned lda, ldb; int nt;
    __device__ __forceinline__ const char* a_base(const Unit& u) const { return A + (size_t)u.pm * BM * lda + (size_t)u.ks * nt * 128; }
    __device__ __forceinline__ const char* b_base(const Unit& u) const { return B + ((size_t)u.e * DM + (size_t)u.pn * BM) * ldb + (size_t)u.ks * nt * 128; }
};
typedef int v8i32 __attribute__((ext_vector_type(8)));
typedef short s16x16 __attribute__((ext_vector_type(16)));
__device__ __forceinline__ v8i32 cat8(bf16x8 lo, bf16x8 hi) { const s16x16 v = __builtin_shufflevector(lo, hi, 0, 1, 2, 3, 4, 5, 6, 7, 8, 9, 10, 11, 12, 13, 14, 15); return __builtin_bit_cast(v8i32, v); }

template <class Epi, class Sched, class Prob>
__device__ __forceinline__ void gemm_phase(LAS unsigned char* lds, LAS unsigned char* lds_epi, const Prob g, const Sched& S, const Epi& E, int wid) {
    const int lane = (int)__builtin_amdgcn_mbcnt_hi(~0u, __builtin_amdgcn_mbcnt_lo(~0u, 0u)), tid = wid * 64 + lane, wr = wid >> 2, wc = wid & 3, fr = lane & 15, fq = lane >> 4;
    const int nt = g.nt;
    int R0, C0, R1, C1; stage_rc(tid * 16, R0, C0); stage_rc(tid * 16 + 8192, R1, C1);
    const unsigned lda2 = g.lda, ldb2 = g.ldb;
    const int Rb0 = Epi::PERM ? ((R0 & ~31) + perm32(R0 & 31)) : R0, Rb1 = Epi::PERM ? ((R1 & ~31) + perm32(R1 & 31)) : R1;
    const unsigned vB0 = (unsigned)Rb0 * ldb2 + (unsigned)C0 * 2u, vB1 = (unsigned)Rb1 * ldb2 + (unsigned)C1 * 2u;
    const unsigned hstepB = (unsigned)HALF * ldb2;
    const size_t kstep = (size_t)(BK * 2);
    const unsigned ldsw = (unsigned)wid * 1024u;
    const int aoff = lds_byte(wr * 64 + fr, fq * 8), boff = lds_byte(wc * 32 + fr, fq * 8);
#define PG8_SA(b, h) (((b) * 2 + (h)) * HTB)
#define PG8_SB(b, h) ((4 + (b) * 2 + (h)) * HTB)
#define PG8_STAGE(bufoff, gbase, o0, o1) do { \
        __builtin_amdgcn_global_load_lds((const unsigned*)((const char*)(gbase) + (o0)), (LAS unsigned*)(lds + (bufoff) + ldsw), 16, 0, 0); \
        __builtin_amdgcn_global_load_lds((const unsigned*)((const char*)(gbase) + (o1)), (LAS unsigned*)(lds + (bufoff) + ldsw + 8192), 16, 0, 0); } while (0)
#define PG8_LDA(dst, b, h) do { _Pragma("unroll") for (int m = 0; m < 4; ++m) _Pragma("unroll") for (int k = 0; k < 2; ++k) dst[m][k] = *(const LAS bf16x8*)(lds + PG8_SA(b, h) + aoff + m * 2048 + k * 1024); } while (0)
#define PG8_LDB(dst, b, h) do { _Pragma("unroll") for (int n = 0; n < 2; ++n) _Pragma("unroll") for (int k = 0; k < 2; ++k) dst[n][k] = *(const LAS bf16x8*)(lds + PG8_SB(b, h) + boff + n * 2048 + k * 1024); } while (0)
#define PG8_MMA(ai, bj, At, Bt) do { __builtin_amdgcn_s_setprio(1); \
        if constexpr (Prob::FP8) { _Pragma("unroll") for (int m = 0; m < 4; ++m) _Pragma("unroll") for (int n = 0; n < 2; ++n) \
            asm volatile("v_mfma_f32_16x16x128_f8f6f4 %0, %1, %2, %0" : "+v"(acc[ai][bj][m][n]) : "v"(cat8(Bt[n][0], Bt[n][1])), "v"(cat8(At[m][0], At[m][1]))); } \
        else { _Pragma("unroll") for (int m = 0; m < 4; ++m) _Pragma("unroll") for (int n = 0; n < 2; ++n) _Pragma("unroll") for (int k = 0; k < 2; ++k) \
            acc[ai][bj][m][n] = __builtin_amdgcn_mfma_f32_16x16x32_bf16(Bt[n][k], At[m][k], acc[ai][bj][m][n], 0, 0, 0); } \
        __builtin_amdgcn_s_setprio(0); } while (0)
#define PG8_WAIT_V(n) asm volatile("s_waitcnt vmcnt(" #n ")" ::: "memory")
#define PG8_WAIT_L(n) asm volatile("s_waitcnt lgkmcnt(" #n ")" ::: "memory")
#define PG8_BAR __builtin_amdgcn_s_barrier()
#define PG8_SCHED __builtin_amdgcn_sched_barrier(0)
    Unit cur, nxt; int ui = 0; int epi_pm = -1;
    if (!S.next(0, cur)) return;
    const int Ra0 = aperm_of<Epi>::v ? perm_a64(R0) : R0, Ra1 = aperm_of<Epi>::v ? perm_a64(R1) : R1;
    const unsigned cA00 = (unsigned)Ra0 * lda2 + (unsigned)C0 * 2u, cA01 = (unsigned)Ra1 * lda2 + (unsigned)C1 * 2u, cA10 = cA00 + (unsigned)HALF * lda2, cA11 = cA01 + (unsigned)HALF * lda2;
    f32x4 acc[2][2][4][2];
#define PG8_ACC_INIT(unit) do { if constexpr (Epi::ACC_INIT) { E.init(acc, unit, wr, wc, fr, fq); } else { \
        _Pragma("unroll") for (int a = 0; a < 2; ++a) _Pragma("unroll") for (int b = 0; b < 2; ++b) _Pragma("unroll") for (int m = 0; m < 4; ++m) _Pragma("unroll") for (int n = 0; n < 2; ++n) acc[a][b][m][n] = (f32x4){0.f, 0.f, 0.f, 0.f}; } } while (0)
    PG8_ACC_INIT(cur);
    bf16x8 At[4][2], B0[2][2], B1[2][2];
    const char* cA = g.a_base(cur); const char* cB = g.b_base(cur);
    PG8_STAGE(PG8_SB(0, 0), cB, vB0, vB1); PG8_STAGE(PG8_SB(0, 1), cB + hstepB, vB0, vB1); PG8_STAGE(PG8_SA(0, 0), cA, cA00, cA01); PG8_STAGE(PG8_SA(0, 1), cA, cA10, cA11);
    if (wr == 1) PG8_BAR;
    PG8_WAIT_V(2); PG8_BAR;
    PG8_STAGE(PG8_SB(1, 0), cB + kstep, vB0, vB1); PG8_STAGE(PG8_SA(1, 0), cA + kstep, cA00, cA01); PG8_STAGE(PG8_SB(1, 1), cB + hstepB + kstep, vB0, vB1);
    PG8_WAIT_V(6); PG8_BAR;
    for (;;) {
        const bool has_next = S.next(ui + 1, nxt);
        const char* nA = has_next ? g.a_base(nxt) : cA; const char* nB = has_next ? g.b_base(nxt) : cB;
_Pragma("clang loop unroll(disable)")
        for (int t = 0; t < nt; t += 2) {
            const bool last = (t == nt - 2);
            const char* a1 = cA + (size_t)(t + 1) * kstep;
            const char* a2 = last ? nA : cA + (size_t)(t + 2) * kstep; const char* b2 = last ? nB : cB + (size_t)(t + 2) * kstep;
            const char* a3 = a2 + kstep; const char* b3 = b2 + kstep;
            PG8_LDB(B0, 0, 0); PG8_LDB(B1, 0, 1); PG8_SCHED; PG8_LDA(At, 0, 0); PG8_STAGE(PG8_SA(1, 1), a1, cA10, cA11);
            PG8_WAIT_V(8); PG8_WAIT_L(0); PG8_BAR; PG8_MMA(0, 0, At, B0); PG8_MMA(0, 1, At, B1); PG8_BAR; PG8_SCHED;
            PG8_LDA(At, 0, 1); PG8_STAGE(PG8_SB(0, 0), b2, vB0, vB1); PG8_STAGE(PG8_SB(0, 1), b2 + hstepB, vB0, vB1); PG8_STAGE(PG8_SA(0, 0), a2, cA00, cA01);
            PG8_WAIT_V(8); PG8_WAIT_L(0); PG8_BAR; PG8_MMA(1, 0, At, B0); PG8_MMA(1, 1, At, B1); PG8_BAR; PG8_SCHED;
            PG8_LDB(B0, 1, 0); PG8_LDB(B1, 1, 1); PG8_SCHED; PG8_LDA(At, 1, 0); PG8_STAGE(PG8_SA(0, 1), a2, cA10, cA11);
            PG8_WAIT_V(8); PG8_WAIT_L(0); PG8_BAR; PG8_MMA(0, 0, At, B0); PG8_MMA(0, 1, At, B1); PG8_BAR; PG8_SCHED;
            PG8_LDA(At, 1, 1); PG8_STAGE(PG8_SB(1, 0), b3, vB0, vB1); PG8_STAGE(PG8_SB(1, 1), b3 + hstepB, vB0, vB1); PG8_STAGE(PG8_SA(1, 0), a3, cA00, cA01);
            PG8_WAIT_V(8); PG8_WAIT_L(0); PG8_BAR; PG8_MMA(1, 0, At, B0); PG8_MMA(1, 1, At, B1); PG8_BAR; PG8_SCHED;
        }
        if constexpr (Prob::FP8) asm volatile("s_nop 7\n\ts_nop 7\n\ts_nop 7" ::: "memory");
        if (wr == 0) PG8_BAR;
        E(acc, cur, wr, wc, fr, fq, lds_epi, wid, lane, epi_pm);
        if (!has_next) break;
        PG8_ACC_INIT(nxt);
        cur = nxt; cA = nA; cB = nB; ++ui;
        if (wr == 1) PG8_BAR;
    }
    PG8_WAIT_V(0);
    PG8_BAR;
#undef PG8_ACC_INIT
#undef PG8_SA
#undef PG8_SB
#undef PG8_STAGE
#undef PG8_LDA
#undef PG8_LDB
#undef PG8_MMA
#undef PG8_WAIT_V
#undef PG8_WAIT_L
#undef PG8_BAR
#undef PG8_SCHED
}
}
namespace att {
constexpr int PITCH = NQKV;
constexpr int SHM_V = 64 * 128 * 2, SHM_K = 64 * 128 * 2;
constexpr int LDS_Q = 2 * SHM_V + 2 * SHM_K, LDS_BYTES = LDS_Q + NWAVES * 8192;
constexpr int EPI_WS = 0, EPI_FLAG = NWAVES * 64 * 4;
constexpr float SCALE = 0.08838834764831845f;
constexpr float C2 = 1.4426950408889634f * SCALE;
#define KSWZ(row, colB) ((row) * 256 + ((colB) ^ (((row) & 7) << 4)))
#define SBAR() __builtin_amdgcn_sched_barrier(0)
__device__ __forceinline__ int v_st(int k, int c) { const int kk = (k & ~0xC) | ((k & 4) << 1) | ((k & 8) >> 1); return ((kk >> 3) * 4 + (c >> 5)) * 512 + ((kk & 7) * 32 + (c & 31)) * 2; }
__device__ __forceinline__ int v_rd_base(int lane) { return ((lane & 3) << 3) | (((lane >> 2) & 3) << 6) | (((lane >> 4) & 1) << 5) | (((lane >> 5) & 1) << 8); }
constexpr int v_rd_off(int d0, int ks, int half) { return d0 * 512 + ks * 4096 + half * 2048; }
__device__ __forceinline__ int crow(int r, int hi) { return (r & 3) + 8 * (r >> 2) + 4 * hi; }

template <int KB>
__device__ __forceinline__ void qkt(f32x16& p0, f32x16& p1, LAS const unsigned char* K_lds, LAS const unsigned char* q_lds, int r32, int hi) {
    p0 = f32x16{}; p1 = f32x16{};
    LAS const unsigned char* kb[4];
#pragma unroll
    for (int dd = 0; dd < 4; ++dd) kb[dd] = K_lds + KB * SHM_K + KSWZ(r32, (dd * 16 + hi * 8) * 2);
#pragma unroll
    for (int d0 = 0; d0 < 8; ++d0) { LAS const unsigned char* a = kb[d0 & 3] + (d0 >> 2) * 128;
        const bf16x8 b0 = *(LAS const bf16x8*)(a);
        const bf16x8 b1 = *(LAS const bf16x8*)(a + 32 * 256);
        const bf16x8 qv = *(LAS const bf16x8*)(q_lds + d0 * 1024);
        p0 = __builtin_amdgcn_mfma_f32_32x32x16_bf16(b0, qv, p0, 0, 0, 0);
        p1 = __builtin_amdgcn_mfma_f32_32x32x16_bf16(b1, qv, p1, 0, 0, 0);
        if ((d0 & 3) == 3) SBAR(); }
}
template <int VB>
__device__ __forceinline__ void pv_tile(f32x16* o, int vb0, bf16x8 pa0, bf16x8 pa1, bf16x8 pa2, bf16x8 pa3) {
#define TRRD(dst, off) asm volatile("ds_read_b64_tr_b16 %0, %1 offset:%2" : "=&v"(dst) : "v"(vb0), "i"(off) : "memory")
#define PV_D0(d0) do { s16x4 l0, l1, l2, l3, h0, h1, h2, h3; constexpr int b_ = VB * SHM_V + v_rd_off(d0, 0, 0); \
        TRRD(l0, b_); TRRD(h0, b_ + 2048); TRRD(l1, b_ + 4096); TRRD(h1, b_ + 6144); TRRD(l2, b_ + 8192); TRRD(h2, b_ + 10240); TRRD(l3, b_ + 12288); TRRD(h3, b_ + 14336); \
        asm volatile("s_waitcnt lgkmcnt(0)" ::: "memory"); SBAR(); \
        o[d0] = __builtin_amdgcn_mfma_f32_32x32x16_bf16(pa0, (bf16x8){l0[0], l0[1], l0[2], l0[3], h0[0], h0[1], h0[2], h0[3]}, o[d0], 0, 0, 0);   \
        o[d0] = __builtin_amdgcn_mfma_f32_32x32x16_bf16(pa1, (bf16x8){l1[0], l1[1], l1[2], l1[3], h1[0], h1[1], h1[2], h1[3]}, o[d0], 0, 0, 0);   \
        o[d0] = __builtin_amdgcn_mfma_f32_32x32x16_bf16(pa2, (bf16x8){l2[0], l2[1], l2[2], l2[3], h2[0], h2[1], h2[2], h2[3]}, o[d0], 0, 0, 0);   \
        o[d0] = __builtin_amdgcn_mfma_f32_32x32x16_bf16(pa3, (bf16x8){l3[0], l3[1], l3[2], l3[3], h3[0], h3[1], h3[2], h3[3]}, o[d0], 0, 0, 0); } while (0)
    PV_D0(0); PV_D0(1); PV_D0(2); PV_D0(3);
#undef PV_D0
#undef TRRD
}
__device__ __forceinline__ void pack_p(const f32x16& p0, const f32x16& p1, bf16x8& pa0, bf16x8& pa1, bf16x8& pa2, bf16x8& pa3) {
#define PK4(P, B_, OUT) do { unsigned a0 = cvt_pk_bf16(P[B_+0], P[B_+1]), a1 = cvt_pk_bf16(P[B_+2], P[B_+3]);                          \
        unsigned b0 = cvt_pk_bf16(P[B_+4], P[B_+5]), b1 = cvt_pk_bf16(P[B_+6], P[B_+7]);                                             \
        auto r0 = __builtin_amdgcn_permlane32_swap(a0, b0, false, false); auto r1 = __builtin_amdgcn_permlane32_swap(a1, b1, false, false); \
        u32x4 w = {r0[0], r1[0], r0[1], r1[1]}; OUT = *reinterpret_cast<bf16x8*>(&w); } while (0)
    PK4(p0, 0, pa0); PK4(p0, 8, pa1); PK4(p1, 0, pa2); PK4(p1, 8, pa3);
#undef PK4
}
__device__ __forceinline__ float lane_pair_sum(float v) {
    auto rr = __builtin_amdgcn_permlane32_swap(__float_as_uint(v), __float_as_uint(v), false, false);
    return __uint_as_float(rr[0]) + __uint_as_float(rr[1]);
}
__device__ __forceinline__ float lane_pair_max(float v) {
    auto rr = __builtin_amdgcn_permlane32_swap(__float_as_uint(v), __float_as_uint(v), false, false);
    return fmaxf(__uint_as_float(rr[0]), __uint_as_float(rr[1]));
}

#ifndef SB_EXIT_L2
#define SB_EXIT_L2 48.0f
#endif

template <int MODE>
__device__ __forceinline__ void attn_unit(const bf16* __restrict__ qkv, bf16* __restrict__ O, const float* __restrict__ kmean, int b, int h, int qb, LAS unsigned char* ldsl, LAS unsigned char* lepi, int wid) {
    const int lane = (int)__builtin_amdgcn_mbcnt_hi(~0u, __builtin_amdgcn_mbcnt_lo(~0u, 0u)), tid = wid * 64 + lane, r32 = lane & 31, hi = lane >> 5;
    const size_t rowbase = (size_t)b * SEQ;
    const bf16* Qp = qkv + (MODE == 0 ? 0 : 3 * 1024) + h * HD;
    const bf16* Kp = Qp + 1024 + rowbase * PITCH; const bf16* Vp = Qp + 2048 + rowbase * PITCH;
    LAS const unsigned char* K_lds = ldsl + 2 * SHM_V;
    LAS float* ws = (LAS float*)(lepi + EPI_WS) + wid * 64; LAS float* li_l = ws; LAS float* al_l = ws + 32;
    volatile LAS int* flags = (volatile LAS int*)(lepi + EPI_FLAG);
    LAS unsigned char* q_lds = ldsl + LDS_Q + wid * 8192 + lane * 16;
    const int qlo = qb * 256 + wid * 32, qpos = qlo + r32;
#pragma unroll
    for (int d0 = 0; d0 < 8; ++d0) *(LAS bf16x8*)(q_lds + d0 * 1024) = *(const bf16x8*)(Qp + (rowbase + qpos) * PITCH + d0 * 16 + hi * 8);
    const int NT = 4 * (qb + 1);
    const int vb0 = (int)(unsigned)(uintptr_t)ldsl + v_rd_base(lane);
    unsigned koff0, koff1, voff0, voff1;
    { const int b0 = tid * 16, b1 = b0 + 8192;
      { const int row = b0 >> 8, cb = b0 & 255, colB = cb ^ ((row & 7) << 4); koff0 = (unsigned)(row * PITCH + (colB >> 1)) * 2u; }
      { const int row = b1 >> 8, cb = b1 & 255, colB = cb ^ ((row & 7) << 4); koff1 = (unsigned)(row * PITCH + (colB >> 1)) * 2u; }
      { const int st = b0 >> 9, wb = b0 & 511, kk = (st >> 2) * 8 + (wb >> 6), c = (st & 3) * 32 + ((wb & 63) >> 1), k = (kk & ~0xC) | ((kk & 4) << 1) | ((kk & 8) >> 1); voff0 = (unsigned)(k * PITCH + c) * 2u; }
      { const int st = b1 >> 9, wb = b1 & 511, kk = (st >> 2) * 8 + (wb >> 6), c = (st & 3) * 32 + ((wb & 63) >> 1), k = (kk & ~0xC) | ((kk & 4) << 1) | ((kk & 8) >> 1); voff1 = (unsigned)(k * PITCH + c) * 2u; } }
    const unsigned ldsw = (unsigned)wid * 1024u;
#define TILE_KB(t) (MODE == 0 ? 64 * (NT - 1 - (t)) : 64 * (t))
#define DMA_TILE(kb_, bf) do { const char* kg_ = (const char*)(Kp + (size_t)(kb_) * PITCH); const char* vg_ = (const char*)(Vp + (size_t)(kb_) * PITCH); \
        __builtin_amdgcn_global_load_lds((const unsigned*)(vg_ + voff0), (LAS unsigned*)(ldsl + (bf) * SHM_V + ldsw), 16, 0, 0); \
        __builtin_amdgcn_global_load_lds((const unsigned*)(vg_ + voff1), (LAS unsigned*)(ldsl + (bf) * SHM_V + ldsw + 8192), 16, 0, 0); \
        __builtin_amdgcn_global_load_lds((const unsigned*)(kg_ + koff0), (LAS unsigned*)(ldsl + 2 * SHM_V + (bf) * SHM_K + ldsw), 16, 0, 0); \
        __builtin_amdgcn_global_load_lds((const unsigned*)(kg_ + koff1), (LAS unsigned*)(ldsl + 2 * SHM_V + (bf) * SHM_K + ldsw + 8192), 16, 0, 0); } while (0)
    DMA_TILE(TILE_KB(0), 0);
    unsigned selmask = 0u;
    if constexpr (MODE == 1) {
        float gate[15]; float m1 = -__builtin_inff(), m2 = m1, m3 = m1;
#pragma unroll
        for (int j = 0; j < 15; ++j) {
            gate[j] = -__builtin_inff();
            if (j < qb) {
                const float* km = kmean + ((size_t)((b * 8 + h) * 16 + j)) * HD + hi * 8;
                float a = 0.f;
#pragma unroll
                for (int d0 = 0; d0 < 8; ++d0) {
                    const f32x4 k0 = *(const f32x4*)(km + d0 * 16), k1 = *(const f32x4*)(km + d0 * 16 + 4);
                    const u32x4 qw = *(LAS const u32x4*)(q_lds + d0 * 1024);
                    a += bflo(qw[0]) * k0[0] + bfhi(qw[0]) * k0[1] + bflo(qw[1]) * k0[2] + bfhi(qw[1]) * k0[3]
                       + bflo(qw[2]) * k1[0] + bfhi(qw[2]) * k1[1] + bflo(qw[3]) * k1[2] + bfhi(qw[3]) * k1[3];
                }
                const float g = lane_pair_sum(a);
                gate[j] = g;
                const float t1 = fminf(m1, g); m1 = fmaxf(m1, g); const float t2 = fminf(m2, t1); m2 = fmaxf(m2, t1); m3 = fmaxf(m3, t2);
            }
        }
#pragma unroll
        for (int j = 0; j < 15; ++j) if (j < qb && gate[j] >= m3) selmask |= (1u << j);
    }
    float m_reg = -1e30f, l_reg = 0.f, cacc = 0.f; f32x16 o[4] = {};
    asm volatile("s_waitcnt vmcnt(0)" ::: "memory");
    __syncthreads();
    bool stop = false;
#define STEP(t, BUF) do { \
        const int kb_ = TILE_KB(t); const bool more_ = ((t) + 1 < NT); \
        if (more_) DMA_TILE(TILE_KB((t) + 1), (BUF) ^ 1); \
        SBAR(); \
        if constexpr (MODE == 1) { \
            const int jb_ = kb_ >> 8; bool act_; bool own_ = (jb_ == qb); const bool sel_ = ((selmask >> jb_) & 1u) != 0u; \
            if (own_) act_ = (kb_ <= qlo + 31); else act_ = __any(sel_); \
            if (act_) { \
                f32x16 p0, p1; qkt<BUF>(p0, p1, K_lds, q_lds, r32, hi); SBAR(); \
                const float NEG = -__builtin_inff(); \
                if (own_) { if (kb_ + 63 > qlo) { const int dq = qpos - kb_ - 4 * hi; \
                        _Pragma("unroll") for (int r = 0; r < 16; ++r) { const int c = (r & 3) + 8 * (r >> 2); if (c > dq) p0[r] = NEG; if (c + 32 > dq) p1[r] = NEG; } } } \
                else if (!sel_) { _Pragma("unroll") for (int r = 0; r < 16; ++r) { p0[r] = NEG; p1[r] = NEG; } } \
                float pmax = p0[0]; _Pragma("unroll") for (int r = 1; r < 16; ++r) pmax = fmaxf(pmax, p0[r]); _Pragma("unroll") for (int r = 0; r < 16; ++r) pmax = fmaxf(pmax, p1[r]); \
                pmax = lane_pair_max(pmax); \
                float mn, alpha; \
                if (__all((pmax - m_reg) * SCALE <= 8.0f)) { mn = m_reg; alpha = 1.f; } \
                else { mn = fmaxf(m_reg, pmax); alpha = __builtin_amdgcn_exp2f((m_reg - mn) * C2); m_reg = mn; } \
                if (__any(alpha < 1.f)) { if (hi == 0) al_l[r32] = alpha; asm volatile("s_waitcnt lgkmcnt(0)" ::: "memory"); \
                    _Pragma("unroll") for (int d_ = 0; d_ < 4; ++d_) _Pragma("unroll") for (int r = 0; r < 16; ++r) o[d_][r] *= al_l[crow(r, hi)]; } \
                const float mnL = -mn * C2; float ps = 0.f; \
                _Pragma("unroll") for (int r = 0; r < 16; ++r) { p0[r] = __builtin_amdgcn_exp2f(fmaf(p0[r], C2, mnL)); p1[r] = __builtin_amdgcn_exp2f(fmaf(p1[r], C2, mnL)); ps += p0[r] + p1[r]; } \
                ps = lane_pair_sum(ps); l_reg = l_reg * alpha + ps; \
                bf16x8 pa0, pa1, pa2, pa3; pack_p(p0, p1, pa0, pa1, pa2, pa3); SBAR(); \
                pv_tile<BUF>(o, vb0, pa0, pa1, pa2, pa3); \
            } \
        } else { \
            const bool act_ = (kb_ < qlo + 31); \
            if (act_) { \
                f32x16 p0, p1; qkt<BUF>(p0, p1, K_lds, q_lds, r32, hi); SBAR(); \
                f32x16 k0, k1; \
                _Pragma("unroll") for (int r = 0; r < 16; ++r) { \
                    { const float z = p0[r] * C2, e = __builtin_amdgcn_exp2f(-fabsf(z)), sp = fmaxf(z, 0.f) + __builtin_amdgcn_logf(1.0f + e); k0[r] = -sp; p0[r] = z - sp; } \
                    { const float z = p1[r] * C2, e = __builtin_amdgcn_exp2f(-fabsf(z)), sp = fmaxf(z, 0.f) + __builtin_amdgcn_logf(1.0f + e); k1[r] = -sp; p1[r] = z - sp; } } \
                if (kb_ + 63 >= qlo) { const int dq = qpos - kb_ - 4 * hi; const float NEG = -__builtin_inff(); \
                    _Pragma("unroll") for (int r = 0; r < 16; ++r) { const int c = (r & 3) + 8 * (r >> 2); if (c >= dq) { p0[r] = NEG; k0[r] = 0.f; } if (c + 32 >= dq) { p1[r] = NEG; k1[r] = 0.f; } } } \
                SBAR(); float run = cacc; \
                _Pragma("unroll") for (int k = 7; k >= 0; --k) { const int g4 = 4 * (k & 3); \
                    const float s_ = (k < 4) ? ((k0[g4] + k0[g4 + 1]) + (k0[g4 + 2] + k0[g4 + 3])) : ((k1[g4] + k1[g4 + 1]) + (k1[g4 + 2] + k1[g4 + 3])); \
                    auto rr = __builtin_amdgcn_permlane32_swap(__float_as_uint(s_), __float_as_uint(s_), false, false); \
                    const float lo_ = __uint_as_float(rr[0]), hi_ = __uint_as_float(rr[1]); const float sg = run + (hi ? 0.f : hi_); \
                    if (k < 4) { const float e3 = sg, e2 = e3 + k0[g4 + 3], e1 = e2 + k0[g4 + 2], e0 = e1 + k0[g4 + 1]; \
                        p0[g4 + 3] = __builtin_amdgcn_exp2f(p0[g4 + 3] + e3); p0[g4 + 2] = __builtin_amdgcn_exp2f(p0[g4 + 2] + e2); p0[g4 + 1] = __builtin_amdgcn_exp2f(p0[g4 + 1] + e1); p0[g4] = __builtin_amdgcn_exp2f(p0[g4] + e0); } \
                    else { const float e3 = sg, e2 = e3 + k1[g4 + 3], e1 = e2 + k1[g4 + 2], e0 = e1 + k1[g4 + 1]; \
                        p1[g4 + 3] = __builtin_amdgcn_exp2f(p1[g4 + 3] + e3); p1[g4 + 2] = __builtin_amdgcn_exp2f(p1[g4 + 2] + e2); p1[g4 + 1] = __builtin_amdgcn_exp2f(p1[g4 + 1] + e1); p1[g4] = __builtin_amdgcn_exp2f(p1[g4] + e0); } \
                    run += lo_ + hi_; } \
                cacc = run; \
                bf16x8 pa0, pa1, pa2, pa3; pack_p(p0, p1, pa0, pa1, pa2, pa3); SBAR(); \
                pv_tile<BUF>(o, vb0, pa0, pa1, pa2, pa3); \
            } \
            if (SB_EXIT_L2 > 0.f) { const bool done_ = __all(cacc < -SB_EXIT_L2); if (lane == 0) flags[((t) & 1) * 8 + wid] = done_ ? 1 : 0; } \
        } \
        asm volatile("s_waitcnt vmcnt(0)" ::: "memory"); \
        __syncthreads(); \
        if (MODE == 0 && SB_EXIT_L2 > 0.f) { int all_ = 1; _Pragma("unroll") for (int w_ = 0; w_ < 8; ++w_) all_ &= flags[((t) & 1) * 8 + w_]; stop = (all_ != 0); } \
    } while (0)
    for (int t = 0; t < NT; t += 2) {
        STEP(t, 0);
        if (stop) break;
        STEP(t + 1, 1);
        if (stop) break;
    }
#undef STEP
#undef DMA_TILE
#undef TILE_KB
    float rli[16];
    if constexpr (MODE == 1) {
        if (hi == 0) li_l[r32] = l_reg; asm volatile("s_waitcnt lgkmcnt(0)" ::: "memory");
#pragma unroll
        for (int r = 0; r < 16; ++r) rli[r] = __builtin_amdgcn_rcpf(li_l[crow(r, hi)]);
    } else {
#pragma unroll
        for (int r = 0; r < 16; ++r) rli[r] = 1.0f;
    }
    int r32o = r32; asm volatile("" : "+v"(r32o));
    bf16* Ow = O + (rowbase + qlo) * DM + (MODE == 0 ? 0 : 1024) + h * HD + r32o;
#pragma unroll
    for (int r = 0; r < 16; ++r) { const int orow = crow(r, hi);
#pragma unroll
        for (int d0 = 0; d0 < 4; ++d0) { const float v = o[d0][r] * rli[r]; const float vn = __shfl_xor(v, 1);
            if ((r32 & 1) == 0) *(unsigned*)(Ow + (size_t)orow * DM + d0 * 32) = cvt_pk_bf16(v, vn); } }
    __syncthreads();
}
#undef KSWZ
}
namespace epi {
using pg8::Unit;
typedef f32x4 Acc[2][2][4][2];
#define NEXT_ROW(roff, m, LD) do { roff += (size_t)((m) == 3 ? 80 : 16) * (LD); asm volatile("" : "+v"(roff) :: "memory"); } while (0)
#define ST_NT(ptr, val) (*(ptr) = (val))
#define EPI_BAR() do { asm volatile("s_waitcnt lgkmcnt(0)" ::: "memory"); __builtin_amdgcn_s_barrier(); asm volatile("" ::: "memory"); } while (0)

template <int NPARTS>
__device__ __forceinline__ void row_rstd_to_lds(LAS float* S, const float* parts, int pm, int tid, int& cpm) {
    if (cpm == pm) return;
    cpm = pm;
    if (tid < 256) { float v[NPARTS];
#pragma unroll
        for (int p = 0; p < NPARTS; ++p) v[p] = parts[(size_t)p * T + pm * 256 + tid];
        float s = v[0];
#pragma unroll
        for (int p = 1; p < NPARTS; ++p) s += v[p];
        S[tid] = 1.0f / sqrtf(s * (1.0f / DM) + EPS); }
    EPI_BAR();
}

struct EpiQKV {
    static constexpr bool PERM = true, ACC_INIT = false;
    bf16* out; const float* ssq0; const float* gains; const float* rope; float* kmean;
    __device__ __forceinline__ void operator()(Acc& acc, const Unit& u, int wr, int wc, int fr, int fq, LAS unsigned char* le, int wid, int lane, int& cpm) const {
        LAS float* S = (LAS float*)le; LAS float* P = (LAS float*)(le + 1024);
        const int tid = wid * 64 + lane, row0 = u.pm * 256;
        row_rstd_to_lds<1>(S, ssq0, u.pm, tid, cpm);
        const int type = u.pn >> 2;
        const bool is_v = (type == 2 || type == 5);
        float rs[2][4];
#pragma unroll
        for (int ai = 0; ai < 2; ++ai)
#pragma unroll
            for (int m = 0; m < 4; ++m) rs[ai][m] = S[ai * 128 + wr * 64 + m * 16 + fr];
#pragma unroll
        for (int ai = 0; ai < 2; ++ai)
#pragma unroll
            for (int bj = 0; bj < 2; ++bj)
#pragma unroll
                for (int m = 0; m < 4; ++m)
#pragma unroll
                    for (int n = 0; n < 2; ++n) acc[ai][bj][m][n] = acc[ai][bj][m][n] * rs[ai][m];
        if (!is_v) {
#pragma unroll
            for (int ai = 0; ai < 2; ++ai)
#pragma unroll
                for (int m = 0; m < 4; ++m)
#pragma unroll
                    for (int bj = 0; bj < 2; ++bj) {
                        const f32x4 a = acc[ai][bj][m][0], b = acc[ai][bj][m][1];
                        float s = (a[0] * a[0] + a[1] * a[1]) + (a[2] * a[2] + a[3] * a[3]) + (b[0] * b[0] + b[1] * b[1]) + (b[2] * b[2] + b[3] * b[3]);
                        s += __shfl_xor(s, 16); s += __shfl_xor(s, 32);
                        if (fq == 0) P[((ai * 128 + wr * 64 + m * 16 + fr) * 2 + bj) * 4 + wc] = s;
                    }
            EPI_BAR();
            const float* gn = gains + ((type == 0) ? 0 : (type == 1) ? 128 : (type == 3) ? 256 : 384) + wc * 32 + fq * 8;
            const f32x4 g0 = *(const f32x4*)gn, g1 = *(const f32x4*)(gn + 4);
#pragma unroll
            for (int ai = 0; ai < 2; ++ai)
#pragma unroll
                for (int m = 0; m < 4; ++m)
#pragma unroll
                    for (int bj = 0; bj < 2; ++bj) {
                        const f32x4 pp = *(const LAS f32x4*)(P + ((ai * 128 + wr * 64 + m * 16 + fr) * 2 + bj) * 4);
                        const float rn = 1.0f / sqrtf(((pp[0] + pp[1]) + (pp[2] + pp[3])) * (1.0f / HD) + EPS);
                        acc[ai][bj][m][0] = acc[ai][bj][m][0] * rn * g0; acc[ai][bj][m][1] = acc[ai][bj][m][1] * rn * g1;
                    }
            if (type >= 3 && wc == 0) {
#pragma unroll
                for (int ai = 0; ai < 2; ++ai)
#pragma unroll
                    for (int m = 0; m < 4; ++m) {
                        const int pos = (row0 + ai * 128 + wr * 64 + m * 16 + fr) & (SEQ - 1);
                        const float* cp = rope + (size_t)pos * 16 + (fq & 1) * 8;
                        const f32x4 c0 = *(const f32x4*)cp, c1 = *(const f32x4*)(cp + 4), s0 = *(const f32x4*)(cp + SEQ * 16), s1 = *(const f32x4*)(cp + SEQ * 16 + 4);
#pragma unroll
                        for (int bj = 0; bj < 2; ++bj) {
                            f32x4 a = acc[ai][bj][m][0], b = acc[ai][bj][m][1], oa, ob;
#pragma unroll
                            for (int j = 0; j < 4; ++j) { oa[j] = __shfl_xor(a[j], 32); ob[j] = __shfl_xor(b[j], 32); }
                            if (fq < 2) { a = a * c0 - oa * s0; b = b * c1 - ob * s1; } else { a = a * c0 + oa * s0; b = b * c1 + ob * s1; }
                            acc[ai][bj][m][0] = a; acc[ai][bj][m][1] = b;
                        }
                    }
            }
        }
        if (type == 4) {
            float cs[2][2][4];
#pragma unroll
            for (int bj = 0; bj < 2; ++bj)
#pragma unroll
                for (int n = 0; n < 2; ++n)
#pragma unroll
                    for (int j = 0; j < 4; ++j) { float s = 0.f;
#pragma unroll
                        for (int ai = 0; ai < 2; ++ai)
#pragma unroll
                            for (int m = 0; m < 4; ++m) s += acc[ai][bj][m][n][j];
                        s += __shfl_xor(s, 1); s += __shfl_xor(s, 2); s += __shfl_xor(s, 4); s += __shfl_xor(s, 8);
                        cs[bj][n][j] = s; }
            LAS float* KM = P;
            EPI_BAR();
            if (wr == 1 && fr == 0) {
#pragma unroll
                for (int bj = 0; bj < 2; ++bj)
#pragma unroll
                    for (int n = 0; n < 2; ++n) *(LAS f32x4*)(KM + ((wc * 4 + fq) * 16 + bj * 8 + n * 4)) = (f32x4){cs[bj][n][0], cs[bj][n][1], cs[bj][n][2], cs[bj][n][3]}; }
            EPI_BAR();
            if (wr == 0 && fr == 0) { const int b = u.pm >> 4, blk = u.pm & 15;
#pragma unroll
                for (int bj = 0; bj < 2; ++bj) { const int h = 2 * (u.pn - 16) + bj; float* kp = kmean + ((size_t)((b * 8 + h) * 16 + blk)) * HD + wc * 32 + fq * 8;
#pragma unroll
                    for (int n = 0; n < 2; ++n) { const f32x4 o = *(const LAS f32x4*)(KM + ((wc * 4 + fq) * 16 + bj * 8 + n * 4));
                        *(f32x4*)(kp + n * 4) = (f32x4){(cs[bj][n][0] + o[0]) * (1.0f / 256.0f), (cs[bj][n][1] + o[1]) * (1.0f / 256.0f), (cs[bj][n][2] + o[2]) * (1.0f / 256.0f), (cs[bj][n][3] + o[3]) * (1.0f / 256.0f)}; } } }
        }
        size_t roff = (size_t)(row0 + wr * 64 + fr) * NQKV + u.pn * 256 + wc * 32 + fq * 8;
#pragma unroll
        for (int ai = 0; ai < 2; ++ai)
#pragma unroll
            for (int m = 0; m < 4; ++m) { bf16* rowp = out + roff;
#pragma unroll
                for (int bj = 0; bj < 2; ++bj) { const f32x4 v0 = acc[ai][bj][m][0], v1 = acc[ai][bj][m][1];
                    u32x4 w; w.x = cvt_pk_bf16(v0[0], v0[1]); w.y = cvt_pk_bf16(v0[2], v0[3]); w.z = cvt_pk_bf16(v1[0], v1[1]); w.w = cvt_pk_bf16(v1[2], v1[3]);
                    ST_NT((u32x4*)(rowp + bj * 128), w); }
                NEXT_ROW(roff, m, NQKV); }
    }
};

template <bool NEXT, bool F8 = false> struct EpiResid {
    static constexpr bool PERM = false, ACC_INIT = true;
    const bf16* base; float* out; bf16* outb; float* ssq_part;
    __device__ __forceinline__ void init(Acc& acc, const Unit& u, int wr, int wc, int fr, int fq) const {
        const bf16* bp = base + (size_t)(u.pm * 256 + wr * 64 + fr) * DM + u.pn * 256 + wc * 32 + fq * 4;
#pragma unroll
        for (int ai = 0; ai < 2; ++ai)
#pragma unroll
            for (int m = 0; m < 4; ++m)
#pragma unroll
                for (int bj = 0; bj < 2; ++bj)
#pragma unroll
                    for (int n = 0; n < 2; ++n) { const u32x2 w = *(const u32x2*)(bp + (size_t)(ai * 128 + m * 16) * DM + bj * 128 + n * 16); acc[ai][bj][m][n] = (f32x4){bflo(w.x), bfhi(w.x), bflo(w.y), bfhi(w.y)}; if constexpr (F8) acc[ai][bj][m][n] = acc[ai][bj][m][n] * 4096.0f; }
    }
    __device__ __forceinline__ void operator()(Acc& acc, const Unit& u, int wr, int wc, int fr, int fq, LAS unsigned char* le, int wid, int lane, int& cpm) const {
        LAS float* P = (LAS float*)le;
        const int tid = wid * 64 + lane, row0 = u.pm * 256, col0 = u.pn * 256 + wc * 32 + fq * 4;
        size_t roff = (size_t)(row0 + wr * 64 + fr) * DM + col0;
#pragma unroll
        for (int ai = 0; ai < 2; ++ai)
#pragma unroll
            for (int m = 0; m < 4; ++m) { const int rt = ai * 128 + wr * 64 + m * 16 + fr; const size_t off = roff; float s = 0.f;
#pragma unroll
                for (int bj = 0; bj < 2; ++bj)
#pragma unroll
                    for (int n = 0; n < 2; ++n) { f32x4 v = acc[ai][bj][m][n]; if constexpr (F8) v = v * (1.0f / 4096.0f);
                        if constexpr (NEXT) { u32x2 w; w.x = cvt_pk_bf16(v[0], v[1]); w.y = cvt_pk_bf16(v[2], v[3]); *(u32x2*)(outb + off + bj * 128 + n * 16) = w;
                            const float r0 = bflo(w.x), r1 = bfhi(w.x), r2 = bflo(w.y), r3 = bfhi(w.y); s += (r0 * r0 + r1 * r1) + (r2 * r2 + r3 * r3); }
                        else { u32x2 w; w.x = cvt_pk_bf16(v[0], v[1]); w.y = cvt_pk_bf16(v[2], v[3]); *(u32x2*)(outb + off + bj * 128 + n * 16) = w; } }
                if constexpr (NEXT) { s += __shfl_xor(s, 16); s += __shfl_xor(s, 32); if (fq == 0) P[rt * 4 + wc] = s; }
                NEXT_ROW(roff, m, DM); }
        if constexpr (NEXT) { EPI_BAR();
        if (tid < 256) { const f32x4 pp = *(const LAS f32x4*)(P + tid * 4); ssq_part[(size_t)u.pn * T + row0 + tid] = (pp[0] + pp[1]) + (pp[2] + pp[3]); } }
    }
};

template <bool MOE> struct EpiSwiGLU {
    static constexpr bool PERM = true, ACC_INIT = false;
    bf16* out; const float* parts; int nparts; const float* slot_rstd;
    __device__ __forceinline__ void operator()(Acc& acc, const Unit& u, int wr, int wc, int fr, int fq, LAS unsigned char* le, int wid, int lane, int& cpm) const {
        LAS float* S = (LAS float*)le; const int tid = wid * 64 + lane, row0 = u.pm * 256;
        if constexpr (MOE) { if (cpm != u.pm) { cpm = u.pm; if (tid < 256) S[tid] = slot_rstd[row0 + tid]; EPI_BAR(); } }
        else row_rstd_to_lds<8>(S, parts, u.pm, tid, cpm);
        size_t roff = (size_t)(row0 + wr * 64 + fr) * DFF + u.pn * 128 + wc * 32 + fq * 8;
#pragma unroll
        for (int ai = 0; ai < 2; ++ai)
#pragma unroll
            for (int m = 0; m < 4; ++m) { const int rt = ai * 128 + wr * 64 + m * 16 + fr; const float rs = S[rt];
                const f32x4 ga = acc[ai][0][m][0] * rs, gb = acc[ai][0][m][1] * rs, ua = acc[ai][1][m][0] * rs, ub = acc[ai][1][m][1] * rs; f32x4 ha, hb;
#pragma unroll
                for (int j = 0; j < 4; ++j) { ha[j] = ga[j] * fast_sigmoid(ga[j]) * ua[j]; hb[j] = gb[j] * fast_sigmoid(gb[j]) * ub[j]; }
                u32x4 w; w.x = cvt_pk_bf16(ha[0], ha[1]); w.y = cvt_pk_bf16(ha[2], ha[3]); w.z = cvt_pk_bf16(hb[0], hb[1]); w.w = cvt_pk_bf16(hb[2], hb[3]);
                ST_NT((u32x4*)(out + roff), w);
                NEXT_ROW(roff, m, DFF); }
    }
};

__device__ __forceinline__ unsigned pk4_fp8(float a, float b, float c, float d) {
    a = __builtin_amdgcn_fmed3f(a, -448.f, 448.f); b = __builtin_amdgcn_fmed3f(b, -448.f, 448.f); c = __builtin_amdgcn_fmed3f(c, -448.f, 448.f); d = __builtin_amdgcn_fmed3f(d, -448.f, 448.f);
    unsigned w = 0u; w = __builtin_amdgcn_cvt_pk_fp8_f32(a, b, w, false); w = __builtin_amdgcn_cvt_pk_fp8_f32(c, d, w, true); return w;
}
constexpr float W_UP_SCALE = 256.f, W_DN_SCALE = 512.f, H_SCALE = 8.f, Y_SCALE = 16.f;
struct EpiSwiGLUFp8 {
    static constexpr bool PERM = true, ACC_INIT = false;
    unsigned char* out; const float* slot_rstd;
    __device__ __forceinline__ void operator()(Acc& acc, const Unit& u, int wr, int wc, int fr, int fq, LAS unsigned char* le, int wid, int lane, int& cpm) const {
        LAS float* S = (LAS float*)le; const int tid = wid * 64 + lane, row0 = u.pm * 256;
        if (cpm != u.pm) { cpm = u.pm; if (tid < 256) S[tid] = slot_rstd[row0 + tid] * (1.0f / W_UP_SCALE); EPI_BAR(); }
        size_t roff = (size_t)(row0 + wr * 64 + fr) * DFF + u.pn * 128 + wc * 32 + fq * 8;
#pragma unroll
        for (int ai = 0; ai < 2; ++ai)
#pragma unroll
            for (int m = 0; m < 4; ++m) { const int rt = ai * 128 + wr * 64 + m * 16 + fr; const float rs = S[rt];
                const float rl = rs * -1.4426950408889634f, kk = rs * rs * H_SCALE; f32x4 ha, hb;
#pragma unroll
                for (int j = 0; j < 4; ++j) { const float g0 = acc[ai][0][m][0][j], g1 = acc[ai][0][m][1][j];
                    ha[j] = (g0 * acc[ai][1][m][0][j]) * kk * __builtin_amdgcn_rcpf(1.0f + __builtin_amdgcn_exp2f(g0 * rl));
                    hb[j] = (g1 * acc[ai][1][m][1][j]) * kk * __builtin_amdgcn_rcpf(1.0f + __builtin_amdgcn_exp2f(g1 * rl)); }
                u32x2 w; w.x = pk4_fp8(ha[0], ha[1], ha[2], ha[3]); w.y = pk4_fp8(hb[0], hb[1], hb[2], hb[3]);
                ST_NT((u32x2*)(out + roff), w);
                NEXT_ROW(roff, m, DFF); }
    }
};

struct EpiRecIn {
    static constexpr bool PERM = true, ACC_INIT = false;
    bf16* xbr; bf16* gg; const float* parts;
    __device__ __forceinline__ void operator()(Acc& acc, const Unit& u, int wr, int wc, int fr, int fq, LAS unsigned char* le, int wid, int lane, int& cpm) const {
        LAS float* S = (LAS float*)le; const int tid = wid * 64 + lane, row0 = u.pm * 256;
        row_rstd_to_lds<8>(S, parts, u.pm, tid, cpm);
        const bool is_gate = u.pn >= 8; bf16* dst = is_gate ? gg : xbr; const int colt = (u.pn & 7) * 256 + wc * 32 + fq * 8;
        size_t roff = (size_t)(row0 + wr * 64 + fr) * DM + colt;
#pragma unroll
        for (int ai = 0; ai < 2; ++ai)
#pragma unroll
            for (int m = 0; m < 4; ++m) { const int rt = ai * 128 + wr * 64 + m * 16 + fr; const float rs = S[rt];
#pragma unroll
                for (int bj = 0; bj < 2; ++bj) { f32x4 v0 = acc[ai][bj][m][0] * rs, v1 = acc[ai][bj][m][1] * rs;
                    if (is_gate) {
#pragma unroll
                        for (int j = 0; j < 4; ++j) { { const float x = v0[j]; v0[j] = x * fast_sigmoid(1.5957691216057308f * (x + 0.044715f * x * x * x)); }
                                                      { const float x = v1[j]; v1[j] = x * fast_sigmoid(1.5957691216057308f * (x + 0.044715f * x * x * x)); } } }
                    u32x4 w; w.x = cvt_pk_bf16(v0[0], v0[1]); w.y = cvt_pk_bf16(v0[2], v0[3]); w.z = cvt_pk_bf16(v1[0], v1[1]); w.w = cvt_pk_bf16(v1[2], v1[3]);
                    ST_NT((u32x4*)(dst + roff + bj * 128), w); }
                NEXT_ROW(roff, m, DM); }
    }
};

#define DPP_SHR(x, ctrl) __builtin_bit_cast(float, __builtin_amdgcn_update_dpp(0, __builtin_bit_cast(int, (x)), (ctrl), 0xf, 0xf, true))
struct EpiGates {
    static constexpr bool PERM = false, ACC_INIT = false, APERM = true;
    const bf16* xc; const float* b_a; const float* b_i; const float* spl; unsigned* au; float* scanA; float* scanH;
    __device__ __forceinline__ void operator()(Acc& acc, const Unit& u, int wr, int wc, int fr, int fq, LAS unsigned char* le, int, int, int&) const {
        const int row0 = u.pm * 256, ch0 = (u.pn >> 1) * 256 + (u.pn & 1) * 128 + wc * 32 + fq * 4;
        size_t roff = (size_t)(row0 + wr * 64 + 4 * fr) * DM + ch0;
        LAS float* X = (LAS float*)le;
        u32x2 xpre[2][4][2];
#pragma unroll
        for (int ai = 0; ai < 2; ++ai)
#pragma unroll
            for (int m = 0; m < 4; ++m)
#pragma unroll
                for (int n = 0; n < 2; ++n) xpre[ai][m][n] = *(const u32x2*)(xc + roff + (size_t)(ai * 128 + m) * DM + n * 16);
        float RA[2][2][4], RH[2][2][4];
#pragma unroll
        for (int ai = 0; ai < 2; ++ai) {
#pragma unroll
            for (int m = 0; m < 4; ++m) {
#pragma unroll
                for (int n = 0; n < 2; ++n) { const size_t off = roff + n * 16;
                    const f32x4 ba = *(const f32x4*)(b_a + ch0 + n * 16), bi = *(const f32x4*)(b_i + ch0 + n * 16), sl = *(const f32x4*)(spl + ch0 + n * 16);
                    const u32x2 xw = xpre[ai][m][n]; const float xv[4] = {bflo(xw.x), bfhi(xw.x), bflo(xw.y), bfhi(xw.y)};
                    const f32x4 ra = acc[ai][0][m][n] + ba, ri = acc[ai][1][m][n] + bi; u32x4 pk;
#pragma unroll
                    for (int j = 0; j < 4; ++j) { const float r = fast_sigmoid(ra[j]), ig = fast_sigmoid(ri[j]);
                        const float la = bflo(cvt_pk_bf16(-8.0f * r * sl[j], 0.f));
                        const float a = fast_exp(la); const float x2 = 2.0f * la;
                        const float ser = -x2 * (1.0f + x2 * (0.5f + x2 * (1.0f / 6.0f + x2 * (1.0f / 24.0f + x2 * (1.0f / 120.0f)))));
                        const float om = (x2 > -0.3f) ? ser : (1.0f - a * a);
                        const unsigned w = cvt_pk_bf16(la, __builtin_amdgcn_sqrtf(om) * (ig * xv[j])); pk[j] = w;
                        const float uu = bfhi(w);
                        if (m == 0) { RA[ai][n][j] = a; RH[ai][n][j] = uu; } else { RH[ai][n][j] = a * RH[ai][n][j] + uu; RA[ai][n][j] = RA[ai][n][j] * a; } }
                    ST_NT((u32x4*)(au + off), pk); }
                roff += (size_t)(m == 3 ? 125 : 1) * DM; asm volatile("" : "+v"(roff) :: "memory"); }
#pragma unroll
            for (int n = 0; n < 2; ++n)
#pragma unroll
                for (int j = 0; j < 4; ++j) { float A = RA[ai][n][j], H = RH[ai][n][j];
                    { const float Ap = DPP_SHR(A, 0x111), Hp = DPP_SHR(H, 0x111); H = A * Hp + H; A = Ap * A; }
                    { const float Ap = DPP_SHR(A, 0x112), Hp = DPP_SHR(H, 0x112); H = A * Hp + H; A = Ap * A; }
                    { const float Ap = DPP_SHR(A, 0x114), Hp = DPP_SHR(H, 0x114); H = A * Hp + H; A = Ap * A; }
                    { const float Ap = DPP_SHR(A, 0x118), Hp = DPP_SHR(H, 0x118); H = A * Hp + H; A = Ap * A; }
                    RA[ai][n][j] = A; RH[ai][n][j] = H; }
            if (wr == 1 && fr == 15) {
#pragma unroll
                for (int n = 0; n < 2; ++n)
#pragma unroll
                    for (int j = 0; j < 4; ++j) { LAS float* xp = X + ((((ai * 4 + wc) * 4 + fq) * 2 + n) * 4 + j) * 2; xp[0] = RA[ai][n][j]; xp[1] = RH[ai][n][j]; } }
        }
        EPI_BAR();
        if (wr == 0 && fr == 15) { const int b = u.pm >> 4, c2 = (u.pm & 15) * 2;
#pragma unroll
            for (int ai = 0; ai < 2; ++ai)
#pragma unroll
                for (int n = 0; n < 2; ++n) { f32x4 oa, oh;
#pragma unroll
                    for (int j = 0; j < 4; ++j) { const LAS float* xp = X + ((((ai * 4 + wc) * 4 + fq) * 2 + n) * 4 + j) * 2; const float A2 = xp[0], H2 = xp[1];
                        oa[j] = RA[ai][n][j] * A2; oh[j] = A2 * RH[ai][n][j] + H2; }
                    const size_t o = (size_t)(b * 32 + c2 + ai) * DM + ch0 + n * 16; *(f32x4*)(scanA + o) = oa; *(f32x4*)(scanH + o) = oh; } }
    }
};
#define DPP_SHR_ID(x, idv, ctrl) __builtin_bit_cast(float, __builtin_amdgcn_update_dpp(__builtin_bit_cast(int, (float)(idv)), __builtin_bit_cast(int, (x)), (ctrl), 0xf, 0xf, false))
struct EpiGatesScan {
    static constexpr bool PERM = false, ACC_INIT = false, APERM = true;
    const bf16* xc; const float* b_a; const float* b_i; const float* spl; const bf16* gg; bf16* yb; float* agg; unsigned* flags;
    __device__ __forceinline__ void operator()(Acc& acc, const Unit& u, int wr, int wc, int fr_, int fq_, LAS unsigned char* le, int wid, int lane, int&) const {
        asm volatile("" : "+v"(lane));
        const int fr = lane & 15, fq = lane >> 4;
        const int row0 = u.pm * 256, chb = (u.pn >> 1) * 256 + (u.pn & 1) * 128, ch0 = chb + wc * 32 + fq * 4, tid = wid * 64 + lane;
        size_t roff = (size_t)(row0 + wr * 64 + 4 * fr) * DM + ch0;
        LAS float* X = (LAS float*)le;
        LAS float* C0 = X + 1024;
        u32x2 xpre[2][4][2];
#pragma unroll
        for (int ai = 0; ai < 2; ++ai)
#pragma unroll
            for (int m = 0; m < 4; ++m)
#pragma unroll
                for (int n = 0; n < 2; ++n) xpre[ai][m][n] = *(const u32x2*)(xc + roff + (size_t)(ai * 128 + m) * DM + n * 16);
        float EA[2][2][4], EH[2][2][4];
#pragma unroll
        for (int ai = 0; ai < 2; ++ai) {
#pragma unroll
            for (int m = 0; m < 4; ++m) {
#pragma unroll
                for (int n = 0; n < 2; ++n) {
                    const f32x4 ba = *(const f32x4*)(b_a + ch0 + n * 16), bi = *(const f32x4*)(b_i + ch0 + n * 16), sl = *(const f32x4*)(spl + ch0 + n * 16);
                    const u32x2 xw = xpre[ai][m][n]; const float xv[4] = {bflo(xw.x), bfhi(xw.x), bflo(xw.y), bfhi(xw.y)};
                    const f32x4 ra = acc[ai][0][m][n] + ba, ri = acc[ai][1][m][n] + bi;
#pragma unroll
                    for (int j = 0; j < 4; ++j) { const float r = fast_sigmoid(ra[j]), ig = fast_sigmoid(ri[j]);
                        const float la = -8.0f * r * sl[j];
                        const float a = fast_exp(la); const float x2 = 2.0f * la;
                        const float ser = -x2 * (1.0f + x2 * (0.5f + x2 * (1.0f / 6.0f + x2 * (1.0f / 24.0f + x2 * (1.0f / 120.0f)))));
                        const float om = (x2 > -0.3f) ? ser : (1.0f - a * a);
                        const float uu = __builtin_amdgcn_sqrtf(om) * (ig * xv[j]);
                        if (m == 0) { acc[ai][0][m][n][j] = a; acc[ai][1][m][n][j] = uu; }
                        else { acc[ai][1][m][n][j] = a * acc[ai][1][m - 1][n][j] + uu; acc[ai][0][m][n][j] = acc[ai][0][m - 1][n][j] * a; } } } }
#pragma unroll
            for (int n = 0; n < 2; ++n)
#pragma unroll
                for (int j = 0; j < 4; ++j) { float A = acc[ai][0][3][n][j], H = acc[ai][1][3][n][j];
                    { const float Ap = DPP_SHR_ID(A, 1.0f, 0x111), Hp = DPP_SHR_ID(H, 0.0f, 0x111); H = A * Hp + H; A = Ap * A; }
                    { const float Ap = DPP_SHR_ID(A, 1.0f, 0x112), Hp = DPP_SHR_ID(H, 0.0f, 0x112); H = A * Hp + H; A = Ap * A; }
                    { const float Ap = DPP_SHR_ID(A, 1.0f, 0x114), Hp = DPP_SHR_ID(H, 0.0f, 0x114); H = A * Hp + H; A = Ap * A; }
                    { const float Ap = DPP_SHR_ID(A, 1.0f, 0x118), Hp = DPP_SHR_ID(H, 0.0f, 0x118); H = A * Hp + H; A = Ap * A; }
                    EA[ai][n][j] = DPP_SHR_ID(A, 1.0f, 0x111); EH[ai][n][j] = DPP_SHR_ID(H, 0.0f, 0x111);
                    if (fr == 15) { LAS float* xp = X + (((ai * 2 + wr) * 128) + wc * 32 + n * 16 + fq * 4 + j) * 2; xp[0] = A; xp[1] = H; } }
        }
        u32x2 gpre[2][4][2];
#pragma unroll
        for (int m = 0; m < 4; ++m)
#pragma unroll
            for (int n = 0; n < 2; ++n) gpre[0][m][n] = *(const u32x2*)(gg + roff + (size_t)m * DM + n * 16);
        EPI_BAR();
        if (tid < 128) { float TA = 1.f, TH = 0.f;
#pragma unroll
            for (int blk = 0; blk < 4; ++blk) { const f32x2 ah = *(const LAS f32x2*)(X + (blk * 128 + tid) * 2); TH = ah.x * TH + ah.y; TA = TA * ah.x; }
            __hip_atomic_store((unsigned long long*)(agg + ((size_t)u.pm * DM + chb + tid) * 2), __builtin_bit_cast(unsigned long long, (f32x2){TA, TH}), __ATOMIC_RELAXED, __HIP_MEMORY_SCOPE_AGENT);
            asm volatile("s_waitcnt vmcnt(0)" ::: "memory"); }
        EPI_BAR();
        if (tid == 0) __hip_atomic_store(flags + u.pm * 16 + u.pn, 1u, __ATOMIC_RELAXED, __HIP_MEMORY_SCOPE_AGENT);
        if (tid < 128) { const int pm0 = u.pm & ~15, np = u.pm & 15; float h0 = 0.f;
            { const int q = lane & 15; unsigned sp = 0;
                for (;;) { const unsigned f = (q < np) ? __hip_atomic_load(flags + (pm0 + q) * 16 + u.pn, __ATOMIC_RELAXED, __HIP_MEMORY_SCOPE_AGENT) : 1u;
                    if (__builtin_amdgcn_ballot_w64(f == 0u) == 0ull) break;
                    __builtin_amdgcn_s_sleep(1); if (++sp > (1u << 14)) break; } }
            asm volatile("" ::: "memory");
            f32x2 ahs[15];
#pragma unroll
            for (int q = 0; q < 15; ++q) { const int qq = q < np ? q : 0;
                ahs[q] = __builtin_bit_cast(f32x2, __hip_atomic_load((unsigned long long*)(agg + ((size_t)(pm0 + qq) * DM + chb + tid) * 2), __ATOMIC_RELAXED, __HIP_MEMORY_SCOPE_AGENT)); }
#pragma unroll
            for (int q = 0; q < 15; ++q) if (q < np) h0 = ahs[q].x * h0 + ahs[q].y;
            C0[tid] = h0; }
        EPI_BAR();
#pragma unroll
        for (int ai = 0; ai < 2; ++ai) { float cl[2][4];
            if (ai == 0) {
#pragma unroll
                for (int m = 0; m < 4; ++m)
#pragma unroll
                    for (int n = 0; n < 2; ++n) gpre[1][m][n] = *(const u32x2*)(gg + roff + (size_t)(128 + m) * DM + n * 16); }
#pragma unroll
            for (int n = 0; n < 2; ++n)
#pragma unroll
                for (int j = 0; j < 4; ++j) { const int c = wc * 32 + n * 16 + fq * 4 + j; float s = C0[c];
                    if (ai == 1) { const f32x2 b0 = *(const LAS f32x2*)(X + (0 * 128 + c) * 2), b1 = *(const LAS f32x2*)(X + (1 * 128 + c) * 2); s = b0.x * s + b0.y; s = b1.x * s + b1.y; }
                    if (wr == 1) { const f32x2 b2 = *(const LAS f32x2*)(X + ((ai * 2) * 128 + c) * 2); s = b2.x * s + b2.y; }
                    cl[n][j] = EA[ai][n][j] * s + EH[ai][n][j]; }
#pragma unroll
            for (int m = 0; m < 4; ++m) {
#pragma unroll
                for (int n = 0; n < 2; ++n) { const u32x2 gw = gpre[ai][m][n]; const float gv[4] = {bflo(gw.x), bfhi(gw.x), bflo(gw.y), bfhi(gw.y)}; float y[4];
#pragma unroll
                    for (int j = 0; j < 4; ++j) y[j] = (acc[ai][0][m][n][j] * cl[n][j] + acc[ai][1][m][n][j]) * gv[j];
                    u32x2 w; w.x = cvt_pk_bf16(y[0], y[1]); w.y = cvt_pk_bf16(y[2], y[3]);
                    *(u32x2*)(yb + roff + n * 16) = w; }
                roff += (size_t)(m == 3 ? 125 : 1) * DM; asm volatile("" : "+v"(roff) :: "memory"); } }
    }
};

struct EpiSwiGLUDenseF8 {
    static constexpr bool PERM = true, ACC_INIT = false;
    unsigned char* out; const float* parts;
    __device__ __forceinline__ void operator()(Acc& acc, const Unit& u, int wr, int wc, int fr, int fq, LAS unsigned char* le, int wid, int lane, int& cpm) const {
        LAS float* S = (LAS float*)le; const int tid = wid * 64 + lane, row0 = u.pm * 256;
        row_rstd_to_lds<8>(S, parts, u.pm, tid, cpm);
        size_t roff = (size_t)(row0 + wr * 64 + fr) * DFF + u.pn * 128 + wc * 32 + fq * 8;
#pragma unroll
        for (int ai = 0; ai < 2; ++ai)
#pragma unroll
            for (int m = 0; m < 4; ++m) { const int rt = ai * 128 + wr * 64 + m * 16 + fr; const float rs = S[rt];
                const float rl = rs * -1.4426950408889634f, kk = rs * rs * H_SCALE; f32x4 ha, hb;
#pragma unroll
                for (int j = 0; j < 4; ++j) { const float g0 = acc[ai][0][m][0][j], g1 = acc[ai][0][m][1][j];
                    ha[j] = (g0 * acc[ai][1][m][0][j]) * kk * __builtin_amdgcn_rcpf(1.0f + __builtin_amdgcn_exp2f(g0 * rl));
                    hb[j] = (g1 * acc[ai][1][m][1][j]) * kk * __builtin_amdgcn_rcpf(1.0f + __builtin_amdgcn_exp2f(g1 * rl)); }
                u32x2 w; w.x = pk4_fp8(ha[0], ha[1], ha[2], ha[3]); w.y = pk4_fp8(hb[0], hb[1], hb[2], hb[3]);
                ST_NT((u32x2*)(out + roff), w);
                NEXT_ROW(roff, m, DFF); }
    }
};
struct EpiMoeDown {
    static constexpr bool PERM = true, ACC_INIT = false;
    unsigned char* y; float oscale;
    __device__ __forceinline__ void operator()(Acc& acc, const Unit& u, int wr, int wc, int fr, int fq, LAS unsigned char*, int, int, int&) const {
        size_t roff = (size_t)(u.pm * 256 + wr * 64 + fr) * DM + u.pn * 256 + wc * 32 + fq * 8;
#pragma unroll
        for (int ai = 0; ai < 2; ++ai)
#pragma unroll
            for (int m = 0; m < 4; ++m) {
#pragma unroll
                for (int bj = 0; bj < 2; ++bj) { const f32x4 v0 = acc[ai][bj][m][0] * oscale, v1 = acc[ai][bj][m][1] * oscale;
                    u32x2 w; w.x = pk4_fp8(v0[0], v0[1], v0[2], v0[3]); w.y = pk4_fp8(v1[0], v1[1], v1[2], v1[3]);
                    *(u32x2*)(y + roff + bj * 128) = w; }
                NEXT_ROW(roff, m, DM); }
    }
};
struct EpiMoeDownTail {
    static constexpr bool PERM = true, ACC_INIT = false;
    unsigned char* y; float oscale; float* part; unsigned* flg;
    __device__ __forceinline__ void operator()(Acc& acc, const Unit& u, int wr, int wc, int fr, int fq, LAS unsigned char*, int wid, int lane, int&) const {
        const int tid = wid * 64 + lane;
        if (u.ks < 3) { float* p = part + (size_t)(u.ti * 3 + u.ks) * (32 * 512 * 4) + tid * 4;
#pragma unroll
            for (int ai = 0; ai < 2; ++ai)
#pragma unroll
                for (int bj = 0; bj < 2; ++bj)
#pragma unroll
                    for (int m = 0; m < 4; ++m)
#pragma unroll
                        for (int n = 0; n < 2; ++n) *(f32x4*)(p + (size_t)(((ai * 2 + bj) * 4 + m) * 2 + n) * (512 * 4)) = acc[ai][bj][m][n];
            asm volatile("s_waitcnt vmcnt(0)" ::: "memory");
            EPI_BAR();
            if (tid == 0) __hip_atomic_fetch_add(flg + u.ti, 1u, __ATOMIC_RELAXED, __HIP_MEMORY_SCOPE_AGENT);
            return; }
        if (tid == 0) { unsigned sp = 0; while (__hip_atomic_load(flg + u.ti, __ATOMIC_RELAXED, __HIP_MEMORY_SCOPE_AGENT) < 3u) { __builtin_amdgcn_s_sleep(1); if (++sp > (1u << 14)) break; } }
        EPI_BAR();
        __builtin_amdgcn_fence(__ATOMIC_ACQUIRE, "agent");
#pragma unroll
        for (int q = 0; q < 3; ++q) { const float* p = part + (size_t)(u.ti * 3 + q) * (32 * 512 * 4) + tid * 4;
#pragma unroll
            for (int ai = 0; ai < 2; ++ai)
#pragma unroll
                for (int bj = 0; bj < 2; ++bj)
#pragma unroll
                    for (int m = 0; m < 4; ++m)
#pragma unroll
                        for (int n = 0; n < 2; ++n) acc[ai][bj][m][n] += *(const f32x4*)(p + (size_t)(((ai * 2 + bj) * 4 + m) * 2 + n) * (512 * 4)); }
        size_t roff = (size_t)(u.pm * 256 + wr * 64 + fr) * DM + u.pn * 256 + wc * 32 + fq * 8;
#pragma unroll
        for (int ai = 0; ai < 2; ++ai)
#pragma unroll
            for (int m = 0; m < 4; ++m) {
#pragma unroll
                for (int bj = 0; bj < 2; ++bj) { const f32x4 v0 = acc[ai][bj][m][0] * oscale, v1 = acc[ai][bj][m][1] * oscale;
                    u32x2 w; w.x = pk4_fp8(v0[0], v0[1], v0[2], v0[3]); w.y = pk4_fp8(v1[0], v1[1], v1[2], v1[3]);
                    *(u32x2*)(y + roff + bj * 128) = w; }
                NEXT_ROW(roff, m, DM); }
    }
};
}
constexpr size_t MiB = 1u << 20;
constexpr size_t WS_CTL = 0, CTL_ZERO_BYTES = 1 * MiB;
constexpr size_t WS_SSQ0 = 1 * MiB;
constexpr size_t WS_SSQ1 = WS_SSQ0 + 64 * 1024;
constexpr size_t WS_SSQ2 = WS_SSQ1 + 512 * 1024;
constexpr size_t WS_SSQ3 = WS_SSQ2 + 512 * 1024;
constexpr size_t WS_KMEAN = WS_SSQ3 + 512 * 1024;
constexpr size_t WS_ROPE = WS_KMEAN + 256 * 1024;
constexpr size_t WS_SPL = WS_ROPE + 512 * 1024;
constexpr size_t WS_RSTD3 = WS_SPL + 8 * 1024;
constexpr size_t WS_TOKE = WS_RSTD3 + 64 * 1024;
constexpr size_t WS_TOKW = WS_TOKE + 64 * 1024;
constexpr size_t WS_CNTC = WS_TOKW + 128 * 1024;
constexpr size_t WS_SLOTT = WS_CNTC + 8 * 1024;
constexpr size_t WS_SLOTW = WS_SLOTT + 144 * 1024;
constexpr size_t WS_TPREF = WS_SLOTW + 144 * 1024;
constexpr size_t WS_GAINS = WS_TPREF + 1024;
constexpr size_t WS_TOKS = WS_GAINS + 4096;
constexpr size_t WS_SLOTR = WS_TOKS + 128 * 1024;
constexpr size_t WS_SCANA = 8 * MiB, WS_SCANH = 9 * MiB, WS_SCANC = 10 * MiB;
static_assert(WS_SLOTR + 144 * 1024 <= WS_SCANA, "small arrays");
constexpr size_t WS_WQKV = 32 * MiB, WS_WO = 56 * MiB, WS_WGU = 64 * MiB, WS_WDN = 120 * MiB, WS_WIN = 148 * MiB, WS_WAI = 164 * MiB, WS_WO2 = 166 * MiB;
constexpr size_t WS_EGU = 176 * MiB, WS_EDN = 624 * MiB;
constexpr size_t WS_XB = 848 * MiB;
constexpr size_t WS_XR = 912 * MiB;
constexpr size_t WS_ARENA = 1040 * MiB;
constexpr size_t WS_QKV = WS_ARENA, WS_O = WS_ARENA + 192 * MiB;
constexpr size_t WS_H = WS_ARENA;
constexpr size_t WS_XBR = WS_ARENA, WS_GG = WS_ARENA + 64 * MiB, WS_XC = WS_ARENA + 128 * MiB, WS_AA = WS_ARENA + 192 * MiB, WS_UU = WS_ARENA + 320 * MiB, WS_Y = WS_ARENA + 448 * MiB;
constexpr size_t WS_PART = WS_ARENA + 256 * MiB;
constexpr size_t WS_HE = WS_ARENA;
constexpr size_t WS_XG = WS_ARENA + 512 * MiB;
constexpr size_t WS_END = WS_XG + 136 * MiB;
static_assert((size_t)NSLOT_PAD * DFF * 2 <= 512 * MiB && (size_t)T * DFF * 2 <= 512 * MiB && (size_t)NSLOT_PAD * DM * 2 <= 136 * MiB, "arena");
constexpr int CW_TMO = 0, CW_BAR = 4096, CW_XRANK = 8192, CW_SCANF = 12288, CW_TAILF = 13312;

constexpr int RING_OFF = 0, RING_BYTES = 131072, EPI_OFF = 131072, EPI_BYTES = 12288, MISC_OFF = EPI_OFF + EPI_BYTES, LDS_BYTES = 147456;
static_assert(MISC_OFF + 128 <= LDS_BYTES && att::LDS_BYTES <= RING_BYTES, "LDS map");

#define XB_TMO      128
#define XB_XCNT(j)  (256  + 64 * (j))
#define XB_XSUB(j)  (1280 + 64 * (j))
#define XB_XGEN(j)  (2304 + 64 * (j))
#define XB_TOP      3328
#define XB_TOPGEN   3392
#define XCD_BAR_WORDS 3456
#define XB_SPIN_CAP (1u << 18)
__device__ __forceinline__ unsigned xb_ld(unsigned* p)              { return __hip_atomic_load(p, __ATOMIC_RELAXED, __HIP_MEMORY_SCOPE_AGENT); }
__device__ __forceinline__ unsigned xb_add(unsigned* p, unsigned v) { return __hip_atomic_fetch_add(p, v, __ATOMIC_RELAXED, __HIP_MEMORY_SCOPE_AGENT); }
__device__ __forceinline__ unsigned xb_xcc_id() { return (unsigned)__builtin_amdgcn_s_getreg((3 << 11) | 20) & 0xFu; }
#define XB_SPIN(cond, bar) do { unsigned _sp = 0; while (cond) { __builtin_amdgcn_s_sleep(1); \
    if ((++_sp & 255u) == 0u) { if (xb_ld(&(bar)[XB_TMO])) break; if (_sp > XB_SPIN_CAP) { atomicAdd(&(bar)[XB_TMO], 1u); break; } } } } while (0)
struct XcdBarrier { unsigned* bar; unsigned x; volatile LAS unsigned* st; int wave; };
__device__ __forceinline__ bool xb_leader(int wave) { return wave == 0 && __builtin_amdgcn_mbcnt_hi(~0u, __builtin_amdgcn_mbcnt_lo(~0u, 0u)) == 0u; }
__device__ __forceinline__ XcdBarrier xcd_barrier_post(unsigned* bar, volatile LAS unsigned* st, int wave) {
    XcdBarrier b; b.bar = bar; b.x = xb_xcc_id(); b.st = st; b.wave = wave;
    if (xb_leader(wave)) (void)xb_add(&bar[XB_XCNT(b.x)], 1u);
    return b;
}
__device__ __forceinline__ void xcd_barrier_complete(unsigned* bar, unsigned x, unsigned& nloc, unsigned& nx) {
    const unsigned G = gridDim.x * gridDim.y * gridDim.z;
    unsigned sum, cnt, mine, sp = 0u;
    for (;;) {
        sum = 0u; cnt = 0u; mine = 0u;
#pragma unroll
        for (unsigned j = 0; j < 16; ++j) { const unsigned c = xb_ld(&bar[XB_XCNT(j)]); sum += c; cnt += (c > 0u) ? 1u : 0u; mine = (j == x) ? c : mine; }
        if (sum == G) break;
        __builtin_amdgcn_s_sleep(1);
        if ((++sp & 255u) == 0u) { if (xb_ld(&bar[XB_TMO])) break; if (sp > XB_SPIN_CAP) { atomicAdd(&bar[XB_TMO], 1u); break; } }
    }
    nloc = mine > 0u ? mine : 1u; nx = cnt > 0u ? cnt : 1u;
}
__device__ __forceinline__ void xcd_barrier(const XcdBarrier& b) {
    asm volatile("s_waitcnt vmcnt(0)" ::: "memory");
    __syncthreads();
    if (xb_leader(b.wave)) {
        unsigned* bar = b.bar;
        __builtin_amdgcn_s_waitcnt(0);
        unsigned nloc = b.st[0], nx = b.st[1];
        if (nloc == 0u) { xcd_barrier_complete(bar, b.x, nloc, nx); b.st[0] = nloc; b.st[1] = nx; }
        const unsigned old = xb_add(&bar[XB_XSUB(b.x)], 1u);
        const unsigned gen = old / nloc;
        if (old + 1u == (gen + 1u) * nloc) {
            __builtin_amdgcn_fence(__ATOMIC_RELEASE, "agent");
            asm volatile("s_waitcnt vmcnt(0)" ::: "memory");
            const unsigned og = xb_add(&bar[XB_TOP], 1u);
            const unsigned tg = og / nx;
            if (og + 1u == (tg + 1u) * nx) xb_add(&bar[XB_TOPGEN], 1u);
            else XB_SPIN(xb_ld(&bar[XB_TOPGEN]) == tg, bar);
            __builtin_amdgcn_fence(__ATOMIC_ACQUIRE, "agent");
            xb_add(&bar[XB_XGEN(b.x)], 1u);
            asm volatile("s_waitcnt vmcnt(0)" ::: "memory");
        } else {
            XB_SPIN(xb_ld(&bar[XB_XGEN(b.x)]) == gen, bar);
            __builtin_amdgcn_fence(__ATOMIC_ACQUIRE, "agent");
            asm volatile("s_waitcnt vmcnt(0)" ::: "memory");
        }
    }
    __syncthreads();
}

#define LDS_WAIT() asm volatile("s_waitcnt lgkmcnt(0)" ::: "memory")
__device__ __forceinline__ void transpose_item(const float* W, int ldw, int k0, int n0, const float* gain, bf16* WT, int ldwt, int drow0, LAS float* scr, int lane) {
    const int n4 = lane & 7, kr = lane >> 3;
#pragma unroll
    for (int i = 0; i < 8; ++i) { const int kk = 8 * i + kr; f32x4 v = *(const f32x4*)(W + (size_t)(k0 + kk) * ldw + n0 + 4 * n4);
        if (gain) v = v * gain[k0 + kk];
        LAS float* d = scr + kk * 33 + 4 * n4; d[0] = v[0]; d[1] = v[1]; d[2] = v[2]; d[3] = v[3]; }
    LDS_WAIT(); asm volatile("" ::: "memory");
    const int c = lane & 7;
#pragma unroll
    for (int j = 0; j < 4; ++j) { const int n = (lane >> 3) + 8 * j; const LAS float* s = scr + (8 * c) * 33 + n;
        u32x4 o; o.x = pk2(s[0 * 33], s[1 * 33]); o.y = pk2(s[2 * 33], s[3 * 33]); o.z = pk2(s[4 * 33], s[5 * 33]); o.w = pk2(s[6 * 33], s[7 * 33]);
        *(u32x4*)(WT + (size_t)(drow0 + n) * ldwt + k0 + 8 * c) = o; }
    LDS_WAIT(); asm volatile("" ::: "memory");
}
__device__ __forceinline__ void transpose_item_fp8(const float* W, int ldw, int k0, int n0, const float* gain, float scale, unsigned char* WT, int ldwt, int drow0, LAS float* scr, int lane) {
    const int n4 = lane & 7, kr = lane >> 3;
#pragma unroll
    for (int i = 0; i < 8; ++i) { const int kk = 8 * i + kr; f32x4 v = *(const f32x4*)(W + (size_t)(k0 + kk) * ldw + n0 + 4 * n4);
        v = v * (gain ? gain[k0 + kk] * scale : scale);
        LAS float* d = scr + kk * 33 + 4 * n4; d[0] = v[0]; d[1] = v[1]; d[2] = v[2]; d[3] = v[3]; }
    LDS_WAIT(); asm volatile("" ::: "memory");
    const int c = lane & 7;
#pragma unroll
    for (int j = 0; j < 4; ++j) { const int n = (lane >> 3) + 8 * j; const LAS float* s = scr + (8 * c) * 33 + n;
        u32x2 o; o.x = epi::pk4_fp8(s[0 * 33], s[1 * 33], s[2 * 33], s[3 * 33]); o.y = epi::pk4_fp8(s[4 * 33], s[5 * 33], s[6 * 33], s[7 * 33]);
        *(u32x2*)(WT + (size_t)(drow0 + n) * ldwt + k0 + 8 * c) = o; }
    LDS_WAIT(); asm volatile("" ::: "memory");
}
__device__ __forceinline__ bool transpose_group_fp8(int& it, const float* W, size_t wstride, int nmat, int K, int N, const float* gain, float scale, unsigned char* WT, size_t tstride, int mode, LAS float* scr, int lane) {
    const int nblk = N / 32, per = (K / 64) * nblk, tot = per * nmat;
    if (it >= tot) { it -= tot; return false; }
    const int mat = it / per, r = it % per, kb = r / nblk, nb = r % nblk, n0 = 32 * nb;
    const int drow0 = (mode == 0) ? n0 : (256 * (n0 / 128) + (n0 % 128) + (mode == 2 ? 128 : 0));
    transpose_item_fp8(W + (size_t)mat * wstride, N, 64 * kb, n0, gain, scale, WT + (size_t)mat * tstride, K, drow0, scr, lane);
    return true;
}
__device__ __forceinline__ bool transpose_group(int& it, const float* W, size_t wstride, int nmat, int K, int N, const float* gain, bf16* WT, size_t tstride, int mode, LAS float* scr, int lane) {
    const int nblk = N / 32, per = (K / 64) * nblk, tot = per * nmat;
    if (it >= tot) { it -= tot; return false; }
    const int mat = it / per, r = it % per, kb = r / nblk, nb = r % nblk, n0 = 32 * nb;
    const int drow0 = (mode == 0) ? n0 : (256 * (n0 / 128) + (n0 % 128) + (mode == 2 ? 128 : 0));
    transpose_item(W + (size_t)mat * wstride, N, 64 * kb, n0, gain, WT + (size_t)mat * tstride, K, drow0, scr, lane);
    return true;
}
__device__ __forceinline__ void sincos_f64(double x, double& s, double& c) {
    const double TWO_PI = 6.283185307179586476925286766559, INV_2PI = 0.15915494309189533576888376337251;
    const double n = __builtin_rint(x * INV_2PI); const double r = __builtin_fma(-n, TWO_PI, x), r2 = r * r;
    double ts = r, tc = 1.0; s = r; c = 1.0;
#pragma unroll
    for (int k = 1; k <= 14; ++k) { tc = -tc * r2 / (double)((2 * k - 1) * (2 * k)); ts = -ts * r2 / (double)((2 * k) * (2 * k + 1)); c += tc; s += ts; }
}

struct TItem { const float* src; const float* gain; unsigned char* dst; int ldw, ldwt, fp8; float scale; };
__device__ __forceinline__ bool titem_group(int& it, TItem& t, const float* W, size_t wstride, int nmat, int K, int N, const float* gain, float scale, void* WT, size_t tstride_bytes, int mode, int fp8) {
    const int nblk = N / 64, per = (K / 64) * nblk, tot = per * nmat;
    if (it >= tot) { it -= tot; return false; }
    const int mat = it / per, r = it % per, k0 = 64 * (r / nblk), n0 = 64 * (r % nblk), esz = fp8 ? 1 : 2;
    const int drow0 = (mode == 0) ? n0 : (256 * (n0 / 128) + (n0 % 128) + (mode == 2 ? 128 : 0));
    t.src = W + (size_t)mat * wstride + (size_t)k0 * N + n0; t.gain = gain ? gain + k0 : nullptr;
    t.dst = (unsigned char*)WT + (size_t)mat * tstride_bytes + ((size_t)drow0 * K + k0) * esz; t.ldw = N; t.ldwt = K * esz; t.fp8 = fp8; t.scale = scale; return true;
}
__device__ __forceinline__ void titem_load(const TItem& t, f32x4 (&v)[2][8], f32x4 (&g)[2], int lane) {
    const int n4 = lane & 7, kr = lane >> 3;
    const float* gp = t.gain ? t.gain : t.src;
#pragma unroll
    for (int h = 0; h < 2; ++h)
#pragma unroll
        for (int i = 0; i < 8; ++i) v[h][i] = *(const f32x4*)(t.src + (size_t)(8 * kr + i) * t.ldw + 32 * h + 4 * n4);
    g[0] = *(const f32x4*)(gp + 8 * kr); g[1] = *(const f32x4*)(gp + 8 * kr + 4);
}
__device__ __forceinline__ void titem_process(const TItem& t, const f32x4 (&v)[2][8], const f32x4 (&g)[2], int lane) {
    const int n4 = lane & 7, kr = lane >> 3;
    float s[8];
#pragma unroll
    for (int j = 0; j < 8; ++j) s[j] = t.gain ? g[j >> 2][j & 3] * t.scale : t.scale;
    if (t.fp8) {
#pragma unroll
        for (int h = 0; h < 2; ++h)
#pragma unroll
            for (int i = 0; i < 4; ++i) { u32x2 o; o.x = epi::pk4_fp8(v[h][0][i] * s[0], v[h][1][i] * s[1], v[h][2][i] * s[2], v[h][3][i] * s[3]); o.y = epi::pk4_fp8(v[h][4][i] * s[4], v[h][5][i] * s[5], v[h][6][i] * s[6], v[h][7][i] * s[7]);
                __builtin_nontemporal_store(o, (u32x2*)(t.dst + (size_t)(32 * h + 4 * n4 + i) * t.ldwt + 8 * kr)); }
    } else {
#pragma unroll
        for (int h = 0; h < 2; ++h)
#pragma unroll
            for (int i = 0; i < 4; ++i) { u32x4 o; o.x = cvt_pk_bf16(v[h][0][i] * s[0], v[h][1][i] * s[1]); o.y = cvt_pk_bf16(v[h][2][i] * s[2], v[h][3][i] * s[3]); o.z = cvt_pk_bf16(v[h][4][i] * s[4], v[h][5][i] * s[5]); o.w = cvt_pk_bf16(v[h][6][i] * s[6], v[h][7][i] * s[7]);
                *(u32x4*)(t.dst + (size_t)(32 * h + 4 * n4 + i) * t.ldwt + 16 * kr) = o; }
    }
}

struct Args { const float* in[27]; float* out; unsigned char* ws; int ph_lo, ph_hi; };
constexpr int NPHASE = 19;
#ifndef MK_PER_PHASE
#define MK_PER_PHASE 0
#endif

__global__ void __launch_bounds__(NTHR, 2) fwd_kernel(Args args) {
    extern __shared__ __attribute__((aligned(16))) unsigned char lds_raw[];
    LAS unsigned char* lds = (LAS unsigned char*)lds_raw;
    volatile LAS unsigned* MISC = (volatile LAS unsigned*)(lds + MISC_OFF);
    const int G = gridDim.x, wg = blockIdx.x, GT = G * NTHR, NGW = G * NWAVES;
    const int wave_s = __builtin_amdgcn_readfirstlane(threadIdx.x >> 6);
#define x_in (AP->in[0])
#define ev_attn_norm (AP->in[1])
#define ev_w_in (AP->in[2])
#define ev_qn_sb (AP->in[3])
#define ev_kn_sb (AP->in[4])
#define ev_qn_mb (AP->in[5])
#define ev_kn_mb (AP->in[6])
#define ev_w_o (AP->in[7])
#define ev_ffn_norm (AP->in[8])
#define ev_w_gate (AP->in[9])
#define ev_w_up (AP->in[10])
#define ev_w_down (AP->in[11])
#define od_rec_norm (AP->in[12])
#define od_w_in (AP->in[13])
#define od_conv_w (AP->in[14])
#define od_conv_b (AP->in[15])
#define od_w_a (AP->in[16])
#define od_b_a (AP->in[17])
#define od_w_i (AP->in[18])
#define od_b_i (AP->in[19])
#define od_lambda (AP->in[20])
#define od_w_o (AP->in[21])
#define od_ffn_norm (AP->in[22])
#define od_router (AP->in[23])
#define od_we_gate (AP->in[24])
#define od_we_up (AP->in[25])
#define od_we_down (AP->in[26])
#define ssq0 ((float*)(AP->ws + WS_SSQ0))
#define ssq1 ((float*)(AP->ws + WS_SSQ1))
#define ssq2 ((float*)(AP->ws + WS_SSQ2))
#define ssq3 ((float*)(AP->ws + WS_SSQ3))
#define kmean ((float*)(AP->ws + WS_KMEAN))
#define rope ((float*)(AP->ws + WS_ROPE))
#define spl ((float*)(AP->ws + WS_SPL))
#define rstd3 ((float*)(AP->ws + WS_RSTD3))
#define tok_e ((int*)(AP->ws + WS_TOKE))
#define tok_w ((float*)(AP->ws + WS_TOKW))
#define tok_slot ((int*)(AP->ws + WS_TOKS))
#define cnt_chunk ((int*)(AP->ws + WS_CNTC))
#define slot_tok ((int*)(AP->ws + WS_SLOTT))
#define slot_w ((float*)(AP->ws + WS_SLOTW))
#define tpref ((int*)(AP->ws + WS_TPREF))
#define gains ((float*)(AP->ws + WS_GAINS))
#define slot_rstd ((float*)(AP->ws + WS_SLOTR))
#define XG ((bf16*)(AP->ws + WS_XG))
#define scanA ((float*)(AP->ws + WS_SCANA))
#define scanH ((float*)(AP->ws + WS_SCANH))
#define scanC ((float*)(AP->ws + WS_SCANC))
#define Wqkv ((bf16*)(AP->ws + WS_WQKV))
#define Wo ((bf16*)(AP->ws + WS_WO))
#define Wgu ((bf16*)(AP->ws + WS_WGU))
#define Wdn ((bf16*)(AP->ws + WS_WDN))
#define Win ((bf16*)(AP->ws + WS_WIN))
#define Wai ((bf16*)(AP->ws + WS_WAI))
#define Wo2 ((bf16*)(AP->ws + WS_WO2))
#define Egu ((bf16*)(AP->ws + WS_EGU))
#define Edn ((bf16*)(AP->ws + WS_EDN))
#define XB ((bf16*)(AP->ws + WS_XB))
#define XR ((float*)(AP->ws + WS_XR))
#define QKV ((bf16*)(AP->ws + WS_QKV))
#define OB ((bf16*)(AP->ws + WS_O))
#define HB ((bf16*)(AP->ws + WS_H))
#define XBR ((bf16*)(AP->ws + WS_XBR))
#define GG ((bf16*)(AP->ws + WS_GG))
#define XC ((bf16*)(AP->ws + WS_XC))
#define AA ((float*)(AP->ws + WS_AA))
#define UU ((float*)(AP->ws + WS_UU))
#define YB ((bf16*)(AP->ws + WS_Y))
#define HE ((bf16*)(AP->ws + WS_HE))
#define out (AP->out)
    typedef const __attribute__((address_space(4))) Args* ArgsP;
#define PHASE_ARGS() ArgsP AP = (ArgsP)__builtin_amdgcn_kernarg_segment_ptr(); asm volatile("" : "+s"(AP))
    gu32* ctl; { PHASE_ARGS(); ctl = (gu32*)(AP->ws + WS_CTL); }
#define PHASE_IDS() const int lane = (int)__builtin_amdgcn_mbcnt_hi(~0u, __builtin_amdgcn_mbcnt_lo(~0u, 0u)), wave = wave_s, tid = wave * 64 + lane, gtid = wg * NTHR + tid, gw = wg * NWAVES + wave; (void)gtid; (void)gw
    for (int u = threadIdx.x; u < (LDS_BYTES - MISC_OFF) / 4; u += NTHR) ((LAS unsigned*)(lds + MISC_OFF))[u] = 0u;
    __syncthreads();
    XcdBarrier bar; bar.bar = (unsigned*)(ctl + CW_BAR); bar.x = 0; bar.st = nullptr; bar.wave = wave_s;
    if (!MK_PER_PHASE) bar = xcd_barrier_post((unsigned*)(ctl + CW_BAR), MISC + 8, wave_s);
    if (!MK_PER_PHASE && xb_leader(wave_s)) { const unsigned xcc = xb_xcc_id(); const unsigned rk = xb_add((unsigned*)(ctl + CW_XRANK + 64 * (xcc & 7u)), 1u); MISC[16] = rk * 8u + (xcc & 7u); }
    int vwg = wg; bool xloc = false;
    const int lo = args.ph_lo, hi = args.ph_hi;
#ifndef PHMASK
#define PHMASK 0x7ffff
#endif
#define IN(k) (((PHMASK >> (k)) & 1) && lo <= (k) && (k) < hi)
#ifndef PROBE_XBAR
#define PROBE_XBAR 0
#endif
#define SEAM(k) do { if (IN(k) && IN((k) + 1)) { xcd_barrier(bar); for (int xb_ = 0; xb_ < PROBE_XBAR; ++xb_) xcd_barrier(bar); } } while (0)
#ifndef PHREP
#define PHREP 0
#endif
#define NREP(k) ((((PHREP) >> (k)) & 1) ? 2 : 1)
    LAS unsigned char* ring = lds + RING_OFF; LAS unsigned char* lepi = lds + EPI_OFF;

    constexpr int PER_FF = (DM / 64) * (DFF / 64), PER_DN = (DFF / 64) * (DM / 64), NEXP_ITEMS = 16 * PER_FF + 8 * PER_DN;
    constexpr int NITEMS = (DM / 64) * (NQKV / 64) + (DM / 64) * (DM / 64) + 2 * PER_FF + PER_DN + (DM / 64) * (2 * DM / 64) + 16 * (256 / 64) * (256 / 64) + (DM / 64) * (DM / 64) + NEXP_ITEMS;
#define TDECODE(itv, t) do { int it_ = (itv); \
            if (titem_group(it_, t, od_we_gate, (size_t)DM * DFF, 8, DM, DFF, od_ffn_norm, epi::W_UP_SCALE, Egu, (size_t)2 * DFF * DM, 1, 1)) break; \
            if (titem_group(it_, t, od_we_up, (size_t)DM * DFF, 8, DM, DFF, od_ffn_norm, epi::W_UP_SCALE, Egu, (size_t)2 * DFF * DM, 2, 1)) break; \
            if (titem_group(it_, t, od_we_down, (size_t)DFF * DM, 8, DFF, DM, nullptr, epi::W_DN_SCALE, Edn, (size_t)DM * DFF, 0, 1)) break; \
            if (titem_group(it_, t, ev_w_in, 0, 1, DM, NQKV, ev_attn_norm, 1.0f, Wqkv, 0, 0, 0)) break; \
            if (titem_group(it_, t, ev_w_o, 0, 1, DM, DM, nullptr, 1.0f, Wo, 0, 0, 0)) break; \
            if (titem_group(it_, t, ev_w_gate, 0, 1, DM, DFF, ev_ffn_norm, 1.0f, Wgu, 0, 1, 0)) break; \
            if (titem_group(it_, t, ev_w_up, 0, 1, DM, DFF, ev_ffn_norm, 1.0f, Wgu, 0, 2, 0)) break; \
            if (titem_group(it_, t, ev_w_down, 0, 1, DFF, DM, nullptr, epi::W_DN_SCALE, Wdn, 0, 0, 1)) break; \
            if (titem_group(it_, t, od_w_in, 0, 1, DM, 2 * DM, od_rec_norm, 1.0f, Win, 0, 0, 0)) break; \
            if (titem_group(it_, t, od_w_a, (size_t)256 * 256, 8, 256, 256, nullptr, 1.0f, Wai, (size_t)512 * 256 * 2, 1, 0)) break; \
            if (titem_group(it_, t, od_w_i, (size_t)256 * 256, 8, 256, 256, nullptr, 1.0f, Wai, (size_t)512 * 256 * 2, 2, 0)) break; \
            titem_group(it_, t, od_w_o, 0, 1, DM, DM, nullptr, 1.0f, Wo2, 0, 0, 0); } while (0)
#define CONVERT_RANGE(first_, last_) do { \
            TItem tA, tB; f32x4 vA[2][8], vB[2][8]; f32x4 gA[2], gB[2]; \
            int it = (first_) + gw; \
            if (it < (last_)) { \
                TDECODE(it, tA); titem_load(tA, vA, gA, lane); \
                for (;;) {                                                     \
                    int itB = it + NGW; const bool hasB = itB < (last_); if (!hasB) itB = it; \
                    TDECODE(itB, tB); titem_load(tB, vB, gB, lane); \
                    titem_process(tA, vA, gA, lane); \
                    if (!hasB) break; \
                    it = itB + NGW; const bool hasA = it < (last_); if (!hasA) it = itB; \
                    TDECODE(it, tA); titem_load(tA, vA, gA, lane); \
                    titem_process(tB, vB, gB, lane); \
                    if (!hasA) break; \
                } } } while (0)
    for (int rep_ = 0; rep_ < NREP(0); ++rep_) { if (rep_ > 0 && !MK_PER_PHASE) xcd_barrier(bar);
    if (IN(0)) { PHASE_ARGS(); PHASE_IDS();
#ifdef PROBE_CONV_IN_P0
        CONVERT_RANGE(0, NITEMS);
#else
        CONVERT_RANGE(NEXP_ITEMS, NITEMS);
#endif
        for (int m = gw; m < T; m += NGW) {
            const f32x4* xr = (const f32x4*)(x_in + (size_t)m * DM) + lane; f32x4 v[8]; float s = 0.f;
#pragma unroll
            for (int j = 0; j < 8; ++j) { v[j] = xr[64 * j]; s += (v[j][0] * v[j][0] + v[j][1] * v[j][1]) + (v[j][2] * v[j][2] + v[j][3] * v[j][3]); }
            s = wave_sum(s); if (lane == 0) ssq0[m] = s;
            u32x2* o8 = (u32x2*)(XB + (size_t)m * DM) + lane;
#pragma unroll
            for (int j = 0; j < 8; ++j) { u32x2 w; w.x = cvt_pk_bf16(v[j][0], v[j][1]); w.y = cvt_pk_bf16(v[j][2], v[j][3]); o8[64 * j] = w; }
        }
        for (int idx = gtid; idx < SEQ * 16; idx += GT) {
            const double invf[16] = {1.0, 0.44036660267178046, 0.19392274474868576, 0.08539710028576561, 0.03760603093086393, 0.016560440080994446, 0.007292664737217109, 0.003211445994752591,
                                     0.001414213562373095, 0.000622772421914596, 0.0002742481756762073, 0.00012076973741146504, 5.318295896944988e-05, 2.341999896140934e-05, 1.031338537721246e-05, 4.5416704806078695e-06};
            const int pos = idx >> 4, i = idx & 15; double f = invf[0];
#pragma unroll
            for (int k = 1; k < 16; ++k) f = (i == k) ? invf[k] : f;
            double s, c; sincos_f64((double)pos * f, s, c);
            rope[idx] = (float)c; rope[SEQ * 16 + idx] = (float)s;
        }
        for (int c = gtid; c < DM; c += GT) { const float l = od_lambda[c]; spl[c] = (l > 15.f) ? expf(-l) : log1pf(expf(-l)); }
        if (gtid < HD) { gains[gtid] = ev_qn_sb[gtid]; gains[128 + gtid] = ev_kn_sb[gtid]; gains[256 + gtid] = ev_qn_mb[gtid]; gains[384 + gtid] = ev_kn_mb[gtid]; }
    }
    }
    SEAM(0);
    if (!MK_PER_PHASE && lo == 0) {
        bool ok = (G % 8) == 0;
#pragma unroll
        for (int j = 0; j < 8; ++j) ok = ok && (__hip_atomic_load((unsigned*)(ctl + CW_XRANK + 64 * j), __ATOMIC_RELAXED, __HIP_MEMORY_SCOPE_AGENT) == (unsigned)(G / 8));
        const int cand = __builtin_amdgcn_readfirstlane((int)MISC[16]);
        vwg = (ok && cand < G) ? cand : wg; xloc = ok && cand < G;
    }

    for (int rep_ = 0; rep_ < NREP(1); ++rep_) { if (rep_ > 0 && !MK_PER_PHASE) xcd_barrier(bar);
    if (IN(1)) { PHASE_ARGS();
        pg8::ProbPlain g{(const char*)XB, (const char*)Wqkv, (unsigned)DM * 2u, (unsigned)DM * 2u, DM / 64}; pg8::StaticOrder S; S.init(T / 256, NQKV / 256, G, vwg);
        epi::EpiQKV E{QKV, ssq0, gains, rope, kmean};
        pg8::gemm_phase(ring, lepi, g, S, E, wave_s);
    }
    }
    SEAM(1);

    for (int rep_ = 0; rep_ < NREP(3); ++rep_) { if (rep_ > 0 && !MK_PER_PHASE) xcd_barrier(bar);
    if (IN(3)) { PHASE_ARGS(); PHASE_IDS();
        const int half = (wg >> 3) & 1;
#ifndef PROBE_CONV_IN_P0
        if (half == 1) { CONVERT_RANGE(0, NEXP_ITEMS); __syncthreads(); }
#endif
#ifdef PROBE_ATT2
        int nrp_ = 2; asm volatile("" : "+s"(nrp_));
        for (int rp_ = 0; rp_ < nrp_; ++rp_) {
#endif
        for (int p = wg; p < 256; p += G) { const int bh = p >> 3, k = p & 7, b = bh >> 3, h = bh & 7;
            for (int s = 0; s < 2; ++s) att::attn_unit<1>(QKV, OB, kmean, b, h, s ? 15 - k : k, ring, lepi, wave_s); }
        for (int p = wg; p < 256; p += G) { const int bh = p >> 3, k = p & 7, b = bh >> 3, h = bh & 7;
            for (int s = 0; s < 2; ++s) att::attn_unit<0>(QKV, OB, kmean, b, h, s ? 15 - k : k, ring, lepi, wave_s); }
#ifdef PROBE_ATT2
        }
#endif
#ifndef PROBE_CONV_IN_P0
        if (half == 0) { __syncthreads(); CONVERT_RANGE(0, NEXP_ITEMS); }
#endif
    }
    }
    SEAM(3);

    for (int rep_ = 0; rep_ < NREP(4); ++rep_) { if (rep_ > 0 && !MK_PER_PHASE) xcd_barrier(bar);
    if (IN(4)) { PHASE_ARGS();
        pg8::ProbPlain g{(const char*)OB, (const char*)Wo, (unsigned)DM * 2u, (unsigned)DM * 2u, DM / 64}; pg8::StaticOrder S; S.init(T / 256, DM / 256, G, vwg);
        epi::EpiResid<true> E{XB, nullptr, XB, ssq1};
        pg8::gemm_phase(ring, lepi, g, S, E, wave_s);
    }
    }
    SEAM(4);

    for (int rep_ = 0; rep_ < NREP(5); ++rep_) { if (rep_ > 0 && !MK_PER_PHASE) xcd_barrier(bar);
    if (IN(5)) { PHASE_ARGS();
        pg8::ProbPlain g{(const char*)XB, (const char*)Wgu, (unsigned)DM * 2u, (unsigned)DM * 2u, DM / 64}; pg8::StaticOrder S; S.init(T / 256, 2 * DFF / 256, G, vwg);
        epi::EpiSwiGLUDenseF8 E{(unsigned char*)HB, ssq1};
#ifdef PROBE_SPLIT5
        S.i1 = 7; pg8::gemm_phase(ring, lepi, g, S, E, wave_s); if (PROBE_SPLIT5 == 1) xcd_barrier(bar); S.i0 = 7; S.i1 = 1 << 30; pg8::gemm_phase(ring, lepi, g, S, E, wave_s);
#else
        pg8::gemm_phase(ring, lepi, g, S, E, wave_s);
#endif
    }
    }
    SEAM(5);

    for (int rep_ = 0; rep_ < NREP(6); ++rep_) { if (rep_ > 0 && !MK_PER_PHASE) xcd_barrier(bar);
    if (IN(6)) { PHASE_ARGS();
        pg8::ProbPlainF8 g{(const char*)HB, (const char*)Wdn, (unsigned)DFF, (unsigned)DFF, DFF / 128}; pg8::StaticOrder S; S.init(T / 256, DM / 256, G, vwg);
        epi::EpiResid<true, true> E{XB, nullptr, XB, ssq2};
        pg8::gemm_phase(ring, lepi, g, S, E, wave_s);
    }
    }
    SEAM(6);

    for (int rep_ = 0; rep_ < NREP(7); ++rep_) { if (rep_ > 0 && !MK_PER_PHASE) xcd_barrier(bar);
    if (IN(7)) { PHASE_ARGS();
        pg8::ProbPlain g{(const char*)XB, (const char*)Win, (unsigned)DM * 2u, (unsigned)DM * 2u, DM / 64}; pg8::StaticOrder S; S.init(T / 256, 2 * DM / 256, G, vwg);
        epi::EpiRecIn E{XBR, GG, ssq2};
        pg8::gemm_phase(ring, lepi, g, S, E, wave_s);
    }
    }
    SEAM(7);

    for (int rep_ = 0; rep_ < NREP(8); ++rep_) { if (rep_ > 0 && !MK_PER_PHASE) xcd_barrier(bar);
    if (IN(8)) { PHASE_ARGS(); PHASE_IDS();
        for (int idx = gtid; idx < (T / 32) * 256; idx += GT) { const int cg = idx & 255, row0 = (idx >> 8) * 32, c0 = cg * 8;
            float cw[4][8], cb[8], xm3[8], xm2[8], xm1[8];
#pragma unroll
            for (int tp = 0; tp < 4; ++tp) { const f32x4 a = *(const f32x4*)(od_conv_w + tp * DM + c0), b = *(const f32x4*)(od_conv_w + tp * DM + c0 + 4);
#pragma unroll
                for (int j = 0; j < 4; ++j) { cw[tp][j] = a[j]; cw[tp][4 + j] = b[j]; } }
            { const f32x4 a = *(const f32x4*)(od_conv_b + c0), b = *(const f32x4*)(od_conv_b + c0 + 4);
#pragma unroll
              for (int j = 0; j < 4; ++j) { cb[j] = a[j]; cb[4 + j] = b[j]; } }
            const bool first = (row0 & (SEQ - 1)) == 0;
#define LD8(dst, r_) do { const u32x4 w_ = *(const u32x4*)(XBR + (size_t)(r_) * DM + c0); dst[0] = bflo(w_.x); dst[1] = bfhi(w_.x); dst[2] = bflo(w_.y); dst[3] = bfhi(w_.y); dst[4] = bflo(w_.z); dst[5] = bfhi(w_.z); dst[6] = bflo(w_.w); dst[7] = bfhi(w_.w); } while (0)
            if (first) {
#pragma unroll
                for (int j = 0; j < 8; ++j) { xm3[j] = 0.f; xm2[j] = 0.f; xm1[j] = 0.f; }
            } else { LD8(xm3, row0 - 3); LD8(xm2, row0 - 2); LD8(xm1, row0 - 1); }
#pragma unroll 4
            for (int r = 0; r < 32; ++r) { float xt[8], y[8]; LD8(xt, row0 + r);
#pragma unroll
                for (int j = 0; j < 8; ++j) { y[j] = cb[j] + cw[0][j] * xm3[j] + cw[1][j] * xm2[j] + cw[2][j] * xm1[j] + cw[3][j] * xt[j]; xm3[j] = xm2[j]; xm2[j] = xm1[j]; xm1[j] = xt[j]; }
                u32x4 w; w.x = pk2(y[0], y[1]); w.y = pk2(y[2], y[3]); w.z = pk2(y[4], y[5]); w.w = pk2(y[6], y[7]); *(u32x4*)(XC + (size_t)(row0 + r) * DM + c0) = w; }
#undef LD8
        }
    }
    }
    SEAM(8);

    for (int rep_ = 0; rep_ < NREP(9); ++rep_) { if (rep_ > 0 && !MK_PER_PHASE) xcd_barrier(bar);
    if (IN(9)) { PHASE_ARGS();
        pg8::ProbGates g{(const char*)XC, (const char*)Wai, (unsigned)DM * 2u, 512u, 4}; pg8::StaticOrder S; S.init(T / 256, 16, G, vwg);
        epi::EpiGatesScan E{XC, od_b_a, od_b_i, spl, GG, YB, scanA, (unsigned*)(ctl + CW_SCANF)};
        pg8::gemm_phase(ring, lepi, g, S, E, wave_s);
    }
    }
    SEAM(9);


    for (int rep_ = 0; rep_ < NREP(13); ++rep_) { if (rep_ > 0 && !MK_PER_PHASE) xcd_barrier(bar);
    if (IN(13)) { PHASE_ARGS();
        pg8::ProbPlain g{(const char*)YB, (const char*)Wo2, (unsigned)DM * 2u, (unsigned)DM * 2u, DM / 64}; pg8::StaticOrder S; S.init(T / 256, DM / 256, G, vwg);
        epi::EpiResid<false> E{XB, nullptr, XB, nullptr};
        pg8::gemm_phase(ring, lepi, g, S, E, wave_s);
    }
    }
    SEAM(13);

    for (int rep_ = 0; rep_ < NREP(14); ++rep_) { if (rep_ > 0 && !MK_PER_PHASE) xcd_barrier(bar);
    if (IN(14)) { PHASE_ARGS(); PHASE_IDS();
        LAS float* Rg = (LAS float*)ring;
        LAS int* lcnt = (LAS int*)lepi;
        for (int i = tid; i < DM * 8; i += NTHR) { const int k = i >> 3, e = i & 7; Rg[e * DM + k] = od_ffn_norm[k] * od_router[i]; }
        for (int c = wg; c < T / 64; c += G) {
            if (tid < 8) lcnt[tid] = 0;
            __syncthreads();
            const int t0 = c * 64 + wave * 8;
            float acc[8][8], ssq[8];
#pragma unroll
            for (int q = 0; q < 8; ++q) { ssq[q] = 0.f;
#pragma unroll
                for (int e = 0; e < 8; ++e) acc[q][e] = 0.f; }
#pragma unroll 2
            for (int i = 0; i < 16; ++i) { const int k = 2 * lane + 128 * i; f32x2 rv[8]; unsigned xw[8];
#pragma unroll
                for (int e = 0; e < 8; ++e) rv[e] = *(const LAS f32x2*)(Rg + e * DM + k);
#pragma unroll
                for (int q = 0; q < 8; ++q) xw[q] = *(const unsigned*)(XB + (size_t)(t0 + q) * DM + k);
#pragma unroll
                for (int q = 0; q < 8; ++q) { const float x0 = bflo(xw[q]), x1 = bfhi(xw[q]); ssq[q] += x0 * x0 + x1 * x1;
#pragma unroll
                    for (int e = 0; e < 8; ++e) acc[q][e] += x0 * rv[e].x + x1 * rv[e].y; } }
#pragma unroll
            for (int q = 0; q < 8; ++q) { const float sq = wave_sum(ssq[q]); const float rs = 1.0f / sqrtf(sq * (1.0f / DM) + EPS);
                float lg[8];
#pragma unroll
                for (int e = 0; e < 8; ++e) lg[e] = wave_sum(acc[q][e]) * rs;
                int i0 = 0; float v0 = lg[0];
#pragma unroll
                for (int e = 1; e < 8; ++e) if (lg[e] > v0) { v0 = lg[e]; i0 = e; }
                int i1 = -1; float v1 = -__builtin_inff();
#pragma unroll
                for (int e = 0; e < 8; ++e) if (e != i0 && lg[e] > v1) { v1 = lg[e]; i1 = e; }
                if (lane == 0) { const int t = t0 + q; const float w0 = 1.0f / (1.0f + expf(v1 - v0));
                    tok_e[t] = i0 | (i1 << 8); tok_w[2 * t] = w0; tok_w[2 * t + 1] = 1.0f - w0; rstd3[t] = rs;
                    atomicAdd((int*)&lcnt[i0], 1); atomicAdd((int*)&lcnt[i1], 1); } }
            __syncthreads();
            if (tid < 8) cnt_chunk[c * 8 + tid] = lcnt[tid];
            __syncthreads();
        }
    }
    }
    SEAM(14);

    for (int rep_ = 0; rep_ < NREP(15); ++rep_) { if (rep_ > 0 && !MK_PER_PHASE) xcd_barrier(bar);
    if (IN(15)) { PHASE_ARGS(); PHASE_IDS();
        LAS int* li = (LAS int*)lepi;
        for (int c = wg; c < T / 64; c += G) {
            LAS int* lcnt = li + 256; LAS int* lte = li + 2304; LAS float* ltw = (LAS float*)(li + 2368); LAS float* lrs = (LAS float*)(li + 2496);
            for (int i = tid; i < (T / 64) * 8; i += NTHR) lcnt[i] = cnt_chunk[i];
            if (tid < 64) { lte[tid] = tok_e[c * 64 + tid]; lrs[tid] = rstd3[c * 64 + tid]; } else if (tid < 192) ltw[tid - 64] = tok_w[c * 128 + tid - 64];
            __syncthreads();
            if (tid < 8) { int run = 0, mine = 0; for (int cc = 0; cc < T / 64; ++cc) { if (cc == c) mine = run; run += lcnt[cc * 8 + tid]; } li[tid] = run; li[8 + tid] = mine; }
            __syncthreads();
            if (tid == 0) { int s = 0; for (int e = 0; e < 8; ++e) { li[16 + e] = s; s += ((li[e] + 255) >> 8) << 8; } li[24] = s; }
            __syncthreads();
            LAS int* lslot = li + 32;
            if (tid < 8) { const int e = tid; int pos = li[16 + e] + li[8 + e];
                for (int q = 0; q < 64; ++q) { const int t = c * 64 + q; const int pe = lte[q];
                    if ((pe & 255) == e) { slot_tok[pos] = t; slot_w[pos] = ltw[2 * q]; slot_rstd[pos] = lrs[q]; lslot[2 * q] = pos; ++pos; }
                    if ((pe >> 8) == e) { slot_tok[pos] = t; slot_w[pos] = ltw[2 * q + 1]; slot_rstd[pos] = lrs[q]; lslot[2 * q + 1] = pos; ++pos; } } }
            __syncthreads();
            if (tid < 128) tok_slot[c * 128 + tid] = lslot[tid];
            for (int q = wave; q < 64; q += NWAVES) {
                const u32x4* src = (const u32x4*)(XB + (size_t)(c * 64 + q) * DM) + lane; u32x2* d0 = (u32x2*)((unsigned char*)XG + (size_t)lslot[2 * q] * DM) + lane; u32x2* d1 = (u32x2*)((unsigned char*)XG + (size_t)lslot[2 * q + 1] * DM) + lane;
#pragma unroll
                for (int j = 0; j < 4; ++j) { const u32x4 v = src[64 * j]; u32x2 w; w.x = epi::pk4_fp8(bflo(v.x), bfhi(v.x), bflo(v.y), bfhi(v.y)); w.y = epi::pk4_fp8(bflo(v.z), bfhi(v.z), bflo(v.w), bfhi(v.w)); d0[64 * j] = w; d1[64 * j] = w; } }
            if (c == 0) {
                if (tid < 9) tpref[tid] = li[16 + tid] >> 8;
                for (int e = 0; e < 8; ++e) { const int a = li[16 + e] + li[e], z = li[16 + e + 1]; for (int s = a + tid; s < z; s += NTHR) { slot_tok[s] = 0; slot_w[s] = 0.f; slot_rstd[s] = 0.f; } }
            }
            __syncthreads();
        }
    }
    }
    SEAM(15);

    for (int rep_ = 0; rep_ < NREP(16); ++rep_) { if (rep_ > 0 && !MK_PER_PHASE) xcd_barrier(bar);
    if (IN(16)) { PHASE_ARGS();
        pg8::MoeOrder S;
#pragma unroll
        for (int k = 0; k < 9; ++k) S.pf[k] = __builtin_amdgcn_readfirstlane(tpref[k]);
        S.so.init(S.pf[8], 2 * DFF / 256, G, vwg);
        pg8::ProbMoeUp g{(const char*)XG, (const char*)Egu, (unsigned)DM, (unsigned)DM, DM / 128};
        epi::EpiSwiGLUFp8 E{(unsigned char*)HE, slot_rstd};
        pg8::gemm_phase(ring, lepi, g, S, E, wave_s);
    }
    }
    SEAM(16);

    for (int rep_ = 0; rep_ < NREP(17); ++rep_) { if (rep_ > 0 && !MK_PER_PHASE) xcd_barrier(bar);
    if (IN(17)) { PHASE_ARGS();
        pg8::MoeOrder S;
#pragma unroll
        for (int k = 0; k < 9; ++k) S.pf[k] = __builtin_amdgcn_readfirstlane(tpref[k]);
        S.so.init(S.pf[8], DM / 256, G, vwg);
        pg8::ProbMoeDown g{(const char*)HE, (const char*)Edn, (unsigned)DFF, (unsigned)DFF, DFF / 128};
        epi::EpiMoeDown E{(unsigned char*)XG, epi::Y_SCALE / (epi::W_DN_SCALE * epi::H_SCALE)};
        const int nj = S.pf[8] - 128;
        const bool use_tail = xloc && G == 256 && nj >= 1 && nj <= 8 && !MK_PER_PHASE;
        if (use_tail) S.so.i1 = 4;
        pg8::gemm_phase(ring, lepi, g, S, E, wave_s);
        if (use_tail) {
            pg8::MoeTailOrder ST; ST.so = S.so; ST.so.i1 = 1 << 30; ST.nj = nj;
#pragma unroll
            for (int k = 0; k < 9; ++k) ST.pf[k] = S.pf[k];
            pg8::ProbMoeDown g4{(const char*)HE, (const char*)Edn, (unsigned)DFF, (unsigned)DFF, DFF / 128 / 4};
            epi::EpiMoeDownTail ET{(unsigned char*)XG, epi::Y_SCALE / (epi::W_DN_SCALE * epi::H_SCALE), (float*)(AP->ws + WS_PART), (unsigned*)(ctl + CW_TAILF)};
            pg8::gemm_phase(ring, lepi, g4, ST, ET, wave_s);
        }
    }
    }
    SEAM(17);

    if (IN(18)) { PHASE_ARGS(); PHASE_IDS();
        for (int idx = gtid; idx < T * (DM / 8); idx += GT) { const int t = idx >> 8, c0 = (idx & 255) * 8;
            const int s0 = tok_slot[2 * t], s1 = tok_slot[2 * t + 1]; const float w0 = tok_w[2 * t] * (1.0f / epi::Y_SCALE), w1 = tok_w[2 * t + 1] * (1.0f / epi::Y_SCALE);
            const u32x2 a = *(const u32x2*)((const unsigned char*)XG + (size_t)s0 * DM + c0), b = *(const u32x2*)((const unsigned char*)XG + (size_t)s1 * DM + c0); const u32x4 x = *(const u32x4*)(XB + (size_t)t * DM + c0);
            const f32x2 a0 = __builtin_amdgcn_cvt_pk_f32_fp8((int)a.x, false), a1 = __builtin_amdgcn_cvt_pk_f32_fp8((int)a.x, true), a2 = __builtin_amdgcn_cvt_pk_f32_fp8((int)a.y, false), a3 = __builtin_amdgcn_cvt_pk_f32_fp8((int)a.y, true);
            const f32x2 b0 = __builtin_amdgcn_cvt_pk_f32_fp8((int)b.x, false), b1 = __builtin_amdgcn_cvt_pk_f32_fp8((int)b.x, true), b2 = __builtin_amdgcn_cvt_pk_f32_fp8((int)b.y, false), b3 = __builtin_amdgcn_cvt_pk_f32_fp8((int)b.y, true);
            f32x4 o0, o1;
            o0[0] = bflo(x.x) + (w0 * a0[0] + w1 * b0[0]); o0[1] = bfhi(x.x) + (w0 * a0[1] + w1 * b0[1]); o0[2] = bflo(x.y) + (w0 * a1[0] + w1 * b1[0]); o0[3] = bfhi(x.y) + (w0 * a1[1] + w1 * b1[1]);
            o1[0] = bflo(x.z) + (w0 * a2[0] + w1 * b2[0]); o1[1] = bfhi(x.z) + (w0 * a2[1] + w1 * b2[1]); o1[2] = bflo(x.w) + (w0 * a3[0] + w1 * b3[0]); o1[3] = bfhi(x.w) + (w0 * a3[1] + w1 * b3[1]);
            float* op = out + (size_t)t * DM + c0; *(f32x4*)op = o0; *(f32x4*)(op + 4) = o1; }
    }
#undef IN
#undef SEAM
#undef PHASE_IDS
#undef tok_slot
#undef TDECODE
#undef CONVERT_RANGE
#undef PHASE_ARGS
#undef x_in
#undef ev_attn_norm
#undef ev_w_in
#undef ev_qn_sb
#undef ev_kn_sb
#undef ev_qn_mb
#undef ev_kn_mb
#undef ev_w_o
#undef ev_ffn_norm
#undef ev_w_gate
#undef ev_w_up
#undef ev_w_down
#undef od_rec_norm
#undef od_w_in
#undef od_conv_w
#undef od_conv_b
#undef od_w_a
#undef od_b_a
#undef od_w_i
#undef od_b_i
#undef od_lambda
#undef od_w_o
#undef od_ffn_norm
#undef od_router
#undef od_we_gate
#undef od_we_up
#undef od_we_down
#undef ssq0
#undef ssq1
#undef ssq2
#undef ssq3
#undef kmean
#undef rope
#undef spl
#undef rstd3
#undef tok_e
#undef tok_w
#undef cnt_chunk
#undef slot_tok
#undef slot_w
#undef tpref
#undef gains
#undef slot_rstd
#undef XG
#undef scanA
#undef scanH
#undef scanC
#undef Wqkv
#undef Wo
#undef Wgu
#undef Wdn
#undef Win
#undef Wai
#undef Wo2
#undef Egu
#undef Edn
#undef XB
#undef XR
#undef QKV
#undef OB
#undef HB
#undef XBR
#undef GG
#undef XC
#undef AA
#undef UU
#undef YB
#undef HE
#undef out
}

extern "C" void kernel_launch(void* const* d_in, const int* in_sizes, int n_in, void* d_out, int out_size, void* d_ws, size_t ws_size, hipStream_t stream) {
    static int grid = 0;
    if (grid == 0) {
        if (n_in != 27 || in_sizes[0] != T * DM || out_size != T * DM || ws_size < WS_END) {
            fprintf(stderr, "kernel_launch: built for 27 inputs, x/out of %d floats, >= %zu bytes of workspace; got n_in %d, in0 %d, out %d, ws %zu; nothing launched\n", T * DM, (size_t)WS_END, n_in, n_in > 0 ? in_sizes[0] : -1, out_size, ws_size);
            grid = -1; return; }
        int dev = 0, cus = 0, per_cu = 0;
        if (hipGetDevice(&dev) != hipSuccess || hipDeviceGetAttribute(&cus, hipDeviceAttributeMultiprocessorCount, dev) != hipSuccess) { fprintf(stderr, "kernel_launch: device query failed\n"); grid = -1; return; }
        if (hipFuncSetAttribute((const void*)fwd_kernel, hipFuncAttributeMaxDynamicSharedMemorySize, LDS_BYTES) != hipSuccess) { fprintf(stderr, "kernel_launch: hipFuncSetAttribute failed\n"); grid = -1; return; }
        if (hipOccupancyMaxActiveBlocksPerMultiprocessor(&per_cu, (const void*)fwd_kernel, NTHR, LDS_BYTES) != hipSuccess || per_cu < 1)
            fprintf(stderr, "kernel_launch: note: occupancy query reports %d workgroups per CU\n", per_cu);
        (void)hipGetLastError();
        grid = cus;
    }
    if (grid < 0) return;
    if (hipMemsetAsync((char*)d_ws + WS_CTL, 0, CTL_ZERO_BYTES, stream) != hipSuccess) { fprintf(stderr, "kernel_launch: memset failed\n"); return; }
    Args a{};
    for (int i = 0; i < 27; ++i) a.in[i] = (const float*)d_in[i];
    a.out = (float*)d_out; a.ws = (unsigned char*)d_ws;
#if MK_PER_PHASE
    for (int p = 0; p < NPHASE; ++p) { a.ph_lo = p; a.ph_hi = p + 1; hipLaunchKernelGGL(fwd_kernel, dim3(grid), dim3(NTHR), LDS_BYTES, stream, a); }
#else
    a.ph_lo = 0; a.ph_hi = NPHASE;
    hipLaunchKernelGGL(fwd_kernel, dim3(grid), dim3(NTHR), LDS_BYTES, stream, a);
#endif
    const hipError_t le = hipPeekAtLastError();
    if (le != hipSuccess) fprintf(stderr, "kernel_launch: launch failed: %s\n", hipGetErrorName(le));
}
```

```cpp
#include <hip/hip_runtime.h>
#include <cstdio>
#include <cstdint>

#define LAS __attribute__((address_space(3)))
#define GAS __attribute__((address_space(1)))
typedef unsigned short bf16;
typedef short bf16x8 __attribute__((ext_vector_type(8)));
typedef short s16x4 __attribute__((ext_vector_type(4)));
typedef float f32x2 __attribute__((ext_vector_type(2)));
typedef float f32x4 __attribute__((ext_vector_type(4)));
typedef float f32x16 __attribute__((ext_vector_type(16)));
typedef unsigned u32x2 __attribute__((ext_vector_type(2)));
typedef unsigned u32x4 __attribute__((ext_vector_type(4)));
typedef GAS unsigned gu32;

constexpr int NB = 4, SEQ = 4096, DM = 2048, T = NB * SEQ;
constexpr int HD = 128, NQKV = 6144, DFF = 7168, NEXP = 8, NSLOT_PAD = 2 * T + NEXP * 256;
constexpr float EPS = 1e-6f;
constexpr int NWAVES = 8, NTHR = 512;

__device__ __forceinline__ unsigned f2bf(float f) { unsigned u = __builtin_bit_cast(unsigned, f); return (u + 0x7fffu + ((u >> 16) & 1u)) >> 16; }
__device__ __forceinline__ unsigned pk2(float lo, float hi) { return f2bf(lo) | (f2bf(hi) << 16); }
__device__ __forceinline__ float bf2f(unsigned short h) { return __builtin_bit_cast(float, (unsigned)h << 16); }
__device__ __forceinline__ float bflo(unsigned w) { return __builtin_bit_cast(float, w << 16); }
__device__ __forceinline__ float bfhi(unsigned w) { return __builtin_bit_cast(float, w & 0xffff0000u); }
__device__ __forceinline__ unsigned cvt_pk_bf16(float lo, float hi) { unsigned r; asm volatile("v_cvt_pk_bf16_f32 %0, %1, %2" : "=v"(r) : "v"(lo), "v"(hi)); return r; }
__device__ __forceinline__ float wave_sum(float v) {
#pragma unroll
    for (int o = 1; o < 64; o <<= 1) v += __shfl_xor(v, o);
    return v;
}
__device__ __forceinline__ float fast_exp(float x) { return __builtin_amdgcn_exp2f(x * 1.4426950408889634f); }
__device__ __forceinline__ float fast_sigmoid(float x) { return __builtin_amdgcn_rcpf(1.0f + fast_exp(-x)); }

namespace pg8 {
constexpr int BM = 256, BK = 64, HALF = 128, HTB = HALF * BK * 2, STAGE_BYTES = 8 * HTB, NXCD = 8, WGM = 8;
__host__ __device__ __forceinline__ int lds_byte(int r, int c) { const int st = (r >> 4) * 2 + (c >> 5), rr = r & 15, cc = c & 31, ob = rr * 64 + cc * 2; return st * 1024 + (ob ^ (((ob >> 9) & 1) << 5)); }
__host__ __device__ __forceinline__ void stage_rc(int b, int& R, int& C) { const int st = b / 1024, sb = b % 1024, swz = sb ^ (((sb >> 9) & 1) << 5); R = (st >> 1) * 16 + swz / 64; C = (st & 1) * 32 + (swz % 64) / 2; }
__host__ __device__ __forceinline__ int perm_a64(int r) { return (r & ~63) + 4 * (r & 15) + ((r >> 4) & 3); }
template <class E, class = void> struct aperm_of { static constexpr bool v = false; };
template <class E> struct aperm_of<E, decltype((void)E::APERM)> { static constexpr bool v = E::APERM; };
__host__ __device__ __forceinline__ int perm32(int rho) { const int n = rho >> 4, i = rho & 15; return 8 * (i >> 2) + 4 * n + (i & 3); }

struct Unit { int pm, pn, e, ks, ti; };

struct StaticOrder {
    int nM, nN, nwg, G, c, i0 = 0, i1 = 1 << 30;
    __device__ __forceinline__ void init(int nM_, int nN_, int G_, int c_) { nM = nM_; nN = nN_; nwg = nM * nN; G = G_; c = c_; }
    __device__ __forceinline__ bool unit_at(long L, Unit& u) const {
        if (L >= nwg) return false;
        int wgid = (int)L; { const int q = nwg / NXCD, r = nwg % NXCD, xcd = wgid % NXCD, off = wgid / NXCD; wgid = (xcd < r ? xcd * (q + 1) : r * (q + 1) + (xcd - r) * q) + off; }
        const int nig = WGM * nN, gid = wgid / nig, fm = gid * WGM, gsz = (nM - fm) < WGM ? (nM - fm) : WGM;
        u.pm = fm + ((wgid % nig) % gsz); u.pn = (wgid % nig) / gsz; u.e = 0; u.ks = 0; u.ti = 0; return true;
    }
    __device__ __forceinline__ bool next(int i, Unit& u) const {
        i += i0; if (i >= i1) return false;
        return unit_at((long)i * G + c, u);
    }
};
struct MoeOrder {
    StaticOrder so; int pf[9]; int tail_first = -1, tail_n = 0;
    __device__ __forceinline__ bool next(int i, Unit& u) const {
        if (tail_first >= 0) { const long L2 = (long)i * so.G + so.c; if (L2 >= 4L * tail_n) return false; if (!so.unit_at(tail_first + (L2 >> 2), u)) return false; u.ks = (int)(L2 & 3); }
        else if (!so.next(i, u)) return false;
        int e = 0;
#pragma unroll
        for (int k = 1; k < 8; ++k) e += (u.pm >= pf[k]) ? 1 : 0;
        u.e = e; return true;
    }
};
struct MoeTailOrder {
    StaticOrder so; int pf[9]; int nj;
    __device__ __forceinline__ bool next(int i, Unit& u) const {
        if (i != 0) return false;
        const int x = so.c & 7, r = so.c >> 3; if (r >= 4 * nj) return false;
        if (!so.unit_at(8L * (128 + (r >> 2)) + x, u)) return false;
        u.ks = r & 3; u.ti = x * 8 + (r >> 2);
        int e = 0;
#pragma unroll
        for (int k = 1; k < 8; ++k) e += (u.pm >= pf[k]) ? 1 : 0;
        u.e = e; return true;
    }
};

struct ProbPlain {
    static constexpr bool FP8 = false;
    const char* A; const char* B; unsigned lda, ldb; int nt;
    __device__ __forceinline__ const char* a_base(const Unit& u) const { return A + (size_t)u.pm * BM * lda; }
    __device__ __forceinline__ const char* b_base(const Unit& u) const { return B + (size_t)u.pn * BM * ldb; }
};
struct ProbPlainF8 {
    static constexpr bool FP8 = true;
    const char* A; const char* B; unsigned lda, ldb; int nt;
    __device__ __forceinline__ const char* a_base(const Unit& u) const { return A + (size_t)u.pm * BM * lda; }
    __device__ __forceinline__ const char* b_base(const Unit& u) const { return B + (size_t)u.pn * BM * ldb; }
};
struct ProbGates {
    static constexpr bool FP8 = false;
    const char* A; const char* B; unsigned lda, ldb; int nt;
    __device__ __forceinline__ const char* a_base(const Unit& u) const { return A + (size_t)u.pm * BM * lda + (size_t)(u.pn >> 1) * 512; }
    __device__ __forceinline__ const char* b_base(const Unit& u) const { return B + (size_t)u.pn * BM * ldb; }
};
struct ProbMoeUp {
    static constexpr bool FP8 = true;
    const char* A; const char* B; unsigned lda, ldb; int nt;
    __device__ __forceinline__ const char* a_base(const Unit& u) const { return A + (size_t)u.pm * BM * lda; }
    __device__ __forceinline__ const char* b_base(const Unit& u) const { return B + ((size_t)u.e * (2 * DFF) + (size_t)u.pn * BM) * ldb; }
};
struct ProbMoeDown {
    static constexpr bool FP8 = true;
    const char* A; const char* B; unsigned lda, ldb; int nt;
    __device__ __forceinline__ const char* a_base(const Unit& u) const { return A + (size_t)u.pm * BM * lda + (size_t)u.ks * nt * 128; }
    __device__ __forceinline__ const char* b_base(const Unit& u) const { return B + ((size_t)u.e * DM + (size_t)u.pn * BM) * ldb + (size_t)u.ks * nt * 128; }
};
typedef int v8i32 __attribute__((ext_vector_type(8)));
typedef short s16x16 __attribute__((ext_vector_type(16)));
__device__ __forceinline__ v8i32 cat8(bf16x8 lo, bf16x8 hi) { const s16x16 v = __builtin_shufflevector(lo, hi, 0, 1, 2, 3, 4, 5, 6, 7, 8, 9, 10, 11, 12, 13, 14, 15); return __builtin_bit_cast(v8i32, v); }

template <class Epi, class Sched, class Prob>
__device__ __forceinline__ void gemm_phase(LAS unsigned char* lds, LAS unsigned char* lds_epi, const Prob g, const Sched& S, const Epi& E, int wid) {
    const int lane = (int)__builtin_amdgcn_mbcnt_hi(~0u, __builtin_amdgcn_mbcnt_lo(~0u, 0u)), tid = wid * 64 + lane, wr = wid >> 2, wc = wid & 3, fr = lane & 15, fq = lane >> 4;
    const int nt = g.nt;
    int R0, C0, R1, C1; stage_rc(tid * 16, R0, C0); stage_rc(tid * 16 + 8192, R1, C1);
    const unsigned lda2 = g.lda, ldb2 = g.ldb;
    const int Rb0 = Epi::PERM ? ((R0 & ~31) + perm32(R0 & 31)) : R0, Rb1 = Epi::PERM ? ((R1 & ~31) + perm32(R1 & 31)) : R1;
    const unsigned vB0 = (unsigned)Rb0 * ldb2 + (unsigned)C0 * 2u, vB1 = (unsigned)Rb1 * ldb2 + (unsigned)C1 * 2u;
    const unsigned hstepB = (unsigned)HALF * ldb2;
    const size_t kstep = (size_t)(BK * 2);
    const unsigned ldsw = (unsigned)wid * 1024u;
    const int aoff = lds_byte(wr * 64 + fr, fq * 8), boff = lds_byte(wc * 32 + fr, fq * 8);
#define PG8_SA(b, h) (((b) * 2 + (h)) * HTB)
#define PG8_SB(b, h) ((4 + (b) * 2 + (h)) * HTB)
#define PG8_STAGE(bufoff, gbase, o0, o1) do { \
        __builtin_amdgcn_global_load_lds((const unsigned*)((const char*)(gbase) + (o0)), (LAS unsigned*)(lds + (bufoff) + ldsw), 16, 0, 0); \
        __builtin_amdgcn_global_load_lds((const unsigned*)((const char*)(gbase) + (o1)), (LAS unsigned*)(lds + (bufoff) + ldsw + 8192), 16, 0, 0); } while (0)
#define PG8_LDA(dst, b, h) do { _Pragma("unroll") for (int m = 0; m < 4; ++m) _Pragma("unroll") for (int k = 0; k < 2; ++k) dst[m][k] = *(const LAS bf16x8*)(lds + PG8_SA(b, h) + aoff + m * 2048 + k * 1024); } while (0)
#define PG8_LDB(dst, b, h) do { _Pragma("unroll") for (int n = 0; n < 2; ++n) _Pragma("unroll") for (int k = 0; k < 2; ++k) dst[n][k] = *(const LAS bf16x8*)(lds + PG8_SB(b, h) + boff + n * 2048 + k * 1024); } while (0)
#define PG8_MMA(ai, bj, At, Bt) do { __builtin_amdgcn_s_setprio(1); \
        if constexpr (Prob::FP8) { _Pragma("unroll") for (int m = 0; m < 4; ++m) _Pragma("unroll") for (int n = 0; n < 2; ++n) \
            asm volatile("v_mfma_f32_16x16x128_f8f6f4 %0, %1, %2, %0" : "+v"(acc[ai][bj][m][n]) : "v"(cat8(Bt[n][0], Bt[n][1])), "v"(cat8(At[m][0], At[m][1]))); } \
        else { _Pragma("unroll") for (int m = 0; m < 4; ++m) _Pragma("unroll") for (int n = 0; n < 2; ++n) _Pragma("unroll") for (int k = 0; k < 2; ++k) \
            acc[ai][bj][m][n] = __builtin_amdgcn_mfma_f32_16x16x32_bf16(Bt[n][k], At[m][k], acc[ai][bj][m][n], 0, 0, 0); } \
        __builtin_amdgcn_s_setprio(0); } while (0)
#define PG8_WAIT_V(n) asm volatile("s_waitcnt vmcnt(" #n ")" ::: "memory")
#define PG8_WAIT_L(n) asm volatile("s_waitcnt lgkmcnt(" #n ")" ::: "memory")
#define PG8_BAR __builtin_amdgcn_s_barrier()
#define PG8_SCHED __builtin_amdgcn_sched_barrier(0)
    Unit cur, nxt; int ui = 0; int epi_pm = -1;
    if (!S.next(0, cur)) return;
    const int Ra0 = aperm_of<Epi>::v ? perm_a64(R0) : R0, Ra1 = aperm_of<Epi>::v ? perm_a64(R1) : R1;
    const unsigned cA00 = (unsigned)Ra0 * lda2 + (unsigned)C0 * 2u, cA01 = (unsigned)Ra1 * lda2 + (unsigned)C1 * 2u, cA10 = cA00 + (unsigned)HALF * lda2, cA11 = cA01 + (unsigned)HALF * lda2;
    f32x4 acc[2][2][4][2];
#define PG8_ACC_INIT(unit) do { if constexpr (Epi::ACC_INIT) { E.init(acc, unit, wr, wc, fr, fq); } else { \
        _Pragma("unroll") for (int a = 0; a < 2; ++a) _Pragma("unroll") for (int b = 0; b < 2; ++b) _Pragma("unroll") for (int m = 0; m < 4; ++m) _Pragma("unroll") for (int n = 0; n < 2; ++n) acc[a][b][m][n] = (f32x4){0.f, 0.f, 0.f, 0.f}; } } while (0)
    PG8_ACC_INIT(cur);
    bf16x8 At[4][2], B0[2][2], B1[2][2];
    const char* cA = g.a_base(cur); const char* cB = g.b_base(cur);
    PG8_STAGE(PG8_SB(0, 0), cB, vB0, vB1); PG8_STAGE(PG8_SB(0, 1), cB + hstepB, vB0, vB1); PG8_STAGE(PG8_SA(0, 0), cA, cA00, cA01); PG8_STAGE(PG8_SA(0, 1), cA, cA10, cA11);
    if (wr == 1) PG8_BAR;
    PG8_WAIT_V(2); PG8_BAR;
    PG8_STAGE(PG8_SB(1, 0), cB + kstep, vB0, vB1); PG8_STAGE(PG8_SA(1, 0), cA + kstep, cA00, cA01); PG8_STAGE(PG8_SB(1, 1), cB + hstepB + kstep, vB0, vB1);
    PG8_WAIT_V(6); PG8_BAR;
    for (;;) {
        const bool has_next = S.next(ui + 1, nxt);
        const char* nA = has_next ? g.a_base(nxt) : cA; const char* nB = has_next ? g.b_base(nxt) : cB;
_Pragma("clang loop unroll(disable)")
        for (int t = 0; t < nt; t += 2) {
            const bool last = (t == nt - 2);
            const char* a1 = cA + (size_t)(t + 1) * kstep;
            const char* a2 = last ? nA : cA + (size_t)(t + 2) * kstep; const char* b2 = last ? nB : cB + (size_t)(t + 2) * kstep;
            const char* a3 = a2 + kstep; const char* b3 = b2 + kstep;
            PG8_LDB(B0, 0, 0); PG8_LDB(B1, 0, 1); PG8_SCHED; PG8_LDA(At, 0, 0); PG8_STAGE(PG8_SA(1, 1), a1, cA10, cA11);
            PG8_WAIT_V(8); PG8_WAIT_L(0); PG8_BAR; PG8_MMA(0, 0, At, B0); PG8_MMA(0, 1, At, B1); PG8_BAR; PG8_SCHED;
            PG8_LDA(At, 0, 1); PG8_STAGE(PG8_SB(0, 0), b2, vB0, vB1); PG8_STAGE(PG8_SB(0, 1), b2 + hstepB, vB0, vB1); PG8_STAGE(PG8_SA(0, 0), a2, cA00, cA01);
            PG8_WAIT_V(8); PG8_WAIT_L(0); PG8_BAR; PG8_MMA(1, 0, At, B0); PG8_MMA(1, 1, At, B1); PG8_BAR; PG8_SCHED;
            PG8_LDB(B0, 1, 0); PG8_LDB(B1, 1, 1); PG8_SCHED; PG8_LDA(At, 1, 0); PG8_STAGE(PG8_SA(0, 1), a2, cA10, cA11);
            PG8_WAIT_V(8); PG8_WAIT_L(0); PG8_BAR; PG8_MMA(0, 0, At, B0); PG8_MMA(0, 1, At, B1); PG8_BAR; PG8_SCHED;
            PG8_LDA(At, 1, 1); PG8_STAGE(PG8_SB(1, 0), b3, vB0, vB1); PG8_STAGE(PG8_SB(1, 1), b3 + hstepB, vB0, vB1); PG8_STAGE(PG8_SA(1, 0), a3, cA00, cA01);
            PG8_WAIT_V(8); PG8_WAIT_L(0); PG8_BAR; PG8_MMA(1, 0, At, B0); PG8_MMA(1, 1, At, B1); PG8_BAR; PG8_SCHED;
        }
        if constexpr (Prob::FP8) asm volatile("s_nop 7\n\ts_nop 7\n\ts_nop 7" ::: "memory");
        if (wr == 0) PG8_BAR;
        E(acc, cur, wr, wc, fr, fq, lds_epi, wid, lane, epi_pm);
        if (!has_next) break;
        PG8_ACC_INIT(nxt);
        cur = nxt; cA = nA; cB = nB; ++ui;
        if (wr == 1) PG8_BAR;
    }
    PG8_WAIT_V(0);
    PG8_BAR;
#undef PG8_ACC_INIT
#undef PG8_SA
#undef PG8_SB
#undef PG8_STAGE
#undef PG8_LDA
#undef PG8_LDB
#undef PG8_MMA
#undef PG8_WAIT_V
#undef PG8_WAIT_L
#undef PG8_BAR
#undef PG8_SCHED
}
}
namespace att {
constexpr int PITCH = NQKV;
constexpr int SHM_V = 64 * 128 * 2, SHM_K = 64 * 128 * 2;
constexpr int LDS_Q = 2 * SHM_V + 2 * SHM_K, LDS_BYTES = LDS_Q + NWAVES * 8192;
constexpr int EPI_WS = 0, EPI_FLAG = NWAVES * 64 * 4;
constexpr float SCALE = 0.08838834764831845f;
constexpr float C2 = 1.4426950408889634f * SCALE;
#define KSWZ(row, colB) ((row) * 256 + ((colB) ^ (((row) & 7) << 4)))
#define SBAR() __builtin_amdgcn_sched_barrier(0)
__device__ __forceinline__ int v_st(int k, int c) { const int kk = (k & ~0xC) | ((k & 4) << 1) | ((k & 8) >> 1); return ((kk >> 3) * 4 + (c >> 5)) * 512 + ((kk & 7) * 32 + (c & 31)) * 2; }
__device__ __forceinline__ int v_rd_base(int lane) { return ((lane & 3) << 3) | (((lane >> 2) & 3) << 6) | (((lane >> 4) & 1) << 5) | (((lane >> 5) & 1) << 8); }
constexpr int v_rd_off(int d0, int ks, int half) { return d0 * 512 + ks * 4096 + half * 2048; }
__device__ __forceinline__ int crow(int r, int hi) { return (r & 3) + 8 * (r >> 2) + 4 * hi; }

template <int KB>
__device__ __forceinline__ void qkt(f32x16& p0, f32x16& p1, LAS const unsigned char* K_lds, LAS const unsigned char* q_lds, int r32, int hi) {
    p0 = f32x16{}; p1 = f32x16{};
    LAS const unsigned char* kb[4];
#pragma unroll
    for (int dd = 0; dd < 4; ++dd) kb[dd] = K_lds + KB * SHM_K + KSWZ(r32, (dd * 16 + hi * 8) * 2);
#pragma unroll
    for (int d0 = 0; d0 < 8; ++d0) { LAS const unsigned char* a = kb[d0 & 3] + (d0 >> 2) * 128;
        const bf16x8 b0 = *(LAS const bf16x8*)(a);
        const bf16x8 b1 = *(LAS const bf16x8*)(a + 32 * 256);
        const bf16x8 qv = *(LAS const bf16x8*)(q_lds + d0 * 1024);
        p0 = __builtin_amdgcn_mfma_f32_32x32x16_bf16(b0, qv, p0, 0, 0, 0);
        p1 = __builtin_amdgcn_mfma_f32_32x32x16_bf16(b1, qv, p1, 0, 0, 0);
        if ((d0 & 3) == 3) SBAR(); }
}
template <int VB>
__device__ __forceinline__ void pv_tile(f32x16* o, int vb0, bf16x8 pa0, bf16x8 pa1, bf16x8 pa2, bf16x8 pa3) {
#define TRRD(dst, off) asm volatile("ds_read_b64_tr_b16 %0, %1 offset:%2" : "=&v"(dst) : "v"(vb0), "i"(off) : "memory")
#define PV_D0(d0) do { s16x4 l0, l1, l2, l3, h0, h1, h2, h3; constexpr int b_ = VB * SHM_V + v_rd_off(d0, 0, 0); \
        TRRD(l0, b_); TRRD(h0, b_ + 2048); TRRD(l1, b_ + 4096); TRRD(h1, b_ + 6144); TRRD(l2, b_ + 8192); TRRD(h2, b_ + 10240); TRRD(l3, b_ + 12288); TRRD(h3, b_ + 14336); \
        asm volatile("s_waitcnt lgkmcnt(0)" ::: "memory"); SBAR(); \
        o[d0] = __builtin_amdgcn_mfma_f32_32x32x16_bf16(pa0, (bf16x8){l0[0], l0[1], l0[2], l0[3], h0[0], h0[1], h0[2], h0[3]}, o[d0], 0, 0, 0);   \
        o[d0] = __builtin_amdgcn_mfma_f32_32x32x16_bf16(pa1, (bf16x8){l1[0], l1[1], l1[2], l1[3], h1[0], h1[1], h1[2], h1[3]}, o[d0], 0, 0, 0);   \
        o[d0] = __builtin_amdgcn_mfma_f32_32x32x16_bf16(pa2, (bf16x8){l2[0], l2[1], l2[2], l2[3], h2[0], h2[1], h2[2], h2[3]}, o[d0], 0, 0, 0);   \
        o[d0] = __builtin_amdgcn_mfma_f32_32x32x16_bf16(pa3, (bf16x8){l3[0], l3[1], l3[2], l3[3], h3[0], h3[1], h3[2], h3[3]}, o[d0], 0, 0, 0); } while (0)
    PV_D0(0); PV_D0(1); PV_D0(2); PV_D0(3);
#undef PV_D0
#undef TRRD
}
__device__ __forceinline__ void pack_p(const f32x16& p0, const f32x16& p1, bf16x8& pa0, bf16x8& pa1, bf16x8& pa2, bf16x8& pa3) {
#define PK4(P, B_, OUT) do { unsigned a0 = cvt_pk_bf16(P[B_+0], P[B_+1]), a1 = cvt_pk_bf16(P[B_+2], P[B_+3]);                          \
        unsigned b0 = cvt_pk_bf16(P[B_+4], P[B_+5]), b1 = cvt_pk_bf16(P[B_+6], P[B_+7]);                                             \
        auto r0 = __builtin_amdgcn_permlane32_swap(a0, b0, false, false); auto r1 = __builtin_amdgcn_permlane32_swap(a1, b1, false, false); \
        u32x4 w = {r0[0], r1[0], r0[1], r1[1]}; OUT = *reinterpret_cast<bf16x8*>(&w); } while (0)
    PK4(p0, 0, pa0); PK4(p0, 8, pa1); PK4(p1, 0, pa2); PK4(p1, 8, pa3);
#undef PK4
}
__device__ __forceinline__ float lane_pair_sum(float v) {
    auto rr = __builtin_amdgcn_permlane32_swap(__float_as_uint(v), __float_as_uint(v), false, false);
    return __uint_as_float(rr[0]) + __uint_as_float(rr[1]);
}
__device__ __forceinline__ float lane_pair_max(float v) {
    auto rr = __builtin_amdgcn_permlane32_swap(__float_as_uint(v), __float_as_uint(v), false, false);
    return fmaxf(__uint_as_float(rr[0]), __uint_as_float(rr[1]));
}

#ifndef SB_EXIT_L2
#define SB_EXIT_L2 48.0f
#endif

template <int MODE>
__device__ __forceinline__ void attn_unit(const bf16* __restrict__ qkv, bf16* __restrict__ O, const float* __restrict__ kmean, int b, int h, int qb, LAS unsigned char* ldsl, LAS unsigned char* lepi, int wid) {
    const int lane = (int)__builtin_amdgcn_mbcnt_hi(~0u, __builtin_amdgcn_mbcnt_lo(~0u, 0u)), tid = wid * 64 + lane, r32 = lane & 31, hi = lane >> 5;
    const size_t rowbase = (size_t)b * SEQ;
    const bf16* Qp = qkv + (MODE == 0 ? 0 : 3 * 1024) + h * HD;
    const bf16* Kp = Qp + 1024 + rowbase * PITCH; const bf16* Vp = Qp + 2048 + rowbase * PITCH;
    LAS const unsigned char* K_lds = ldsl + 2 * SHM_V;
    LAS float* ws = (LAS float*)(lepi + EPI_WS) + wid * 64; LAS float* li_l = ws; LAS float* al_l = ws + 32;
    volatile LAS int* flags = (volatile LAS int*)(lepi + EPI_FLAG);
    LAS unsigned char* q_lds = ldsl + LDS_Q + wid * 8192 + lane * 16;
    const int qlo = qb * 256 + wid * 32, qpos = qlo + r32;
#pragma unroll
    for (int d0 = 0; d0 < 8; ++d0) *(LAS bf16x8*)(q_lds + d0 * 1024) = *(const bf16x8*)(Qp + (rowbase + qpos) * PITCH + d0 * 16 + hi * 8);
    const int NT = 4 * (qb + 1);
    const int vb0 = (int)(unsigned)(uintptr_t)ldsl + v_rd_base(lane);
    unsigned koff0, koff1, voff0, voff1;
    { const int b0 = tid * 16, b1 = b0 + 8192;
      { const int row = b0 >> 8, cb = b0 & 255, colB = cb ^ ((row & 7) << 4); koff0 = (unsigned)(row * PITCH + (colB >> 1)) * 2u; }
      { const int row = b1 >> 8, cb = b1 & 255, colB = cb ^ ((row & 7) << 4); koff1 = (unsigned)(row * PITCH + (colB >> 1)) * 2u; }
      { const int st = b0 >> 9, wb = b0 & 511, kk = (st >> 2) * 8 + (wb >> 6), c = (st & 3) * 32 + ((wb & 63) >> 1), k = (kk & ~0xC) | ((kk & 4) << 1) | ((kk & 8) >> 1); voff0 = (unsigned)(k * PITCH + c) * 2u; }
      { const int st = b1 >> 9, wb = b1 & 511, kk = (st >> 2) * 8 + (wb >> 6), c = (st & 3) * 32 + ((wb & 63) >> 1), k = (kk & ~0xC) | ((kk & 4) << 1) | ((kk & 8) >> 1); voff1 = (unsigned)(k * PITCH + c) * 2u; } }
    const unsigned ldsw = (unsigned)wid * 1024u;
#define TILE_KB(t) (MODE == 0 ? 64 * (NT - 1 - (t)) : 64 * (t))
#define DMA_TILE(kb_, bf) do { const char* kg_ = (const char*)(Kp + (size_t)(kb_) * PITCH); const char* vg_ = (const char*)(Vp + (size_t)(kb_) * PITCH); \
        __builtin_amdgcn_global_load_lds((const unsigned*)(vg_ + voff0), (LAS unsigned*)(ldsl + (bf) * SHM_V + ldsw), 16, 0, 0); \
        __builtin_amdgcn_global_load_lds((const unsigned*)(vg_ + voff1), (LAS unsigned*)(ldsl + (bf) * SHM_V + ldsw + 8192), 16, 0, 0); \
        __builtin_amdgcn_global_load_lds((const unsigned*)(kg_ + koff0), (LAS unsigned*)(ldsl + 2 * SHM_V + (bf) * SHM_K + ldsw), 16, 0, 0); \
        __builtin_amdgcn_global_load_lds((const unsigned*)(kg_ + koff1), (LAS unsigned*)(ldsl + 2 * SHM_V + (bf) * SHM_K + ldsw + 8192), 16, 0, 0); } while (0)
    DMA_TILE(TILE_KB(0), 0);
    unsigned selmask = 0u;
    if constexpr (MODE == 1) {
        float gate[15]; float m1 = -__builtin_inff(), m2 = m1, m3 = m1;
#pragma unroll
        for (int j = 0; j < 15; ++j) {
            gate[j] = -__builtin_inff();
            if (j < qb) {
                const float* km = kmean + ((size_t)((b * 8 + h) * 16 + j)) * HD + hi * 8;
                float a = 0.f;
#pragma unroll
                for (int d0 = 0; d0 < 8; ++d0) {
                    const f32x4 k0 = *(const f32x4*)(km + d0 * 16), k1 = *(const f32x4*)(km + d0 * 16 + 4);
                    const u32x4 qw = *(LAS const u32x4*)(q_lds + d0 * 1024);
                    a += bflo(qw[0]) * k0[0] + bfhi(qw[0]) * k0[1] + bflo(qw[1]) * k0[2] + bfhi(qw[1]) * k0[3]
                       + bflo(qw[2]) * k1[0] + bfhi(qw[2]) * k1[1] + bflo(qw[3]) * k1[2] + bfhi(qw[3]) * k1[3];
                }
                const float g = lane_pair_sum(a);
                gate[j] = g;
                const float t1 = fminf(m1, g); m1 = fmaxf(m1, g); const float t2 = fminf(m2, t1); m2 = fmaxf(m2, t1); m3 = fmaxf(m3, t2);
            }
        }
#pragma unroll
        for (int j = 0; j < 15; ++j) if (j < qb && gate[j] >= m3) selmask |= (1u << j);
    }
    float m_reg = -1e30f, l_reg = 0.f, cacc = 0.f; f32x16 o[4] = {};
    asm volatile("s_waitcnt vmcnt(0)" ::: "memory");
    __syncthreads();
    bool stop = false;
#define STEP(t, BUF) do { \
        const int kb_ = TILE_KB(t); const bool more_ = ((t) + 1 < NT); \
        if (more_) DMA_TILE(TILE_KB((t) + 1), (BUF) ^ 1); \
        SBAR(); \
        if constexpr (MODE == 1) { \
            const int jb_ = kb_ >> 8; bool act_; bool own_ = (jb_ == qb); const bool sel_ = ((selmask >> jb_) & 1u) != 0u; \
            if (own_) act_ = (kb_ <= qlo + 31); else act_ = __any(sel_); \
            if (act_) { \
                f32x16 p0, p1; qkt<BUF>(p0, p1, K_lds, q_lds, r32, hi); SBAR(); \
                const float NEG = -__builtin_inff(); \
                if (own_) { if (kb_ + 63 > qlo) { const int dq = qpos - kb_ - 4 * hi; \
                        _Pragma("unroll") for (int r = 0; r < 16; ++r) { const int c = (r & 3) + 8 * (r >> 2); if (c > dq) p0[r] = NEG; if (c + 32 > dq) p1[r] = NEG; } } } \
                else if (!sel_) { _Pragma("unroll") for (int r = 0; r < 16; ++r) { p0[r] = NEG; p1[r] = NEG; } } \
                float pmax = p0[0]; _Pragma("unroll") for (int r = 1; r < 16; ++r) pmax = fmaxf(pmax, p0[r]); _Pragma("unroll") for (int r = 0; r < 16; ++r) pmax = fmaxf(pmax, p1[r]); \
                pmax = lane_pair_max(pmax); \
                float mn, alpha; \
                if (__all((pmax - m_reg) * SCALE <= 8.0f)) { mn = m_reg; alpha = 1.f; } \
                else { mn = fmaxf(m_reg, pmax); alpha = __builtin_amdgcn_exp2f((m_reg - mn) * C2); m_reg = mn; } \
                if (__any(alpha < 1.f)) { if (hi == 0) al_l[r32] = alpha; asm volatile("s_waitcnt lgkmcnt(0)" ::: "memory"); \
                    _Pragma("unroll") for (int d_ = 0; d_ < 4; ++d_) _Pragma("unroll") for (int r = 0; r < 16; ++r) o[d_][r] *= al_l[crow(r, hi)]; } \
                const float mnL = -mn * C2; float ps = 0.f; \
                _Pragma("unroll") for (int r = 0; r < 16; ++r) { p0[r] = __builtin_amdgcn_exp2f(fmaf(p0[r], C2, mnL)); p1[r] = __builtin_amdgcn_exp2f(fmaf(p1[r], C2, mnL)); ps += p0[r] + p1[r]; } \
                ps = lane_pair_sum(ps); l_reg = l_reg * alpha + ps; \
                bf16x8 pa0, pa1, pa2, pa3; pack_p(p0, p1, pa0, pa1, pa2, pa3); SBAR(); \
                pv_tile<BUF>(o, vb0, pa0, pa1, pa2, pa3); \
            } \
        } else { \
            const bool act_ = (kb_ < qlo + 31); \
            if (act_) { \
                f32x16 p0, p1; qkt<BUF>(p0, p1, K_lds, q_lds, r32, hi); SBAR(); \
                f32x16 k0, k1; \
                _Pragma("unroll") for (int r = 0; r < 16; ++r) { \
                    { const float z = p0[r] * C2, e = __builtin_amdgcn_exp2f(-fabsf(z)), sp = fmaxf(z, 0.f) + __builtin_amdgcn_logf(1.0f + e); k0[r] = -sp; p0[r] = z - sp; } \
                    { const float z = p1[r] * C2, e = __builtin_amdgcn_exp2f(-fabsf(z)), sp = fmaxf(z, 0.f) + __builtin_amdgcn_logf(1.0f + e); k1[r] = -sp; p1[r] = z - sp; } } \
                if (kb_ + 63 >= qlo) { const int dq = qpos - kb_ - 4 * hi; const float NEG = -__builtin_inff(); \
                    _Pragma("unroll") for (int r = 0; r < 16; ++r) { const int c = (r & 3) + 8 * (r >> 2); if (c >= dq) { p0[r] = NEG; k0[r] = 0.f; } if (c + 32 >= dq) { p1[r] = NEG; k1[r] = 0.f; } } } \
                SBAR(); float run = cacc; \
                _Pragma("unroll") for (int k = 7; k >= 0; --k) { const int g4 = 4 * (k & 3); \
                    const float s_ = (k < 4) ? ((k0[g4] + k0[g4 + 1]) + (k0[g4 + 2] + k0[g4 + 3])) : ((k1[g4] + k1[g4 + 1]) + (k1[g4 + 2] + k1[g4 + 3])); \
                    auto rr = __builtin_amdgcn_permlane32_swap(__float_as_uint(s_), __float_as_uint(s_), false, false); \
                    const float lo_ = __uint_as_float(rr[0]), hi_ = __uint_as_float(rr[1]); const float sg = run + (hi ? 0.f : hi_); \
                    if (k < 4) { const float e3 = sg, e2 = e3 + k0[g4 + 3], e1 = e2 + k0[g4 + 2], e0 = e1 + k0[g4 + 1]; \
                        p0[g4 + 3] = __builtin_amdgcn_exp2f(p0[g4 + 3] + e3); p0[g4 + 2] = __builtin_amdgcn_exp2f(p0[g4 + 2] + e2); p0[g4 + 1] = __builtin_amdgcn_exp2f(p0[g4 + 1] + e1); p0[g4] = __builtin_amdgcn_exp2f(p0[g4] + e0); } \
                    else { const float e3 = sg, e2 = e3 + k1[g4 + 3], e1 = e2 + k1[g4 + 2], e0 = e1 + k1[g4 + 1]; \
                        p1[g4 + 3] = __builtin_amdgcn_exp2f(p1[g4 + 3] + e3); p1[g4 + 2] = __builtin_amdgcn_exp2f(p1[g4 + 2] + e2); p1[g4 + 1] = __builtin_amdgcn_exp2f(p1[g4 + 1] + e1); p1[g4] = __builtin_amdgcn_exp2f(p1[g4] + e0); } \
                    run += lo_ + hi_; } \
                cacc = run; \
                bf16x8 pa0, pa1, pa2, pa3; pack_p(p0, p1, pa0, pa1, pa2, pa3); SBAR(); \
                pv_tile<BUF>(o, vb0, pa0, pa1, pa2, pa3); \
            } \
            if (SB_EXIT_L2 > 0.f) { const bool done_ = __all(cacc < -SB_EXIT_L2); if (lane == 0) flags[((t) & 1) * 8 + wid] = done_ ? 1 : 0; } \
        } \
        asm volatile("s_waitcnt vmcnt(0)" ::: "memory"); \
        __syncthreads(); \
        if (MODE == 0 && SB_EXIT_L2 > 0.f) { int all_ = 1; _Pragma("unroll") for (int w_ = 0; w_ < 8; ++w_) all_ &= flags[((t) & 1) * 8 + w_]; stop = (all_ != 0); } \
    } while (0)
    for (int t = 0; t < NT; t += 2) {
        STEP(t, 0);
        if (stop) break;
        STEP(t + 1, 1);
        if (stop) break;
    }
#undef STEP
#undef DMA_TILE
#undef TILE_KB
    float rli[16];
    if constexpr (MODE == 1) {
        if (hi == 0) li_l[r32] = l_reg; asm volatile("s_waitcnt lgkmcnt(0)" ::: "memory");
#pragma unroll
        for (int r = 0; r < 16; ++r) rli[r] = __builtin_amdgcn_rcpf(li_l[crow(r, hi)]);
    } else {
#pragma unroll
        for (int r = 0; r < 16; ++r) rli[r] = 1.0f;
    }
    int r32o = r32; asm volatile("" : "+v"(r32o));
    bf16* Ow = O + (rowbase + qlo) * DM + (MODE == 0 ? 0 : 1024) + h * HD + r32o;
#pragma unroll
    for (int r = 0; r < 16; ++r) { const int orow = crow(r, hi);
#pragma unroll
        for (int d0 = 0; d0 < 4; ++d0) { const float v = o[d0][r] * rli[r]; const float vn = __shfl_xor(v, 1);
            if ((r32 & 1) == 0) *(unsigned*)(Ow + (size_t)orow * DM + d0 * 32) = cvt_pk_bf16(v, vn); } }
    __syncthreads();
}
#undef KSWZ
}
namespace epi {
using pg8::Unit;
typedef f32x4 Acc[2][2][4][2];
#define NEXT_ROW(roff, m, LD) do { roff += (size_t)((m) == 3 ? 80 : 16) * (LD); asm volatile("" : "+v"(roff) :: "memory"); } while (0)
#define ST_NT(ptr, val) (*(ptr) = (val))
#define EPI_BAR() do { asm volatile("s_waitcnt lgkmcnt(0)" ::: "memory"); __builtin_amdgcn_s_barrier(); asm volatile("" ::: "memory"); } while (0)

template <int NPARTS>
__device__ __forceinline__ void row_rstd_to_lds(LAS float* S, const float* parts, int pm, int tid, int& cpm) {
    if (cpm == pm) return;
    cpm = pm;
    if (tid < 256) { float v[NPARTS];
#pragma unroll
        for (int p = 0; p < NPARTS; ++p) v[p] = parts[(size_t)p * T + pm * 256 + tid];
        float s = v[0];
#pragma unroll
        for (int p = 1; p < NPARTS; ++p) s += v[p];
        S[tid] = 1.0f / sqrtf(s * (1.0f / DM) + EPS); }
    EPI_BAR();
}

struct EpiQKV {
    static constexpr bool PERM = true, ACC_INIT = false;
    bf16* out; const float* ssq0; const float* gains; const float* rope; float* kmean;
    __device__ __forceinline__ void operator()(Acc& acc, const Unit& u, int wr, int wc, int fr, int fq, LAS unsigned char* le, int wid, int lane, int& cpm) const {
        LAS float* S = (LAS float*)le; LAS float* P = (LAS float*)(le + 1024);
        const int tid = wid * 64 + lane, row0 = u.pm * 256;
        row_rstd_to_lds<1>(S, ssq0, u.pm, tid, cpm);
        const int type = u.pn >> 2;
        const bool is_v = (type == 2 || type == 5);
        float rs[2][4];
#pragma unroll
        for (int ai = 0; ai < 2; ++ai)
#pragma unroll
            for (int m = 0; m < 4; ++m) rs[ai][m] = S[ai * 128 + wr * 64 + m * 16 + fr];
#pragma unroll
        for (int ai = 0; ai < 2; ++ai)
#pragma unroll
            for (int bj = 0; bj < 2; ++bj)
#pragma unroll
                for (int m = 0; m < 4; ++m)
#pragma unroll
                    for (int n = 0; n < 2; ++n) acc[ai][bj][m][n] = acc[ai][bj][m][n] * rs[ai][m];
        if (!is_v) {
#pragma unroll
            for (int ai = 0; ai < 2; ++ai)
#pragma unroll
                for (int m = 0; m < 4; ++m)
#pragma unroll
                    for (int bj = 0; bj < 2; ++bj) {
                        const f32x4 a = acc[ai][bj][m][0], b = acc[ai][bj][m][1];
                        float s = (a[0] * a[0] + a[1] * a[1]) + (a[2] * a[2] + a[3] * a[3]) + (b[0] * b[0] + b[1] * b[1]) + (b[2] * b[2] + b[3] * b[3]);
                        s += __shfl_xor(s, 16); s += __shfl_xor(s, 32);
                        if (fq == 0) P[((ai * 128 + wr * 64 + m * 16 + fr) * 2 + bj) * 4 + wc] = s;
                    }
            EPI_BAR();
            const float* gn = gains + ((type == 0) ? 0 : (type == 1) ? 128 : (type == 3) ? 256 : 384) + wc * 32 + fq * 8;
            const f32x4 g0 = *(const f32x4*)gn, g1 = *(const f32x4*)(gn + 4);
#pragma unroll
            for (int ai = 0; ai < 2; ++ai)
#pragma unroll
                for (int m = 0; m < 4; ++m)
#pragma unroll
                    for (int bj = 0; bj < 2; ++bj) {
                        const f32x4 pp = *(const LAS f32x4*)(P + ((ai * 128 + wr * 64 + m * 16 + fr) * 2 + bj) * 4);
                        const float rn = 1.0f / sqrtf(((pp[0] + pp[1]) + (pp[2] + pp[3])) * (1.0f / HD) + EPS);
                        acc[ai][bj][m][0] = acc[ai][bj][m][0] * rn * g0; acc[ai][bj][m][1] = acc[ai][bj][m][1] * rn * g1;
                    }
            if (type >= 3 && wc == 0) {
#pragma unroll
                for (int ai = 0; ai < 2; ++ai)
#pragma unroll
                    for (int m = 0; m < 4; ++m) {
                        const int pos = (row0 + ai * 128 + wr * 64 + m * 16 + fr) & (SEQ - 1);
                        const float* cp = rope + (size_t)pos * 16 + (fq & 1) * 8;
                        const f32x4 c0 = *(const f32x4*)cp, c1 = *(const f32x4*)(cp + 4), s0 = *(const f32x4*)(cp + SEQ * 16), s1 = *(const f32x4*)(cp + SEQ * 16 + 4);
#pragma unroll
                        for (int bj = 0; bj < 2; ++bj) {
                            f32x4 a = acc[ai][bj][m][0], b = acc[ai][bj][m][1], oa, ob;
#pragma unroll
                            for (int j = 0; j < 4; ++j) { oa[j] = __shfl_xor(a[j], 32); ob[j] = __shfl_xor(b[j], 32); }
                            if (fq < 2) { a = a * c0 - oa * s0; b = b * c1 - ob * s1; } else { a = a * c0 + oa * s0; b = b * c1 + ob * s1; }
                            acc[ai][bj][m][0] = a; acc[ai][bj][m][1] = b;
                        }
                    }
            }
        }
        if (type == 4) {
            float cs[2][2][4];
#pragma unroll
            for (int bj = 0; bj < 2; ++bj)
#pragma unroll
                for (int n = 0; n < 2; ++n)
#pragma unroll
                    for (int j = 0; j < 4; ++j) { float s = 0.f;
#pragma unroll
                        for (int ai = 0; ai < 2; ++ai)
#pragma unroll
                            for (int m = 0; m < 4; ++m) s += acc[ai][bj][m][n][j];
                        s += __shfl_xor(s, 1); s += __shfl_xor(s, 2); s += __shfl_xor(s, 4); s += __shfl_xor(s, 8);
                        cs[bj][n][j] = s; }
            LAS float* KM = P;
            EPI_BAR();
            if (wr == 1 && fr == 0) {
#pragma unroll
                for (int bj = 0; bj < 2; ++bj)
#pragma unroll
                    for (int n = 0; n < 2; ++n) *(LAS f32x4*)(KM + ((wc * 4 + fq) * 16 + bj * 8 + n * 4)) = (f32x4){cs[bj][n][0], cs[bj][n][1], cs[bj][n][2], cs[bj][n][3]}; }
            EPI_BAR();
            if (wr == 0 && fr == 0) { const int b = u.pm >> 4, blk = u.pm & 15;
#pragma unroll
                for (int bj = 0; bj < 2; ++bj) { const int h = 2 * (u.pn - 16) + bj; float* kp = kmean + ((size_t)((b * 8 + h) * 16 + blk)) * HD + wc * 32 + fq * 8;
#pragma unroll
                    for (int n = 0; n < 2; ++n) { const f32x4 o = *(const LAS f32x4*)(KM + ((wc * 4 + fq) * 16 + bj * 8 + n * 4));
                        *(f32x4*)(kp + n * 4) = (f32x4){(cs[bj][n][0] + o[0]) * (1.0f / 256.0f), (cs[bj][n][1] + o[1]) * (1.0f / 256.0f), (cs[bj][n][2] + o[2]) * (1.0f / 256.0f), (cs[bj][n][3] + o[3]) * (1.0f / 256.0f)}; } } }
        }
        size_t roff = (size_t)(row0 + wr * 64 + fr) * NQKV + u.pn * 256 + wc * 32 + fq * 8;
#pragma unroll
        for (int ai = 0; ai < 2; ++ai)
#pragma unroll
            for (int m = 0; m < 4; ++m) { bf16* rowp = out + roff;
#pragma unroll
                for (int bj = 0; bj < 2; ++bj) { const f32x4 v0 = acc[ai][bj][m][0], v1 = acc[ai][bj][m][1];
                    u32x4 w; w.x = cvt_pk_bf16(v0[0], v0[1]); w.y = cvt_pk_bf16(v0[2], v0[3]); w.z = cvt_pk_bf16(v1[0], v1[1]); w.w = cvt_pk_bf16(v1[2], v1[3]);
                    ST_NT((u32x4*)(rowp + bj * 128), w); }
                NEXT_ROW(roff, m, NQKV); }
    }
};

template <bool NEXT, bool F8 = false> struct EpiResid {
    static constexpr bool PERM = false, ACC_INIT = true;
    const bf16* base; float* out; bf16* outb; float* ssq_part;
    __device__ __forceinline__ void init(Acc& acc, const Unit& u, int wr, int wc, int fr, int fq) const {
        const bf16* bp = base + (size_t)(u.pm * 256 + wr * 64 + fr) * DM + u.pn * 256 + wc * 32 + fq * 4;
#pragma unroll
        for (int ai = 0; ai < 2; ++ai)
#pragma unroll
            for (int m = 0; m < 4; ++m)
#pragma unroll
                for (int bj = 0; bj < 2; ++bj)
#pragma unroll
                    for (int n = 0; n < 2; ++n) { const u32x2 w = *(const u32x2*)(bp + (size_t)(ai * 128 + m * 16) * DM + bj * 128 + n * 16); acc[ai][bj][m][n] = (f32x4){bflo(w.x), bfhi(w.x), bflo(w.y), bfhi(w.y)}; if constexpr (F8) acc[ai][bj][m][n] = acc[ai][bj][m][n] * 4096.0f; }
    }
    __device__ __forceinline__ void operator()(Acc& acc, const Unit& u, int wr, int wc, int fr, int fq, LAS unsigned char* le, int wid, int lane, int& cpm) const {
        LAS float* P = (LAS float*)le;
        const int tid = wid * 64 + lane, row0 = u.pm * 256, col0 = u.pn * 256 + wc * 32 + fq * 4;
        size_t roff = (size_t)(row0 + wr * 64 + fr) * DM + col0;
#pragma unroll
        for (int ai = 0; ai < 2; ++ai)
#pragma unroll
            for (int m = 0; m < 4; ++m) { const int rt = ai * 128 + wr * 64 + m * 16 + fr; const size_t off = roff; float s = 0.f;
#pragma unroll
                for (int bj = 0; bj < 2; ++bj)
#pragma unroll
                    for (int n = 0; n < 2; ++n) { f32x4 v = acc[ai][bj][m][n]; if constexpr (F8) v = v * (1.0f / 4096.0f);
                        if constexpr (NEXT) { u32x2 w; w.x = cvt_pk_bf16(v[0], v[1]); w.y = cvt_pk_bf16(v[2], v[3]); *(u32x2*)(outb + off + bj * 128 + n * 16) = w;
                            const float r0 = bflo(w.x), r1 = bfhi(w.x), r2 = bflo(w.y), r3 = bfhi(w.y); s += (r0 * r0 + r1 * r1) + (r2 * r2 + r3 * r3); }
                        else { u32x2 w; w.x = cvt_pk_bf16(v[0], v[1]); w.y = cvt_pk_bf16(v[2], v[3]); *(u32x2*)(outb + off + bj * 128 + n * 16) = w; } }
                if constexpr (NEXT) { s += __shfl_xor(s, 16); s += __shfl_xor(s, 32); if (fq == 0) P[rt * 4 + wc] = s; }
                NEXT_ROW(roff, m, DM); }
        if constexpr (NEXT) { EPI_BAR();
        if (tid < 256) { const f32x4 pp = *(const LAS f32x4*)(P + tid * 4); ssq_part[(size_t)u.pn * T + row0 + tid] = (pp[0] + pp[1]) + (pp[2] + pp[3]); } }
    }
};

template <bool MOE> struct EpiSwiGLU {
    static constexpr bool PERM = true, ACC_INIT = false;
    bf16* out; const float* parts; int nparts; const float* slot_rstd;
    __device__ __forceinline__ void operator()(Acc& acc, const Unit& u, int wr, int wc, int fr, int fq, LAS unsigned char* le, int wid, int lane, int& cpm) const {
        LAS float* S = (LAS float*)le; const int tid = wid * 64 + lane, row0 = u.pm * 256;
        if constexpr (MOE) { if (cpm != u.pm) { cpm = u.pm; if (tid < 256) S[tid] = slot_rstd[row0 + tid]; EPI_BAR(); } }
        else row_rstd_to_lds<8>(S, parts, u.pm, tid, cpm);
        size_t roff = (size_t)(row0 + wr * 64 + fr) * DFF + u.pn * 128 + wc * 32 + fq * 8;
#pragma unroll
        for (int ai = 0; ai < 2; ++ai)
#pragma unroll
            for (int m = 0; m < 4; ++m) { const int rt = ai * 128 + wr * 64 + m * 16 + fr; const float rs = S[rt];
                const f32x4 ga = acc[ai][0][m][0] * rs, gb = acc[ai][0][m][1] * rs, ua = acc[ai][1][m][0] * rs, ub = acc[ai][1][m][1] * rs; f32x4 ha, hb;
#pragma unroll
                for (int j = 0; j < 4; ++j) { ha[j] = ga[j] * fast_sigmoid(ga[j]) * ua[j]; hb[j] = gb[j] * fast_sigmoid(gb[j]) * ub[j]; }
                u32x4 w; w.x = cvt_pk_bf16(ha[0], ha[1]); w.y = cvt_pk_bf16(ha[2], ha[3]); w.z = cvt_pk_bf16(hb[0], hb[1]); w.w = cvt_pk_bf16(hb[2], hb[3]);
                ST_NT((u32x4*)(out + roff), w);
                NEXT_ROW(roff, m, DFF); }
    }
};

__device__ __forceinline__ unsigned pk4_fp8(float a, float b, float c, float d) {
    a = __builtin_amdgcn_fmed3f(a, -448.f, 448.f); b = __builtin_amdgcn_fmed3f(b, -448.f, 448.f); c = __builtin_amdgcn_fmed3f(c, -448.f, 448.f); d = __builtin_amdgcn_fmed3f(d, -448.f, 448.f);
    unsigned w = 0u; w = __builtin_amdgcn_cvt_pk_fp8_f32(a, b, w, false); w = __builtin_amdgcn_cvt_pk_fp8_f32(c, d, w, true); return w;
}
constexpr float W_UP_SCALE = 256.f, W_DN_SCALE = 512.f, H_SCALE = 8.f, Y_SCALE = 16.f;
struct EpiSwiGLUFp8 {
    static constexpr bool PERM = true, ACC_INIT = false;
    unsigned char* out; const float* slot_rstd;
    __device__ __forceinline__ void operator()(Acc& acc, const Unit& u, int wr, int wc, int fr, int fq, LAS unsigned char* le, int wid, int lane, int& cpm) const {
        LAS float* S = (LAS float*)le; const int tid = wid * 64 + lane, row0 = u.pm * 256;
        if (cpm != u.pm) { cpm = u.pm; if (tid < 256) S[tid] = slot_rstd[row0 + tid] * (1.0f / W_UP_SCALE); EPI_BAR(); }
        size_t roff = (size_t)(row0 + wr * 64 + fr) * DFF + u.pn * 128 + wc * 32 + fq * 8;
#pragma unroll
        for (int ai = 0; ai < 2; ++ai)
#pragma unroll
            for (int m = 0; m < 4; ++m) { const int rt = ai * 128 + wr * 64 + m * 16 + fr; const float rs = S[rt];
                const float rl = rs * -1.4426950408889634f, kk = rs * rs * H_SCALE; f32x4 ha, hb;
#pragma unroll
                for (int j = 0; j < 4; ++j) { const float g0 = acc[ai][0][m][0][j], g1 = acc[ai][0][m][1][j];
                    ha[j] = (g0 * acc[ai][1][m][0][j]) * kk * __builtin_amdgcn_rcpf(1.0f + __builtin_amdgcn_exp2f(g0 * rl));
                    hb[j] = (g1 * acc[ai][1][m][1][j]) * kk * __builtin_amdgcn_rcpf(1.0f + __builtin_amdgcn_exp2f(g1 * rl)); }
                u32x2 w; w.x = pk4_fp8(ha[0], ha[1], ha[2], ha[3]); w.y = pk4_fp8(hb[0], hb[1], hb[2], hb[3]);
                ST_NT((u32x2*)(out + roff), w);
                NEXT_ROW(roff, m, DFF); }
    }
};

struct EpiRecIn {
    static constexpr bool PERM = true, ACC_INIT = false;
    bf16* xbr; bf16* gg; const float* parts;
    __device__ __forceinline__ void operator()(Acc& acc, const Unit& u, int wr, int wc, int fr, int fq, LAS unsigned char* le, int wid, int lane, int& cpm) const {
        LAS float* S = (LAS float*)le; const int tid = wid * 64 + lane, row0 = u.pm * 256;
        row_rstd_to_lds<8>(S, parts, u.pm, tid, cpm);
        const bool is_gate = u.pn >= 8; bf16* dst = is_gate ? gg : xbr; const int colt = (u.pn & 7) * 256 + wc * 32 + fq * 8;
        size_t roff = (size_t)(row0 + wr * 64 + fr) * DM + colt;
#pragma unroll
        for (int ai = 0; ai < 2; ++ai)
#pragma unroll
            for (int m = 0; m < 4; ++m) { const int rt = ai * 128 + wr * 64 + m * 16 + fr; const float rs = S[rt];
#pragma unroll
                for (int bj = 0; bj < 2; ++bj) { f32x4 v0 = acc[ai][bj][m][0] * rs, v1 = acc[ai][bj][m][1] * rs;
                    if (is_gate) {
#pragma unroll
                        for (int j = 0; j < 4; ++j) { { const float x = v0[j]; v0[j] = x * fast_sigmoid(1.5957691216057308f * (x + 0.044715f * x * x * x)); }
                                                      { const float x = v1[j]; v1[j] = x * fast_sigmoid(1.5957691216057308f * (x + 0.044715f * x * x * x)); } } }
                    u32x4 w; w.x = cvt_pk_bf16(v0[0], v0[1]); w.y = cvt_pk_bf16(v0[2], v0[3]); w.z = cvt_pk_bf16(v1[0], v1[1]); w.w = cvt_pk_bf16(v1[2], v1[3]);
                    ST_NT((u32x4*)(dst + roff + bj * 128), w); }
                NEXT_ROW(roff, m, DM); }
    }
};

#define DPP_SHR(x, ctrl) __builtin_bit_cast(float, __builtin_amdgcn_update_dpp(0, __builtin_bit_cast(int, (x)), (ctrl), 0xf, 0xf, true))
struct EpiGates {
    static constexpr bool PERM = false, ACC_INIT = false, APERM = true;
    const bf16* xc; const float* b_a; const float* b_i; const float* spl; unsigned* au; float* scanA; float* scanH;
    __device__ __forceinline__ void operator()(Acc& acc, const Unit& u, int wr, int wc, int fr, int fq, LAS unsigned char* le, int, int, int&) const {
        const int row0 = u.pm * 256, ch0 = (u.pn >> 1) * 256 + (u.pn & 1) * 128 + wc * 32 + fq * 4;
        size_t roff = (size_t)(row0 + wr * 64 + 4 * fr) * DM + ch0;
        LAS float* X = (LAS float*)le;
        u32x2 xpre[2][4][2];
#pragma unroll
        for (int ai = 0; ai < 2; ++ai)
#pragma unroll
            for (int m = 0; m < 4; ++m)
#pragma unroll
                for (int n = 0; n < 2; ++n) xpre[ai][m][n] = *(const u32x2*)(xc + roff + (size_t)(ai * 128 + m) * DM + n * 16);
        float RA[2][2][4], RH[2][2][4];
#pragma unroll
        for (int ai = 0; ai < 2; ++ai) {
#pragma unroll
            for (int m = 0; m < 4; ++m) {
#pragma unroll
                for (int n = 0; n < 2; ++n) { const size_t off = roff + n * 16;
                    const f32x4 ba = *(const f32x4*)(b_a + ch0 + n * 16), bi = *(const f32x4*)(b_i + ch0 + n * 16), sl = *(const f32x4*)(spl + ch0 + n * 16);
                    const u32x2 xw = xpre[ai][m][n]; const float xv[4] = {bflo(xw.x), bfhi(xw.x), bflo(xw.y), bfhi(xw.y)};
                    const f32x4 ra = acc[ai][0][m][n] + ba, ri = acc[ai][1][m][n] + bi; u32x4 pk;
#pragma unroll
                    for (int j = 0; j < 4; ++j) { const float r = fast_sigmoid(ra[j]), ig = fast_sigmoid(ri[j]);
                        const float la = bflo(cvt_pk_bf16(-8.0f * r * sl[j], 0.f));
                        const float a = fast_exp(la); const float x2 = 2.0f * la;
                        const float ser = -x2 * (1.0f + x2 * (0.5f + x2 * (1.0f / 6.0f + x2 * (1.0f / 24.0f + x2 * (1.0f / 120.0f)))));
                        const float om = (x2 > -0.3f) ? ser : (1.0f - a * a);
                        const unsigned w = cvt_pk_bf16(la, __builtin_amdgcn_sqrtf(om) * (ig * xv[j])); pk[j] = w;
                        const float uu = bfhi(w);
                        if (m == 0) { RA[ai][n][j] = a; RH[ai][n][j] = uu; } else { RH[ai][n][j] = a * RH[ai][n][j] + uu; RA[ai][n][j] = RA[ai][n][j] * a; } }
                    ST_NT((u32x4*)(au + off), pk); }
                roff += (size_t)(m == 3 ? 125 : 1) * DM; asm volatile("" : "+v"(roff) :: "memory"); }
#pragma unroll
            for (int n = 0; n < 2; ++n)
#pragma unroll
                for (int j = 0; j < 4; ++j) { float A = RA[ai][n][j], H = RH[ai][n][j];
                    { const float Ap = DPP_SHR(A, 0x111), Hp = DPP_SHR(H, 0x111); H = A * Hp + H; A = Ap * A; }
                    { const float Ap = DPP_SHR(A, 0x112), Hp = DPP_SHR(H, 0x112); H = A * Hp + H; A = Ap * A; }
                    { const float Ap = DPP_SHR(A, 0x114), Hp = DPP_SHR(H, 0x114); H = A * Hp + H; A = Ap * A; }
                    { const float Ap = DPP_SHR(A, 0x118), Hp = DPP_SHR(H, 0x118); H = A * Hp + H; A = Ap * A; }
                    RA[ai][n][j] = A; RH[ai][n][j] = H; }
            if (wr == 1 && fr == 15) {
#pragma unroll
                for (int n = 0; n < 2; ++n)
#pragma unroll
                    for (int j = 0; j < 4; ++j) { LAS float* xp = X + ((((ai * 4 + wc) * 4 + fq) * 2 + n) * 4 + j) * 2; xp[0] = RA[ai][n][j]; xp[1] = RH[ai][n][j]; } }
        }
        EPI_BAR();
        if (wr == 0 && fr == 15) { const int b = u.pm >> 4, c2 = (u.pm & 15) * 2;
#pragma unroll
            for (int ai = 0; ai < 2; ++ai)
#pragma unroll
                for (int n = 0; n < 2; ++n) { f32x4 oa, oh;
#pragma unroll
                    for (int j = 0; j < 4; ++j) { const LAS float* xp = X + ((((ai * 4 + wc) * 4 + fq) * 2 + n) * 4 + j) * 2; const float A2 = xp[0], H2 = xp[1];
                        oa[j] = RA[ai][n][j] * A2; oh[j] = A2 * RH[ai][n][j] + H2; }
                    const size_t o = (size_t)(b * 32 + c2 + ai) * DM + ch0 + n * 16; *(f32x4*)(scanA + o) = oa; *(f32x4*)(scanH + o) = oh; } }
    }
};
#define DPP_SHR_ID(x, idv, ctrl) __builtin_bit_cast(float, __builtin_amdgcn_update_dpp(__builtin_bit_cast(int, (float)(idv)), __builtin_bit_cast(int, (x)), (ctrl), 0xf, 0xf, false))
struct EpiGatesScan {
    static constexpr bool PERM = false, ACC_INIT = false, APERM = true;
    const bf16* xc; const float* b_a; const float* b_i; const float* spl; const bf16* gg; bf16* yb; float* agg; unsigned* flags;
    __device__ __forceinline__ void operator()(Acc& acc, const Unit& u, int wr, int wc, int fr_, int fq_, LAS unsigned char* le, int wid, int lane, int&) const {
        asm volatile("" : "+v"(lane));
        const int fr = lane & 15, fq = lane >> 4;
        const int row0 = u.pm * 256, chb = (u.pn >> 1) * 256 + (u.pn & 1) * 128, ch0 = chb + wc * 32 + fq * 4, tid = wid * 64 + lane;
        size_t roff = (size_t)(row0 + wr * 64 + 4 * fr) * DM + ch0;
        LAS float* X = (LAS float*)le;
        LAS float* C0 = X + 1024;
        u32x2 xpre[2][4][2];
#pragma unroll
        for (int ai = 0; ai < 2; ++ai)
#pragma unroll
            for (int m = 0; m < 4; ++m)
#pragma unroll
                for (int n = 0; n < 2; ++n) xpre[ai][m][n] = *(const u32x2*)(xc + roff + (size_t)(ai * 128 + m) * DM + n * 16);
        float EA[2][2][4], EH[2][2][4];
#pragma unroll
        for (int ai = 0; ai < 2; ++ai) {
#pragma unroll
            for (int m = 0; m < 4; ++m) {
#pragma unroll
                for (int n = 0; n < 2; ++n) {
                    const f32x4 ba = *(const f32x4*)(b_a + ch0 + n * 16), bi = *(const f32x4*)(b_i + ch0 + n * 16), sl = *(const f32x4*)(spl + ch0 + n * 16);
                    const u32x2 xw = xpre[ai][m][n]; const float xv[4] = {bflo(xw.x), bfhi(xw.x), bflo(xw.y), bfhi(xw.y)};
                    const f32x4 ra = acc[ai][0][m][n] + ba, ri = acc[ai][1][m][n] + bi;
#pragma unroll
                    for (int j = 0; j < 4; ++j) { const float r = fast_sigmoid(ra[j]), ig = fast_sigmoid(ri[j]);
                        const float la = -8.0f * r * sl[j];
                        const float a = fast_exp(la); const float x2 = 2.0f * la;
                        const float ser = -x2 * (1.0f + x2 * (0.5f + x2 * (1.0f / 6.0f + x2 * (1.0f / 24.0f + x2 * (1.0f / 120.0f)))));
                        const float om = (x2 > -0.3f) ? ser : (1.0f - a * a);
                        const float uu = __builtin_amdgcn_sqrtf(om) * (ig * xv[j]);
                        if (m == 0) { acc[ai][0][m][n][j] = a; acc[ai][1][m][n][j] = uu; }
                        else { acc[ai][1][m][n][j] = a * acc[ai][1][m - 1][n][j] + uu; acc[ai][0][m][n][j] = acc[ai][0][m - 1][n][j] * a; } } } }
#pragma unroll
            for (int n = 0; n < 2; ++n)
#pragma unroll
                for (int j = 0; j < 4; ++j) { float A = acc[ai][0][3][n][j], H = acc[ai][1][3][n][j];
                    { const float Ap = DPP_SHR_ID(A, 1.0f, 0x111), Hp = DPP_SHR_ID(H, 0.0f, 0x111); H = A * Hp + H; A = Ap * A; }
                    { const float Ap = DPP_SHR_ID(A, 1.0f, 0x112), Hp = DPP_SHR_ID(H, 0.0f, 0x112); H = A * Hp + H; A = Ap * A; }
                    { const float Ap = DPP_SHR_ID(A, 1.0f, 0x114), Hp = DPP_SHR_ID(H, 0.0f, 0x114); H = A * Hp + H; A = Ap * A; }
                    { const float Ap = DPP_SHR_ID(A, 1.0f, 0x118), Hp = DPP_SHR_ID(H, 0.0f, 0x118); H = A * Hp + H; A = Ap * A; }
                    EA[ai][n][j] = DPP_SHR_ID(A, 1.0f, 0x111); EH[ai][n][j] = DPP_SHR_ID(H, 0.0f, 0x111);
                    if (fr == 15) { LAS float* xp = X + (((ai * 2 + wr) * 128) + wc * 32 + n * 16 + fq * 4 + j) * 2; xp[0] = A; xp[1] = H; } }
        }
        u32x2 gpre[2][4][2];
#pragma unroll
        for (int m = 0; m < 4; ++m)
#pragma unroll
            for (int n = 0; n < 2; ++n) gpre[0][m][n] = *(const u32x2*)(gg + roff + (size_t)m * DM + n * 16);
        EPI_BAR();
        if (tid < 128) { float TA = 1.f, TH = 0.f;
#pragma unroll
            for (int blk = 0; blk < 4; ++blk) { const f32x2 ah = *(const LAS f32x2*)(X + (blk * 128 + tid) * 2); TH = ah.x * TH + ah.y; TA = TA * ah.x; }
            __hip_atomic_store((unsigned long long*)(agg + ((size_t)u.pm * DM + chb + tid) * 2), __builtin_bit_cast(unsigned long long, (f32x2){TA, TH}), __ATOMIC_RELAXED, __HIP_MEMORY_SCOPE_AGENT);
            asm volatile("s_waitcnt vmcnt(0)" ::: "memory"); }
        EPI_BAR();
        if (tid == 0) __hip_atomic_store(flags + u.pm * 16 + u.pn, 1u, __ATOMIC_RELAXED, __HIP_MEMORY_SCOPE_AGENT);
        if (tid < 128) { const int pm0 = u.pm & ~15, np = u.pm & 15; float h0 = 0.f;
            { const int q = lane & 15; unsigned sp = 0;
                for (;;) { const unsigned f = (q < np) ? __hip_atomic_load(flags + (pm0 + q) * 16 + u.pn, __ATOMIC_RELAXED, __HIP_MEMORY_SCOPE_AGENT) : 1u;
                    if (__builtin_amdgcn_ballot_w64(f == 0u) == 0ull) break;
                    __builtin_amdgcn_s_sleep(1); if (++sp > (1u << 14)) break; } }
            asm volatile("" ::: "memory");
            f32x2 ahs[15];
#pragma unroll
            for (int q = 0; q < 15; ++q) { const int qq = q < np ? q : 0;
                ahs[q] = __builtin_bit_cast(f32x2, __hip_atomic_load((unsigned long long*)(agg + ((size_t)(pm0 + qq) * DM + chb + tid) * 2), __ATOMIC_RELAXED, __HIP_MEMORY_SCOPE_AGENT)); }
#pragma unroll
            for (int q = 0; q < 15; ++q) if (q < np) h0 = ahs[q].x * h0 + ahs[q].y;
            C0[tid] = h0; }
        EPI_BAR();
#pragma unroll
        for (int ai = 0; ai < 2; ++ai) { float cl[2][4];
            if (ai == 0) {
#pragma unroll
                for (int m = 0; m < 4; ++m)
#pragma unroll
                    for (int n = 0; n < 2; ++n) gpre[1][m][n] = *(const u32x2*)(gg + roff + (size_t)(128 + m) * DM + n * 16); }
#pragma unroll
            for (int n = 0; n < 2; ++n)
#pragma unroll
                for (int j = 0; j < 4; ++j) { const int c = wc * 32 + n * 16 + fq * 4 + j; float s = C0[c];
                    if (ai == 1) { const f32x2 b0 = *(const LAS f32x2*)(X + (0 * 128 + c) * 2), b1 = *(const LAS f32x2*)(X + (1 * 128 + c) * 2); s = b0.x * s + b0.y; s = b1.x * s + b1.y; }
                    if (wr == 1) { const f32x2 b2 = *(const LAS f32x2*)(X + ((ai * 2) * 128 + c) * 2); s = b2.x * s + b2.y; }
                    cl[n][j] = EA[ai][n][j] * s + EH[ai][n][j]; }
#pragma unroll
            for (int m = 0; m < 4; ++m) {
#pragma unroll
                for (int n = 0; n < 2; ++n) { const u32x2 gw = gpre[ai][m][n]; const float gv[4] = {bflo(gw.x), bfhi(gw.x), bflo(gw.y), bfhi(gw.y)}; float y[4];
#pragma unroll
                    for (int j = 0; j < 4; ++j) y[j] = (acc[ai][0][m][n][j] * cl[n][j] + acc[ai][1][m][n][j]) * gv[j];
                    u32x2 w; w.x = cvt_pk_bf16(y[0], y[1]); w.y = cvt_pk_bf16(y[2], y[3]);
                    *(u32x2*)(yb + roff + n * 16) = w; }
                roff += (size_t)(m == 3 ? 125 : 1) * DM; asm volatile("" : "+v"(roff) :: "memory"); } }
    }
};

struct EpiSwiGLUDenseF8 {
    static constexpr bool PERM = true, ACC_INIT = false;
    unsigned char* out; const float* parts;
    __device__ __forceinline__ void operator()(Acc& acc, const Unit& u, int wr, int wc, int fr, int fq, LAS unsigned char* le, int wid, int lane, int& cpm) const {
        LAS float* S = (LAS float*)le; const int tid = wid * 64 + lane, row0 = u.pm * 256;
        row_rstd_to_lds<8>(S, parts, u.pm, tid, cpm);
        size_t roff = (size_t)(row0 + wr * 64 + fr) * DFF + u.pn * 128 + wc * 32 + fq * 8;
#pragma unroll
        for (int ai = 0; ai < 2; ++ai)
#pragma unroll
            for (int m = 0; m < 4; ++m) { const int rt = ai * 128 + wr * 64 + m * 16 + fr; const float rs = S[rt];
                const float rl = rs * -1.4426950408889634f, kk = rs * rs * H_SCALE; f32x4 ha, hb;
#pragma unroll
                for (int j = 0; j < 4; ++j) { const float g0 = acc[ai][0][m][0][j], g1 = acc[ai][0][m][1][j];
                    ha[j] = (g0 * acc[ai][1][m][0][j]) * kk * __builtin_amdgcn_rcpf(1.0f + __builtin_amdgcn_exp2f(g0 * rl));
                    hb[j] = (g1 * acc[ai][1][m][1][j]) * kk * __builtin_amdgcn_rcpf(1.0f + __builtin_amdgcn_exp2f(g1 * rl)); }
                u32x2 w; w.x = pk4_fp8(ha[0], ha[1], ha[2], ha[3]); w.y = pk4_fp8(hb[0], hb[1], hb[2], hb[3]);
                ST_NT((u32x2*)(out + roff), w);
                NEXT_ROW(roff, m, DFF); }
    }
};
struct EpiMoeDown {
    static constexpr bool PERM = true, ACC_INIT = false;
    unsigned char* y; float oscale;
    __device__ __forceinline__ void operator()(Acc& acc, const Unit& u, int wr, int wc, int fr, int fq, LAS unsigned char*, int, int, int&) const {
        size_t roff = (size_t)(u.pm * 256 + wr * 64 + fr) * DM + u.pn * 256 + wc * 32 + fq * 8;
#pragma unroll
        for (int ai = 0; ai < 2; ++ai)
#pragma unroll
            for (int m = 0; m < 4; ++m) {
#pragma unroll
                for (int bj = 0; bj < 2; ++bj) { const f32x4 v0 = acc[ai][bj][m][0] * oscale, v1 = acc[ai][bj][m][1] * oscale;
                    u32x2 w; w.x = pk4_fp8(v0[0], v0[1], v0[2], v0[3]); w.y = pk4_fp8(v1[0], v1[1], v1[2], v1[3]);
                    *(u32x2*)(y + roff + bj * 128) = w; }
                NEXT_ROW(roff, m, DM); }
    }
};
struct EpiMoeDownTail {
    static constexpr bool PERM = true, ACC_INIT = false;
    unsigned char* y; float oscale; float* part; unsigned* flg;
    __device__ __forceinline__ void operator()(Acc& acc, const Unit& u, int wr, int wc, int fr, int fq, LAS unsigned char*, int wid, int lane, int&) const {
        const int tid = wid * 64 + lane;
        if (u.ks < 3) { float* p = part + (size_t)(u.ti * 3 + u.ks) * (32 * 512 * 4) + tid * 4;
#pragma unroll
            for (int ai = 0; ai < 2; ++ai)
#pragma unroll
                for (int bj = 0; bj < 2; ++bj)
#pragma unroll
                    for (int m = 0; m < 4; ++m)
#pragma unroll
                        for (int n = 0; n < 2; ++n) *(f32x4*)(p + (size_t)(((ai * 2 + bj) * 4 + m) * 2 + n) * (512 * 4)) = acc[ai][bj][m][n];
            asm volatile("s_waitcnt vmcnt(0)" ::: "memory");
            EPI_BAR();
            if (tid == 0) __hip_atomic_fetch_add(flg + u.ti, 1u, __ATOMIC_RELAXED, __HIP_MEMORY_SCOPE_AGENT);
            return; }
        if (tid == 0) { unsigned sp = 0; while (__hip_atomic_load(flg + u.ti, __ATOMIC_RELAXED, __HIP_MEMORY_SCOPE_AGENT) < 3u) { __builtin_amdgcn_s_sleep(1); if (++sp > (1u << 14)) break; } }
        EPI_BAR();
        __builtin_amdgcn_fence(__ATOMIC_ACQUIRE, "agent");
#pragma unroll
        for (int q = 0; q < 3; ++q) { const float* p = part + (size_t)(u.ti * 3 + q) * (32 * 512 * 4) + tid * 4;
#pragma unroll
            for (int ai = 0; ai < 2; ++ai)
#pragma unroll
                for (int bj = 0; bj < 2; ++bj)
#pragma unroll
                    for (int m = 0; m < 4; ++m)
#pragma unroll
                        for (int n = 0; n < 2; ++n) acc[ai][bj][m][n] += *(const f32x4*)(p + (size_t)(((ai * 2 + bj) * 4 + m) * 2 + n) * (512 * 4)); }
        size_t roff = (size_t)(u.pm * 256 + wr * 64 + fr) * DM + u.pn * 256 + wc * 32 + fq * 8;
#pragma unroll
        for (int ai = 0; ai < 2; ++ai)
#pragma unroll
            for (int m = 0; m < 4; ++m) {
#pragma unroll
                for (int bj = 0; bj < 2; ++bj) { const f32x4 v0 = acc[ai][bj][m][0] * oscale, v1 = acc[ai][bj][m][1] * oscale;
                    u32x2 w; w.x = pk4_fp8(v0[0], v0[1], v0[2], v0[3]); w.y = pk4_fp8(v1[0], v1[1], v1[2], v1[3]);
                    *(u32x2*)(y + roff + bj * 128) = w; }
                NEXT_ROW(roff, m, DM); }
    }
};
}
constexpr size_t MiB = 1u << 20;
constexpr size_t WS_CTL = 0, CTL_ZERO_BYTES = 1 * MiB;
constexpr size_t WS_SSQ0 = 1 * MiB;
constexpr size_t WS_SSQ1 = WS_SSQ0 + 64 * 1024;
constexpr size_t WS_SSQ2 = WS_SSQ1 + 512 * 1024;
constexpr size_t WS_SSQ3 = WS_SSQ2 + 512 * 1024;
constexpr size_t WS_KMEAN = WS_SSQ3 + 512 * 1024;
constexpr size_t WS_ROPE = WS_KMEAN + 256 * 1024;
constexpr size_t WS_SPL = WS_ROPE + 512 * 1024;
constexpr size_t WS_RSTD3 = WS_SPL + 8 * 1024;
constexpr size_t WS_TOKE = WS_RSTD3 + 64 * 1024;
constexpr size_t WS_TOKW = WS_TOKE + 64 * 1024;
constexpr size_t WS_CNTC = WS_TOKW + 128 * 1024;
constexpr size_t WS_SLOTT = WS_CNTC + 8 * 1024;
constexpr size_t WS_SLOTW = WS_SLOTT + 144 * 1024;
constexpr size_t WS_TPREF = WS_SLOTW + 144 * 1024;
constexpr size_t WS_GAINS = WS_TPREF + 1024;
constexpr size_t WS_TOKS = WS_GAINS + 4096;
constexpr size_t WS_SLOTR = WS_TOKS + 128 * 1024;
constexpr size_t WS_SCANA = 8 * MiB, WS_SCANH = 9 * MiB, WS_SCANC = 10 * MiB;
static_assert(WS_SLOTR + 144 * 1024 <= WS_SCANA, "small arrays");
constexpr size_t WS_WQKV = 32 * MiB, WS_WO = 56 * MiB, WS_WGU = 64 * MiB, WS_WDN = 120 * MiB, WS_WIN = 148 * MiB, WS_WAI = 164 * MiB, WS_WO2 = 166 * MiB;
constexpr size_t WS_EGU = 176 * MiB, WS_EDN = 624 * MiB;
constexpr size_t WS_XB = 848 * MiB;
constexpr size_t WS_XR = 912 * MiB;
constexpr size_t WS_ARENA = 1040 * MiB;
constexpr size_t WS_QKV = WS_ARENA, WS_O = WS_ARENA + 192 * MiB;
constexpr size_t WS_H = WS_ARENA;
constexpr size_t WS_XBR = WS_ARENA, WS_GG = WS_ARENA + 64 * MiB, WS_XC = WS_ARENA + 128 * MiB, WS_AA = WS_ARENA + 192 * MiB, WS_UU = WS_ARENA + 320 * MiB, WS_Y = WS_ARENA + 448 * MiB;
constexpr size_t WS_PART = WS_ARENA + 256 * MiB;
constexpr size_t WS_HE = WS_ARENA;
constexpr size_t WS_XG = WS_ARENA + 512 * MiB;
constexpr size_t WS_END = WS_XG + 136 * MiB;
static_assert((size_t)NSLOT_PAD * DFF * 2 <= 512 * MiB && (size_t)T * DFF * 2 <= 512 * MiB && (size_t)NSLOT_PAD * DM * 2 <= 136 * MiB, "arena");
constexpr int CW_TMO = 0, CW_BAR = 4096, CW_XRANK = 8192, CW_SCANF = 12288, CW_TAILF = 13312;

constexpr int RING_OFF = 0, RING_BYTES = 131072, EPI_OFF = 131072, EPI_BYTES = 12288, MISC_OFF = EPI_OFF + EPI_BYTES, LDS_BYTES = 147456;
static_assert(MISC_OFF + 128 <= LDS_BYTES && att::LDS_BYTES <= RING_BYTES, "LDS map");

#define XB_TMO      128
#define XB_XCNT(j)  (256  + 64 * (j))
#define XB_XSUB(j)  (1280 + 64 * (j))
#define XB_XGEN(j)  (2304 + 64 * (j))
#define XB_TOP      3328
#define XB_TOPGEN   3392
#define XCD_BAR_WORDS 3456
#define XB_SPIN_CAP (1u << 18)
__device__ __forceinline__ unsigned xb_ld(unsigned* p)              { return __hip_atomic_load(p, __ATOMIC_RELAXED, __HIP_MEMORY_SCOPE_AGENT); }
__device__ __forceinline__ unsigned xb_add(unsigned* p, unsigned v) { return __hip_atomic_fetch_add(p, v, __ATOMIC_RELAXED, __HIP_MEMORY_SCOPE_AGENT); }
__device__ __forceinline__ unsigned xb_xcc_id() { return (unsigned)__builtin_amdgcn_s_getreg((3 << 11) | 20) & 0xFu; }
#define XB_SPIN(cond, bar) do { unsigned _sp = 0; while (cond) { __builtin_amdgcn_s_sleep(1); \
    if ((++_sp & 255u) == 0u) { if (xb_ld(&(bar)[XB_TMO])) break; if (_sp > XB_SPIN_CAP) { atomicAdd(&(bar)[XB_TMO], 1u); break; } } } } while (0)
struct XcdBarrier { unsigned* bar; unsigned x; volatile LAS unsigned* st; int wave; };
__device__ __forceinline__ bool xb_leader(int wave) { return wave == 0 && __builtin_amdgcn_mbcnt_hi(~0u, __builtin_amdgcn_mbcnt_lo(~0u, 0u)) == 0u; }
__device__ __forceinline__ XcdBarrier xcd_barrier_post(unsigned* bar, volatile LAS unsigned* st, int wave) {
    XcdBarrier b; b.bar = bar; b.x = xb_xcc_id(); b.st = st; b.wave = wave;
    if (xb_leader(wave)) (void)xb_add(&bar[XB_XCNT(b.x)], 1u);
    return b;
}
__device__ __forceinline__ void xcd_barrier_complete(unsigned* bar, unsigned x, unsigned& nloc, unsigned& nx) {
    const unsigned G = gridDim.x * gridDim.y * gridDim.z;
    unsigned sum, cnt, mine, sp = 0u;
    for (;;) {
        sum = 0u; cnt = 0u; mine = 0u;
#pragma unroll
        for (unsigned j = 0; j < 16; ++j) { const unsigned c = xb_ld(&bar[XB_XCNT(j)]); sum += c; cnt += (c > 0u) ? 1u : 0u; mine = (j == x) ? c : mine; }
        if (sum == G) break;
        __builtin_amdgcn_s_sleep(1);
        if ((++sp & 255u) == 0u) { if (xb_ld(&bar[XB_TMO])) break; if (sp > XB_SPIN_CAP) { atomicAdd(&bar[XB_TMO], 1u); break; } }
    }
    nloc = mine > 0u ? mine : 1u; nx = cnt > 0u ? cnt : 1u;
}
__device__ __forceinline__ void xcd_barrier(const XcdBarrier& b) {
    asm volatile("s_waitcnt vmcnt(0)" ::: "memory");
    __syncthreads();
    if (xb_leader(b.wave)) {
        unsigned* bar = b.bar;
        __builtin_amdgcn_s_waitcnt(0);
        unsigned nloc = b.st[0], nx = b.st[1];
        if (nloc == 0u) { xcd_barrier_complete(bar, b.x, nloc, nx); b.st[0] = nloc; b.st[1] = nx; }
        const unsigned old = xb_add(&bar[XB_XSUB(b.x)], 1u);
        const unsigned gen = old / nloc;
        if (old + 1u == (gen + 1u) * nloc) {
            __builtin_amdgcn_fence(__ATOMIC_RELEASE, "agent");
            asm volatile("s_waitcnt vmcnt(0)" ::: "memory");
            const unsigned og = xb_add(&bar[XB_TOP], 1u);
            const unsigned tg = og / nx;
            if (og + 1u == (tg + 1u) * nx) xb_add(&bar[XB_TOPGEN], 1u);
            else XB_SPIN(xb_ld(&bar[XB_TOPGEN]) == tg, bar);
            __builtin_amdgcn_fence(__ATOMIC_ACQUIRE, "agent");
            xb_add(&bar[XB_XGEN(b.x)], 1u);
            asm volatile("s_waitcnt vmcnt(0)" ::: "memory");
        } else {
            XB_SPIN(xb_ld(&bar[XB_XGEN(b.x)]) == gen, bar);
            __builtin_amdgcn_fence(__ATOMIC_ACQUIRE, "agent");
            asm volatile("s_waitcnt vmcnt(0)" ::: "memory");
        }
    }
    __syncthreads();
}

#define LDS_WAIT() asm volatile("s_waitcnt lgkmcnt(0)" ::: "memory")
__device__ __forceinline__ void transpose_item(const float* W, int ldw, int k0, int n0, const float* gain, bf16* WT, int ldwt, int drow0, LAS float* scr, int lane) {
    const int n4 = lane & 7, kr = lane >> 3;
#pragma unroll
    for (int i = 0; i < 8; ++i) { const int kk = 8 * i + kr; f32x4 v = *(const f32x4*)(W + (size_t)(k0 + kk) * ldw + n0 + 4 * n4);
        if (gain) v = v * gain[k0 + kk];
        LAS float* d = scr + kk * 33 + 4 * n4; d[0] = v[0]; d[1] = v[1]; d[2] = v[2]; d[3] = v[3]; }
    LDS_WAIT(); asm volatile("" ::: "memory");
    const int c = lane & 7;
#pragma unroll
    for (int j = 0; j < 4; ++j) { const int n = (lane >> 3) + 8 * j; const LAS float* s = scr + (8 * c) * 33 + n;
        u32x4 o; o.x = pk2(s[0 * 33], s[1 * 33]); o.y = pk2(s[2 * 33], s[3 * 33]); o.z = pk2(s[4 * 33], s[5 * 33]); o.w = pk2(s[6 * 33], s[7 * 33]);
        *(u32x4*)(WT + (size_t)(drow0 + n) * ldwt + k0 + 8 * c) = o; }
    LDS_WAIT(); asm volatile("" ::: "memory");
}
__device__ __forceinline__ void transpose_item_fp8(const float* W, int ldw, int k0, int n0, const float* gain, float scale, unsigned char* WT, int ldwt, int drow0, LAS float* scr, int lane) {
    const int n4 = lane & 7, kr = lane >> 3;
#pragma unroll
    for (int i = 0; i < 8; ++i) { const int kk = 8 * i + kr; f32x4 v = *(const f32x4*)(W + (size_t)(k0 + kk) * ldw + n0 + 4 * n4);
        v = v * (gain ? gain[k0 + kk] * scale : scale);
        LAS float* d = scr + kk * 33 + 4 * n4; d[0] = v[0]; d[1] = v[1]; d[2] = v[2]; d[3] = v[3]; }
    LDS_WAIT(); asm volatile("" ::: "memory");
    const int c = lane & 7;
#pragma unroll
    for (int j = 0; j < 4; ++j) { const int n = (lane >> 3) + 8 * j; const LAS float* s = scr + (8 * c) * 33 + n;
        u32x2 o; o.x = epi::pk4_fp8(s[0 * 33], s[1 * 33], s[2 * 33], s[3 * 33]); o.y = epi::pk4_fp8(s[4 * 33], s[5 * 33], s[6 * 33], s[7 * 33]);
        *(u32x2*)(WT + (size_t)(drow0 + n) * ldwt + k0 + 8 * c) = o; }
    LDS_WAIT(); asm volatile("" ::: "memory");
}
__device__ __forceinline__ bool transpose_group_fp8(int& it, const float* W, size_t wstride, int nmat, int K, int N, const float* gain, float scale, unsigned char* WT, size_t tstride, int mode, LAS float* scr, int lane) {
    const int nblk = N / 32, per = (K / 64) * nblk, tot = per * nmat;
    if (it >= tot) { it -= tot; return false; }
    const int mat = it / per, r = it % per, kb = r / nblk, nb = r % nblk, n0 = 32 * nb;
    const int drow0 = (mode == 0) ? n0 : (256 * (n0 / 128) + (n0 % 128) + (mode == 2 ? 128 : 0));
    transpose_item_fp8(W + (size_t)mat * wstride, N, 64 * kb, n0, gain, scale, WT + (size_t)mat * tstride, K, drow0, scr, lane);
    return true;
}
__device__ __forceinline__ bool transpose_group(int& it, const float* W, size_t wstride, int nmat, int K, int N, const float* gain, bf16* WT, size_t tstride, int mode, LAS float* scr, int lane) {
    const int nblk = N / 32, per = (K / 64) * nblk, tot = per * nmat;
    if (it >= tot) { it -= tot; return false; }
    const int mat = it / per, r = it % per, kb = r / nblk, nb = r % nblk, n0 = 32 * nb;
    const int drow0 = (mode == 0) ? n0 : (256 * (n0 / 128) + (n0 % 128) + (mode == 2 ? 128 : 0));
    transpose_item(W + (size_t)mat * wstride, N, 64 * kb, n0, gain, WT + (size_t)mat * tstride, K, drow0, scr, lane);
    return true;
}
__device__ __forceinline__ void sincos_f64(double x, double& s, double& c) {
    const double TWO_PI = 6.283185307179586476925286766559, INV_2PI = 0.15915494309189533576888376337251;
    const double n = __builtin_rint(x * INV_2PI); const double r = __builtin_fma(-n, TWO_PI, x), r2 = r * r;
    double ts = r, tc = 1.0; s = r; c = 1.0;
#pragma unroll
    for (int k = 1; k <= 14; ++k) { tc = -tc * r2 / (double)((2 * k - 1) * (2 * k)); ts = -ts * r2 / (double)((2 * k) * (2 * k + 1)); c += tc; s += ts; }
}

struct TItem { const float* src; const float* gain; unsigned char* dst; int ldw, ldwt, fp8; float scale; };
__device__ __forceinline__ bool titem_group(int& it, TItem& t, const float* W, size_t wstride, int nmat, int K, int N, const float* gain, float scale, void* WT, size_t tstride_bytes, int mode, int fp8) {
    const int nblk = N / 64, per = (K / 64) * nblk, tot = per * nmat;
    if (it >= tot) { it -= tot; return false; }
    const int mat = it / per, r = it % per, k0 = 64 * (r / nblk), n0 = 64 * (r % nblk), esz = (fp8 == 1) ? 1 : 2;
    const int drow0 = (mode == 0) ? n0 : (256 * (n0 / 128) + (n0 % 128) + (mode == 2 ? 128 : 0));
    t.src = W + (size_t)mat * wstride + (size_t)k0 * N + n0; t.gain = gain ? gain + k0 : nullptr;
    t.dst = (unsigned char*)WT + (size_t)mat * tstride_bytes + ((size_t)drow0 * K + k0) * esz; t.ldw = N; t.ldwt = K * esz; t.fp8 = fp8; t.scale = scale; return true;
}
__device__ __forceinline__ void titem_load(const TItem& t, f32x4 (&v)[2][8], f32x4 (&g)[2], int lane) {
    const int n4 = lane & 7, kr = lane >> 3;
    const float* gp = t.gain ? t.gain : t.src;
#pragma unroll
    for (int h = 0; h < 2; ++h)
#pragma unroll
        for (int i = 0; i < 8; ++i) v[h][i] = *(const f32x4*)(t.src + (size_t)(8 * kr + i) * t.ldw + 32 * h + 4 * n4);
    g[0] = *(const f32x4*)(gp + 8 * kr); g[1] = *(const f32x4*)(gp + 8 * kr + 4);
}
__device__ __forceinline__ void titem_process(const TItem& t, const f32x4 (&v)[2][8], const f32x4 (&g)[2], int lane) {
    const int n4 = lane & 7, kr = lane >> 3;
    float s[8];
#pragma unroll
    for (int j = 0; j < 8; ++j) s[j] = t.gain ? g[j >> 2][j & 3] * t.scale : t.scale;
    if (t.fp8 == 1) {
#pragma unroll
        for (int h = 0; h < 2; ++h)
#pragma unroll
            for (int i = 0; i < 4; ++i) { u32x2 o; o.x = epi::pk4_fp8(v[h][0][i] * s[0], v[h][1][i] * s[1], v[h][2][i] * s[2], v[h][3][i] * s[3]); o.y = epi::pk4_fp8(v[h][4][i] * s[4], v[h][5][i] * s[5], v[h][6][i] * s[6], v[h][7][i] * s[7]);
                __builtin_nontemporal_store(o, (u32x2*)(t.dst + (size_t)(32 * h + 4 * n4 + i) * t.ldwt + 8 * kr)); }
    } else {
#pragma unroll
        for (int h = 0; h < 2; ++h)
#pragma unroll
            for (int i = 0; i < 4; ++i) { u32x4 o; o.x = cvt_pk_bf16(v[h][0][i] * s[0], v[h][1][i] * s[1]); o.y = cvt_pk_bf16(v[h][2][i] * s[2], v[h][3][i] * s[3]); o.z = cvt_pk_bf16(v[h][4][i] * s[4], v[h][5][i] * s[5]); o.w = cvt_pk_bf16(v[h][6][i] * s[6], v[h][7][i] * s[7]);
                u32x4* dp = (u32x4*)(t.dst + (size_t)(32 * h + 4 * n4 + i) * t.ldwt + 16 * kr); if (t.fp8 == 2) __builtin_nontemporal_store(o, dp); else *dp = o; }
    }
}

struct Args { const float* in[27]; float* out; unsigned char* ws; int ph_lo, ph_hi; };
constexpr int NPHASE = 19;
#ifndef MK_PER_PHASE
#define MK_PER_PHASE 0
#endif

__global__ void __launch_bounds__(NTHR, 2) fwd_kernel(Args args) {
    extern __shared__ __attribute__((aligned(16))) unsigned char lds_raw[];
    LAS unsigned char* lds = (LAS unsigned char*)lds_raw;
    volatile LAS unsigned* MISC = (volatile LAS unsigned*)(lds + MISC_OFF);
    const int G = gridDim.x, wg = blockIdx.x, GT = G * NTHR, NGW = G * NWAVES;
    const int wave_s = __builtin_amdgcn_readfirstlane(threadIdx.x >> 6);
#define x_in (AP->in[0])
#define ev_attn_norm (AP->in[1])
#define ev_w_in (AP->in[2])
#define ev_qn_sb (AP->in[3])
#define ev_kn_sb (AP->in[4])
#define ev_qn_mb (AP->in[5])
#define ev_kn_mb (AP->in[6])
#define ev_w_o (AP->in[7])
#define ev_ffn_norm (AP->in[8])
#define ev_w_gate (AP->in[9])
#define ev_w_up (AP->in[10])
#define ev_w_down (AP->in[11])
#define od_rec_norm (AP->in[12])
#define od_w_in (AP->in[13])
#define od_conv_w (AP->in[14])
#define od_conv_b (AP->in[15])
#define od_w_a (AP->in[16])
#define od_b_a (AP->in[17])
#define od_w_i (AP->in[18])
#define od_b_i (AP->in[19])
#define od_lambda (AP->in[20])
#define od_w_o (AP->in[21])
#define od_ffn_norm (AP->in[22])
#define od_router (AP->in[23])
#define od_we_gate (AP->in[24])
#define od_we_up (AP->in[25])
#define od_we_down (AP->in[26])
#define ssq0 ((float*)(AP->ws + WS_SSQ0))
#define ssq1 ((float*)(AP->ws + WS_SSQ1))
#define ssq2 ((float*)(AP->ws + WS_SSQ2))
#define ssq3 ((float*)(AP->ws + WS_SSQ3))
#define kmean ((float*)(AP->ws + WS_KMEAN))
#define rope ((float*)(AP->ws + WS_ROPE))
#define spl ((float*)(AP->ws + WS_SPL))
#define rstd3 ((float*)(AP->ws + WS_RSTD3))
#define tok_e ((int*)(AP->ws + WS_TOKE))
#define tok_w ((float*)(AP->ws + WS_TOKW))
#define tok_slot ((int*)(AP->ws + WS_TOKS))
#define cnt_chunk ((int*)(AP->ws + WS_CNTC))
#define slot_tok ((int*)(AP->ws + WS_SLOTT))
#define slot_w ((float*)(AP->ws + WS_SLOTW))
#define tpref ((int*)(AP->ws + WS_TPREF))
#define gains ((float*)(AP->ws + WS_GAINS))
#define slot_rstd ((float*)(AP->ws + WS_SLOTR))
#define XG ((bf16*)(AP->ws + WS_XG))
#define scanA ((float*)(AP->ws + WS_SCANA))
#define scanH ((float*)(AP->ws + WS_SCANH))
#define scanC ((float*)(AP->ws + WS_SCANC))
#define Wqkv ((bf16*)(AP->ws + WS_WQKV))
#define Wo ((bf16*)(AP->ws + WS_WO))
#define Wgu ((bf16*)(AP->ws + WS_WGU))
#define Wdn ((bf16*)(AP->ws + WS_WDN))
#define Win ((bf16*)(AP->ws + WS_WIN))
#define Wai ((bf16*)(AP->ws + WS_WAI))
#define Wo2 ((bf16*)(AP->ws + WS_WO2))
#define Egu ((bf16*)(AP->ws + WS_EGU))
#define Edn ((bf16*)(AP->ws + WS_EDN))
#define XB ((bf16*)(AP->ws + WS_XB))
#define XR ((float*)(AP->ws + WS_XR))
#define QKV ((bf16*)(AP->ws + WS_QKV))
#define OB ((bf16*)(AP->ws + WS_O))
#define HB ((bf16*)(AP->ws + WS_H))
#define XBR ((bf16*)(AP->ws + WS_XBR))
#define GG ((bf16*)(AP->ws + WS_GG))
#define XC ((bf16*)(AP->ws + WS_XC))
#define AA ((float*)(AP->ws + WS_AA))
#define UU ((float*)(AP->ws + WS_UU))
#define YB ((bf16*)(AP->ws + WS_Y))
#define HE ((bf16*)(AP->ws + WS_HE))
#define out (AP->out)
    typedef const __attribute__((address_space(4))) Args* ArgsP;
#define PHASE_ARGS() ArgsP AP = (ArgsP)__builtin_amdgcn_kernarg_segment_ptr(); asm volatile("" : "+s"(AP))
    gu32* ctl; { PHASE_ARGS(); ctl = (gu32*)(AP->ws + WS_CTL); }
#define PHASE_IDS() const int lane = (int)__builtin_amdgcn_mbcnt_hi(~0u, __builtin_amdgcn_mbcnt_lo(~0u, 0u)), wave = wave_s, tid = wave * 64 + lane, gtid = wg * NTHR + tid, gw = wg * NWAVES + wave; (void)gtid; (void)gw
    for (int u = threadIdx.x; u < (LDS_BYTES - MISC_OFF) / 4; u += NTHR) ((LAS unsigned*)(lds + MISC_OFF))[u] = 0u;
    __syncthreads();
    XcdBarrier bar; bar.bar = (unsigned*)(ctl + CW_BAR); bar.x = 0; bar.st = nullptr; bar.wave = wave_s;
    if (!MK_PER_PHASE) bar = xcd_barrier_post((unsigned*)(ctl + CW_BAR), MISC + 8, wave_s);
    if (!MK_PER_PHASE && xb_leader(wave_s)) { const unsigned xcc = xb_xcc_id(); const unsigned rk = xb_add((unsigned*)(ctl + CW_XRANK + 64 * (xcc & 7u)), 1u); MISC[16] = rk * 8u + (xcc & 7u); }
    int vwg = wg; bool xloc = false;
    const int lo = args.ph_lo, hi = args.ph_hi;
#ifndef PHMASK
#define PHMASK 0x7ffff
#endif
#define IN(k) (((PHMASK >> (k)) & 1) && lo <= (k) && (k) < hi)
#ifndef PROBE_XBAR
#define PROBE_XBAR 0
#endif
#define SEAM(k) do { if (IN(k) && IN((k) + 1)) { xcd_barrier(bar); for (int xb_ = 0; xb_ < PROBE_XBAR; ++xb_) xcd_barrier(bar); } } while (0)
#ifndef PHREP
#define PHREP 0
#endif
#define NREP(k) ((((PHREP) >> (k)) & 1) ? 2 : 1)
    LAS unsigned char* ring = lds + RING_OFF; LAS unsigned char* lepi = lds + EPI_OFF;

    constexpr int PER_FF = (DM / 64) * (DFF / 64), PER_DN = (DFF / 64) * (DM / 64), NEXP_ITEMS = 16 * PER_FF + 8 * PER_DN;
    constexpr int NITEMS = (DM / 64) * (NQKV / 64) + (DM / 64) * (DM / 64) + 2 * PER_FF + PER_DN + (DM / 64) * (2 * DM / 64) + 16 * (256 / 64) * (256 / 64) + (DM / 64) * (DM / 64) + NEXP_ITEMS;
#define TDECODE(itv, t) do { int it_ = (itv); \
            if (titem_group(it_, t, od_we_gate, (size_t)DM * DFF, 8, DM, DFF, od_ffn_norm, epi::W_UP_SCALE, Egu, (size_t)2 * DFF * DM, 1, 1)) break; \
            if (titem_group(it_, t, od_we_up, (size_t)DM * DFF, 8, DM, DFF, od_ffn_norm, epi::W_UP_SCALE, Egu, (size_t)2 * DFF * DM, 2, 1)) break; \
            if (titem_group(it_, t, od_we_down, (size_t)DFF * DM, 8, DFF, DM, nullptr, epi::W_DN_SCALE, Edn, (size_t)DM * DFF, 0, 1)) break; \
            if (titem_group(it_, t, ev_w_in, 0, 1, DM, NQKV, ev_attn_norm, 1.0f, Wqkv, 0, 0, 0)) break; \
            if (titem_group(it_, t, ev_w_o, 0, 1, DM, DM, nullptr, 1.0f, Wo, 0, 0, 2)) break; \
            if (titem_group(it_, t, ev_w_gate, 0, 1, DM, DFF, ev_ffn_norm, 1.0f, Wgu, 0, 1, 2)) break; \
            if (titem_group(it_, t, ev_w_up, 0, 1, DM, DFF, ev_ffn_norm, 1.0f, Wgu, 0, 2, 2)) break; \
            if (titem_group(it_, t, ev_w_down, 0, 1, DFF, DM, nullptr, epi::W_DN_SCALE, Wdn, 0, 0, 1)) break; \
            if (titem_group(it_, t, od_w_in, 0, 1, DM, 2 * DM, od_rec_norm, 1.0f, Win, 0, 0, 2)) break; \
            if (titem_group(it_, t, od_w_a, (size_t)256 * 256, 8, 256, 256, nullptr, 1.0f, Wai, (size_t)512 * 256 * 2, 1, 0)) break; \
            if (titem_group(it_, t, od_w_i, (size_t)256 * 256, 8, 256, 256, nullptr, 1.0f, Wai, (size_t)512 * 256 * 2, 2, 0)) break; \
            titem_group(it_, t, od_w_o, 0, 1, DM, DM, nullptr, 1.0f, Wo2, 0, 0, 2); } while (0)
#define CONVERT_RANGE(first_, last_) do { \
            TItem tA, tB; f32x4 vA[2][8], vB[2][8]; f32x4 gA[2], gB[2]; \
            int it = (first_) + gw; \
            if (it < (last_)) { \
                TDECODE(it, tA); titem_load(tA, vA, gA, lane); \
                for (;;) {                                                     \
                    int itB = it + NGW; const bool hasB = itB < (last_); if (!hasB) itB = it; \
                    TDECODE(itB, tB); titem_load(tB, vB, gB, lane); \
                    titem_process(tA, vA, gA, lane); \
                    if (!hasB) break; \
                    it = itB + NGW; const bool hasA = it < (last_); if (!hasA) it = itB; \
                    TDECODE(it, tA); titem_load(tA, vA, gA, lane); \
                    titem_process(tB, vB, gB, lane); \
                    if (!hasA) break; \
                } } } while (0)
    for (int rep_ = 0; rep_ < NREP(0); ++rep_) { if (rep_ > 0 && !MK_PER_PHASE) xcd_barrier(bar);
    if (IN(0)) { PHASE_ARGS(); PHASE_IDS();
#ifdef PROBE_CONV_IN_P0
        CONVERT_RANGE(0, NITEMS);
#else
        CONVERT_RANGE(NEXP_ITEMS, NITEMS);
#endif
        for (int m = gw; m < T; m += NGW) {
            const f32x4* xr = (const f32x4*)(x_in + (size_t)m * DM) + lane; f32x4 v[8]; float s = 0.f;
#pragma unroll
            for (int j = 0; j < 8; ++j) { v[j] = __builtin_nontemporal_load(xr + 64 * j); s += (v[j][0] * v[j][0] + v[j][1] * v[j][1]) + (v[j][2] * v[j][2] + v[j][3] * v[j][3]); }
            s = wave_sum(s); if (lane == 0) ssq0[m] = s;
            u32x2* o8 = (u32x2*)(XB + (size_t)m * DM) + lane;
#pragma unroll
            for (int j = 0; j < 8; ++j) { u32x2 w; w.x = cvt_pk_bf16(v[j][0], v[j][1]); w.y = cvt_pk_bf16(v[j][2], v[j][3]); o8[64 * j] = w; }
        }
        for (int idx = gtid; idx < SEQ * 16; idx += GT) {
            const double invf[16] = {1.0, 0.44036660267178046, 0.19392274474868576, 0.08539710028576561, 0.03760603093086393, 0.016560440080994446, 0.007292664737217109, 0.003211445994752591,
                                     0.001414213562373095, 0.000622772421914596, 0.0002742481756762073, 0.00012076973741146504, 5.318295896944988e-05, 2.341999896140934e-05, 1.031338537721246e-05, 4.5416704806078695e-06};
            const int pos = idx >> 4, i = idx & 15; double f = invf[0];
#pragma unroll
            for (int k = 1; k < 16; ++k) f = (i == k) ? invf[k] : f;
            double s, c; sincos_f64((double)pos * f, s, c);
            rope[idx] = (float)c; rope[SEQ * 16 + idx] = (float)s;
        }
        for (int c = gtid; c < DM; c += GT) { const float l = od_lambda[c]; spl[c] = (l > 15.f) ? expf(-l) : log1pf(expf(-l)); }
        if (gtid < HD) { gains[gtid] = ev_qn_sb[gtid]; gains[128 + gtid] = ev_kn_sb[gtid]; gains[256 + gtid] = ev_qn_mb[gtid]; gains[384 + gtid] = ev_kn_mb[gtid]; }
    }
    }
    SEAM(0);
    if (!MK_PER_PHASE && lo == 0) {
        bool ok = (G % 8) == 0;
#pragma unroll
        for (int j = 0; j < 8; ++j) ok = ok && (__hip_atomic_load((unsigned*)(ctl + CW_XRANK + 64 * j), __ATOMIC_RELAXED, __HIP_MEMORY_SCOPE_AGENT) == (unsigned)(G / 8));
        const int cand = __builtin_amdgcn_readfirstlane((int)MISC[16]);
        vwg = (ok && cand < G) ? cand : wg; xloc = ok && cand < G;
    }

    for (int rep_ = 0; rep_ < NREP(1); ++rep_) { if (rep_ > 0 && !MK_PER_PHASE) xcd_barrier(bar);
    if (IN(1)) { PHASE_ARGS();
        pg8::ProbPlain g{(const char*)XB, (const char*)Wqkv, (unsigned)DM * 2u, (unsigned)DM * 2u, DM / 64}; pg8::StaticOrder S; S.init(T / 256, NQKV / 256, G, vwg);
        epi::EpiQKV E{QKV, ssq0, gains, rope, kmean};
        pg8::gemm_phase(ring, lepi, g, S, E, wave_s);
    }
    }
    SEAM(1);

    for (int rep_ = 0; rep_ < NREP(3); ++rep_) { if (rep_ > 0 && !MK_PER_PHASE) xcd_barrier(bar);
    if (IN(3)) { PHASE_ARGS(); PHASE_IDS();
        const int half = (wg >> 3) & 1;
#ifndef PROBE_CONV_IN_P0
        if (half == 1) { CONVERT_RANGE(0, NEXP_ITEMS); __syncthreads(); }
#endif
#ifdef PROBE_ATT2
        int nrp_ = 2; asm volatile("" : "+s"(nrp_));
        for (int rp_ = 0; rp_ < nrp_; ++rp_) {
#endif
        for (int p = wg; p < 256; p += G) { const int bh = p >> 3, k = p & 7, b = bh >> 3, h = bh & 7;
            for (int s = 0; s < 2; ++s) att::attn_unit<1>(QKV, OB, kmean, b, h, s ? 15 - k : k, ring, lepi, wave_s); }
        for (int p = wg; p < 256; p += G) { const int bh = p >> 3, k = p & 7, b = bh >> 3, h = bh & 7;
            for (int s = 0; s < 2; ++s) att::attn_unit<0>(QKV, OB, kmean, b, h, s ? 15 - k : k, ring, lepi, wave_s); }
#ifdef PROBE_ATT2
        }
#endif
#ifndef PROBE_CONV_IN_P0
        if (half == 0) { __syncthreads(); CONVERT_RANGE(0, NEXP_ITEMS); }
#endif
    }
    }
    SEAM(3);

    for (int rep_ = 0; rep_ < NREP(4); ++rep_) { if (rep_ > 0 && !MK_PER_PHASE) xcd_barrier(bar);
    if (IN(4)) { PHASE_ARGS();
        pg8::ProbPlain g{(const char*)OB, (const char*)Wo, (unsigned)DM * 2u, (unsigned)DM * 2u, DM / 64}; pg8::StaticOrder S; S.init(T / 256, DM / 256, G, vwg);
        epi::EpiResid<true> E{XB, nullptr, XB, ssq1};
        pg8::gemm_phase(ring, lepi, g, S, E, wave_s);
    }
    }
    SEAM(4);

    for (int rep_ = 0; rep_ < NREP(5); ++rep_) { if (rep_ > 0 && !MK_PER_PHASE) xcd_barrier(bar);
    if (IN(5)) { PHASE_ARGS();
        pg8::ProbPlain g{(const char*)XB, (const char*)Wgu, (unsigned)DM * 2u, (unsigned)DM * 2u, DM / 64}; pg8::StaticOrder S; S.init(T / 256, 2 * DFF / 256, G, vwg);
        epi::EpiSwiGLUDenseF8 E{(unsigned char*)HB, ssq1};
#ifdef PROBE_SPLIT5
        S.i1 = 7; pg8::gemm_phase(ring, lepi, g, S, E, wave_s); if (PROBE_SPLIT5 == 1) xcd_barrier(bar); S.i0 = 7; S.i1 = 1 << 30; pg8::gemm_phase(ring, lepi, g, S, E, wave_s);
#else
        pg8::gemm_phase(ring, lepi, g, S, E, wave_s);
#endif
    }
    }
    SEAM(5);

    for (int rep_ = 0; rep_ < NREP(6); ++rep_) { if (rep_ > 0 && !MK_PER_PHASE) xcd_barrier(bar);
    if (IN(6)) { PHASE_ARGS();
        pg8::ProbPlainF8 g{(const char*)HB, (const char*)Wdn, (unsigned)DFF, (unsigned)DFF, DFF / 128}; pg8::StaticOrder S; S.init(T / 256, DM / 256, G, vwg);
        epi::EpiResid<true, true> E{XB, nullptr, XB, ssq2};
        pg8::gemm_phase(ring, lepi, g, S, E, wave_s);
    }
    }
    SEAM(6);

    for (int rep_ = 0; rep_ < NREP(7); ++rep_) { if (rep_ > 0 && !MK_PER_PHASE) xcd_barrier(bar);
    if (IN(7)) { PHASE_ARGS();
        pg8::ProbPlain g{(const char*)XB, (const char*)Win, (unsigned)DM * 2u, (unsigned)DM * 2u, DM / 64}; pg8::StaticOrder S; S.init(T / 256, 2 * DM / 256, G, vwg);
        epi::EpiRecIn E{XBR, GG, ssq2};
        pg8::gemm_phase(ring, lepi, g, S, E, wave_s);
    }
    }
    SEAM(7);

    for (int rep_ = 0; rep_ < NREP(8); ++rep_) { if (rep_ > 0 && !MK_PER_PHASE) xcd_barrier(bar);
    if (IN(8)) { PHASE_ARGS(); PHASE_IDS();
        for (int idx = gtid; idx < (T / 32) * 256; idx += GT) { const int cg = idx & 255, row0 = (idx >> 8) * 32, c0 = cg * 8;
            float cw[4][8], cb[8], xm3[8], xm2[8], xm1[8];
#pragma unroll
            for (int tp = 0; tp < 4; ++tp) { const f32x4 a = *(const f32x4*)(od_conv_w + tp * DM + c0), b = *(const f32x4*)(od_conv_w + tp * DM + c0 + 4);
#pragma unroll
                for (int j = 0; j < 4; ++j) { cw[tp][j] = a[j]; cw[tp][4 + j] = b[j]; } }
            { const f32x4 a = *(const f32x4*)(od_conv_b + c0), b = *(const f32x4*)(od_conv_b + c0 + 4);
#pragma unroll
              for (int j = 0; j < 4; ++j) { cb[j] = a[j]; cb[4 + j] = b[j]; } }
            const bool first = (row0 & (SEQ - 1)) == 0;
#define LD8(dst, r_) do { const u32x4 w_ = *(const u32x4*)(XBR + (size_t)(r_) * DM + c0); dst[0] = bflo(w_.x); dst[1] = bfhi(w_.x); dst[2] = bflo(w_.y); dst[3] = bfhi(w_.y); dst[4] = bflo(w_.z); dst[5] = bfhi(w_.z); dst[6] = bflo(w_.w); dst[7] = bfhi(w_.w); } while (0)
            if (first) {
#pragma unroll
                for (int j = 0; j < 8; ++j) { xm3[j] = 0.f; xm2[j] = 0.f; xm1[j] = 0.f; }
            } else { LD8(xm3, row0 - 3); LD8(xm2, row0 - 2); LD8(xm1, row0 - 1); }
#pragma unroll 4
            for (int r = 0; r < 32; ++r) { float xt[8], y[8]; LD8(xt, row0 + r);
#pragma unroll
                for (int j = 0; j < 8; ++j) { y[j] = cb[j] + cw[0][j] * xm3[j] + cw[1][j] * xm2[j] + cw[2][j] * xm1[j] + cw[3][j] * xt[j]; xm3[j] = xm2[j]; xm2[j] = xm1[j]; xm1[j] = xt[j]; }
                u32x4 w; w.x = pk2(y[0], y[1]); w.y = pk2(y[2], y[3]); w.z = pk2(y[4], y[5]); w.w = pk2(y[6], y[7]); *(u32x4*)(XC + (size_t)(row0 + r) * DM + c0) = w; }
#undef LD8
        }
    }
    }
    SEAM(8);

    for (int rep_ = 0; rep_ < NREP(9); ++rep_) { if (rep_ > 0 && !MK_PER_PHASE) xcd_barrier(bar);
    if (IN(9)) { PHASE_ARGS();
        pg8::ProbGates g{(const char*)XC, (const char*)Wai, (unsigned)DM * 2u, 512u, 4}; pg8::StaticOrder S; S.init(T / 256, 16, G, vwg);
        epi::EpiGatesScan E{XC, od_b_a, od_b_i, spl, GG, YB, scanA, (unsigned*)(ctl + CW_SCANF)};
        pg8::gemm_phase(ring, lepi, g, S, E, wave_s);
    }
    }
    SEAM(9);


    for (int rep_ = 0; rep_ < NREP(13); ++rep_) { if (rep_ > 0 && !MK_PER_PHASE) xcd_barrier(bar);
    if (IN(13)) { PHASE_ARGS();
        pg8::ProbPlain g{(const char*)YB, (const char*)Wo2, (unsigned)DM * 2u, (unsigned)DM * 2u, DM / 64}; pg8::StaticOrder S; S.init(T / 256, DM / 256, G, vwg);
        epi::EpiResid<false> E{XB, nullptr, XB, nullptr};
        pg8::gemm_phase(ring, lepi, g, S, E, wave_s);
    }
    }
    SEAM(13);

    for (int rep_ = 0; rep_ < NREP(14); ++rep_) { if (rep_ > 0 && !MK_PER_PHASE) xcd_barrier(bar);
    if (IN(14)) { PHASE_ARGS(); PHASE_IDS();
        LAS float* Rg = (LAS float*)ring;
        LAS int* lcnt = (LAS int*)lepi;
        for (int i = tid; i < DM * 8; i += NTHR) { const int k = i >> 3, e = i & 7; Rg[e * DM + k] = od_ffn_norm[k] * od_router[i]; }
        for (int c = wg; c < T / 64; c += G) {
            if (tid < 8) lcnt[tid] = 0;
            __syncthreads();
            const int t0 = c * 64 + wave * 8;
            float acc[8][8], ssq[8];
#pragma unroll
            for (int q = 0; q < 8; ++q) { ssq[q] = 0.f;
#pragma unroll
                for (int e = 0; e < 8; ++e) acc[q][e] = 0.f; }
#pragma unroll 2
            for (int i = 0; i < 16; ++i) { const int k = 2 * lane + 128 * i; f32x2 rv[8]; unsigned xw[8];
#pragma unroll
                for (int e = 0; e < 8; ++e) rv[e] = *(const LAS f32x2*)(Rg + e * DM + k);
#pragma unroll
                for (int q = 0; q < 8; ++q) xw[q] = *(const unsigned*)(XB + (size_t)(t0 + q) * DM + k);
#pragma unroll
                for (int q = 0; q < 8; ++q) { const float x0 = bflo(xw[q]), x1 = bfhi(xw[q]); ssq[q] += x0 * x0 + x1 * x1;
#pragma unroll
                    for (int e = 0; e < 8; ++e) acc[q][e] += x0 * rv[e].x + x1 * rv[e].y; } }
#pragma unroll
            for (int q = 0; q < 8; ++q) { const float sq = wave_sum(ssq[q]); const float rs = 1.0f / sqrtf(sq * (1.0f / DM) + EPS);
                float lg[8];
#pragma unroll
                for (int e = 0; e < 8; ++e) lg[e] = wave_sum(acc[q][e]) * rs;
                int i0 = 0; float v0 = lg[0];
#pragma unroll
                for (int e = 1; e < 8; ++e) if (lg[e] > v0) { v0 = lg[e]; i0 = e; }
                int i1 = -1; float v1 = -__builtin_inff();
#pragma unroll
                for (int e = 0; e < 8; ++e) if (e != i0 && lg[e] > v1) { v1 = lg[e]; i1 = e; }
                if (lane == 0) { const int t = t0 + q; const float w0 = 1.0f / (1.0f + expf(v1 - v0));
                    tok_e[t] = i0 | (i1 << 8); tok_w[2 * t] = w0; tok_w[2 * t + 1] = 1.0f - w0; rstd3[t] = rs;
                    atomicAdd((int*)&lcnt[i0], 1); atomicAdd((int*)&lcnt[i1], 1); } }
            __syncthreads();
            if (tid < 8) cnt_chunk[c * 8 + tid] = lcnt[tid];
            __syncthreads();
        }
    }
    }
    SEAM(14);

    for (int rep_ = 0; rep_ < NREP(15); ++rep_) { if (rep_ > 0 && !MK_PER_PHASE) xcd_barrier(bar);
    if (IN(15)) { PHASE_ARGS(); PHASE_IDS();
        LAS int* li = (LAS int*)lepi;
        for (int c = wg; c < T / 64; c += G) {
            LAS int* lcnt = li + 256; LAS int* lte = li + 2304; LAS float* ltw = (LAS float*)(li + 2368); LAS float* lrs = (LAS float*)(li + 2496);
            for (int i = tid; i < (T / 64) * 8; i += NTHR) lcnt[i] = cnt_chunk[i];
            if (tid < 64) { lte[tid] = tok_e[c * 64 + tid]; lrs[tid] = rstd3[c * 64 + tid]; } else if (tid < 192) ltw[tid - 64] = tok_w[c * 128 + tid - 64];
            __syncthreads();
            if (tid < 8) { int run = 0, mine = 0; for (int cc = 0; cc < T / 64; ++cc) { if (cc == c) mine = run; run += lcnt[cc * 8 + tid]; } li[tid] = run; li[8 + tid] = mine; }
            __syncthreads();
            if (tid == 0) { int s = 0; for (int e = 0; e < 8; ++e) { li[16 + e] = s; s += ((li[e] + 255) >> 8) << 8; } li[24] = s; }
            __syncthreads();
            LAS int* lslot = li + 32;
            if (tid < 8) { const int e = tid; int pos = li[16 + e] + li[8 + e];
                for (int q = 0; q < 64; ++q) { const int t = c * 64 + q; const int pe = lte[q];
                    if ((pe & 255) == e) { slot_tok[pos] = t; slot_w[pos] = ltw[2 * q]; slot_rstd[pos] = lrs[q]; lslot[2 * q] = pos; ++pos; }
                    if ((pe >> 8) == e) { slot_tok[pos] = t; slot_w[pos] = ltw[2 * q + 1]; slot_rstd[pos] = lrs[q]; lslot[2 * q + 1] = pos; ++pos; } } }
            __syncthreads();
            if (tid < 128) tok_slot[c * 128 + tid] = lslot[tid];
            for (int q = wave; q < 64; q += NWAVES) {
                const u32x4* src = (const u32x4*)(XB + (size_t)(c * 64 + q) * DM) + lane; u32x2* d0 = (u32x2*)((unsigned char*)XG + (size_t)lslot[2 * q] * DM) + lane; u32x2* d1 = (u32x2*)((unsigned char*)XG + (size_t)lslot[2 * q + 1] * DM) + lane;
#pragma unroll
                for (int j = 0; j < 4; ++j) { const u32x4 v = src[64 * j]; u32x2 w; w.x = epi::pk4_fp8(bflo(v.x), bfhi(v.x), bflo(v.y), bfhi(v.y)); w.y = epi::pk4_fp8(bflo(v.z), bfhi(v.z), bflo(v.w), bfhi(v.w)); d0[64 * j] = w; d1[64 * j] = w; } }
            if (c == 0) {
                if (tid < 9) tpref[tid] = li[16 + tid] >> 8;
                for (int e = 0; e < 8; ++e) { const int a = li[16 + e] + li[e], z = li[16 + e + 1]; for (int s = a + tid; s < z; s += NTHR) { slot_tok[s] = 0; slot_w[s] = 0.f; slot_rstd[s] = 0.f; } }
            }
            __syncthreads();
        }
    }
    }
    SEAM(15);

    for (int rep_ = 0; rep_ < NREP(16); ++rep_) { if (rep_ > 0 && !MK_PER_PHASE) xcd_barrier(bar);
    if (IN(16)) { PHASE_ARGS();
        pg8::MoeOrder S;
#pragma unroll
        for (int k = 0; k < 9; ++k) S.pf[k] = __builtin_amdgcn_readfirstlane(tpref[k]);
        S.so.init(S.pf[8], 2 * DFF / 256, G, vwg);
        pg8::ProbMoeUp g{(const char*)XG, (const char*)Egu, (unsigned)DM, (unsigned)DM, DM / 128};
        epi::EpiSwiGLUFp8 E{(unsigned char*)HE, slot_rstd};
        pg8::gemm_phase(ring, lepi, g, S, E, wave_s);
    }
    }
    SEAM(16);

    for (int rep_ = 0; rep_ < NREP(17); ++rep_) { if (rep_ > 0 && !MK_PER_PHASE) xcd_barrier(bar);
    if (IN(17)) { PHASE_ARGS();
        pg8::MoeOrder S;
#pragma unroll
        for (int k = 0; k < 9; ++k) S.pf[k] = __builtin_amdgcn_readfirstlane(tpref[k]);
        S.so.init(S.pf[8], DM / 256, G, vwg);
        pg8::ProbMoeDown g{(const char*)HE, (const char*)Edn, (unsigned)DFF, (unsigned)DFF, DFF / 128};
        epi::EpiMoeDown E{(unsigned char*)XG, epi::Y_SCALE / (epi::W_DN_SCALE * epi::H_SCALE)};
        const int nj = S.pf[8] - 128;
        const bool use_tail = xloc && G == 256 && nj >= 1 && nj <= 8 && !MK_PER_PHASE;
        if (use_tail) S.so.i1 = 4;
        pg8::gemm_phase(ring, lepi, g, S, E, wave_s);
        if (use_tail) {
            pg8::MoeTailOrder ST; ST.so = S.so; ST.so.i1 = 1 << 30; ST.nj = nj;
#pragma unroll
            for (int k = 0; k < 9; ++k) ST.pf[k] = S.pf[k];
            pg8::ProbMoeDown g4{(const char*)HE, (const char*)Edn, (unsigned)DFF, (unsigned)DFF, DFF / 128 / 4};
            epi::EpiMoeDownTail ET{(unsigned char*)XG, epi::Y_SCALE / (epi::W_DN_SCALE * epi::H_SCALE), (float*)(AP->ws + WS_PART), (unsigned*)(ctl + CW_TAILF)};
            pg8::gemm_phase(ring, lepi, g4, ST, ET, wave_s);
        }
    }
    }
    SEAM(17);

    if (IN(18)) { PHASE_ARGS(); PHASE_IDS();
        for (int idx = gtid; idx < T * (DM / 8); idx += GT) { const int t = idx >> 8, c0 = (idx & 255) * 8;
            const int s0 = tok_slot[2 * t], s1 = tok_slot[2 * t + 1]; const float w0 = tok_w[2 * t] * (1.0f / epi::Y_SCALE), w1 = tok_w[2 * t + 1] * (1.0f / epi::Y_SCALE);
            const u32x2 a = *(const u32x2*)((const unsigned char*)XG + (size_t)s0 * DM + c0), b = *(const u32x2*)((const unsigned char*)XG + (size_t)s1 * DM + c0); const u32x4 x = *(const u32x4*)(XB + (size_t)t * DM + c0);
            const f32x2 a0 = __builtin_amdgcn_cvt_pk_f32_fp8((int)a.x, false), a1 = __builtin_amdgcn_cvt_pk_f32_fp8((int)a.x, true), a2 = __builtin_amdgcn_cvt_pk_f32_fp8((int)a.y, false), a3 = __builtin_amdgcn_cvt_pk_f32_fp8((int)a.y, true);
            const f32x2 b0 = __builtin_amdgcn_cvt_pk_f32_fp8((int)b.x, false), b1 = __builtin_amdgcn_cvt_pk_f32_fp8((int)b.x, true), b2 = __builtin_amdgcn_cvt_pk_f32_fp8((int)b.y, false), b3 = __builtin_amdgcn_cvt_pk_f32_fp8((int)b.y, true);
            f32x4 o0, o1;
            o0[0] = bflo(x.x) + (w0 * a0[0] + w1 * b0[0]); o0[1] = bfhi(x.x) + (w0 * a0[1] + w1 * b0[1]); o0[2] = bflo(x.y) + (w0 * a1[0] + w1 * b1[0]); o0[3] = bfhi(x.y) + (w0 * a1[1] + w1 * b1[1]);
            o1[0] = bflo(x.z) + (w0 * a2[0] + w1 * b2[0]); o1[1] = bfhi(x.z) + (w0 * a2[1] + w1 * b2[1]); o1[2] = bflo(x.w) + (w0 * a3[0] + w1 * b3[0]); o1[3] = bfhi(x.w) + (w0 * a3[1] + w1 * b3[1]);
            float* op = out + (size_t)t * DM + c0; *(f32x4*)op = o0; *(f32x4*)(op + 4) = o1; }
    }
#undef IN
#undef SEAM
#undef PHASE_IDS
#undef tok_slot
#undef TDECODE
#undef CONVERT_RANGE
#undef PHASE_ARGS
#undef x_in
#undef ev_attn_norm
#undef ev_w_in
#undef ev_qn_sb
#undef ev_kn_sb
#undef ev_qn_mb
#undef ev_kn_mb
#undef ev_w_o
#undef ev_ffn_norm
#undef ev_w_gate
#undef ev_w_up
#undef ev_w_down
#undef od_rec_norm
#undef od_w_in
#undef od_conv_w
#undef od_conv_b
#undef od_w_a
#undef od_b_a
#undef od_w_i
#undef od_b_i
#undef od_lambda
#undef od_w_o
#undef od_ffn_norm
#undef od_router
#undef od_we_gate
#undef od_we_up
#undef od_we_down
#undef ssq0
#undef ssq1
#undef ssq2
#undef ssq3
#undef kmean
#undef rope
#undef spl
#undef rstd3
#undef tok_e
#undef tok_w
#undef cnt_chunk
#undef slot_tok
#undef slot_w
#undef tpref
#undef gains
#undef slot_rstd
#undef XG
#undef scanA
#undef scanH
#undef scanC
#undef Wqkv
#undef Wo
#undef Wgu
#undef Wdn
#undef Win
#undef Wai
#undef Wo2
#undef Egu
#undef Edn
#undef XB
#undef XR
#undef QKV
#undef OB
#undef HB
#undef XBR
#undef GG
#undef XC
#undef AA
#undef UU
#undef YB
#undef HE
#undef out
}

extern "C" void kernel_launch(void* const* d_in, const int* in_sizes, int n_in, void* d_out, int out_size, void* d_ws, size_t ws_size, hipStream_t stream) {
    static int grid = 0;
    if (grid == 0) {
        if (n_in != 27 || in_sizes[0] != T * DM || out_size != T * DM || ws_size < WS_END) {
            fprintf(stderr, "kernel_launch: built for 27 inputs, x/out of %d floats, >= %zu bytes of workspace; got n_in %d, in0 %d, out %d, ws %zu; nothing launched\n", T * DM, (size_t)WS_END, n_in, n_in > 0 ? in_sizes[0] : -1, out_size, ws_size);
            grid = -1; return; }
        int dev = 0, cus = 0, per_cu = 0;
        if (hipGetDevice(&dev) != hipSuccess || hipDeviceGetAttribute(&cus, hipDeviceAttributeMultiprocessorCount, dev) != hipSuccess) { fprintf(stderr, "kernel_launch: device query failed\n"); grid = -1; return; }
        if (hipFuncSetAttribute((const void*)fwd_kernel, hipFuncAttributeMaxDynamicSharedMemorySize, LDS_BYTES) != hipSuccess) { fprintf(stderr, "kernel_launch: hipFuncSetAttribute failed\n"); grid = -1; return; }
        if (hipOccupancyMaxActiveBlocksPerMultiprocessor(&per_cu, (const void*)fwd_kernel, NTHR, LDS_BYTES) != hipSuccess || per_cu < 1)
            fprintf(stderr, "kernel_launch: note: occupancy query reports %d workgroups per CU\n", per_cu);
        (void)hipGetLastError();
        grid = cus;
    }
    if (grid < 0) return;
    if (hipMemsetAsync((char*)d_ws + WS_CTL, 0, CTL_ZERO_BYTES, stream) != hipSuccess) { fprintf(stderr, "kernel_launch: memset failed\n"); return; }
    Args a{};
    for (int i = 0; i < 27; ++i) a.in[i] = (const float*)d_in[i];
    a.out = (float*)d_out; a.ws = (unsigned char*)d_ws;
#if MK_PER_PHASE
    for (int p = 0; p < NPHASE; ++p) { a.ph_lo = p; a.ph_hi = p + 1; hipLaunchKernelGGL(fwd_kernel, dim3(grid), dim3(NTHR), LDS_BYTES, stream, a); }
#else
    a.ph_lo = 0; a.ph_hi = NPHASE;
    hipLaunchKernelGGL(fwd_kernel, dim3(grid), dim3(NTHR), LDS_BYTES, stream, a);
#endif
    const hipError_t le = hipPeekAtLastError();
    if (le != hipSuccess) fprintf(stderr, "kernel_launch: launch failed: %s\n", hipGetErrorName(le));
}
```

```cpp
#include <hip/hip_runtime.h>
#include <cstdio>
#include <cstdint>

#define LAS __attribute__((address_space(3)))
#define GAS __attribute__((address_space(1)))
typedef unsigned short bf16;
typedef short bf16x8 __attribute__((ext_vector_type(8)));
typedef short s16x4 __attribute__((ext_vector_type(4)));
typedef float f32x2 __attribute__((ext_vector_type(2)));
typedef float f32x4 __attribute__((ext_vector_type(4)));
typedef float f32x16 __attribute__((ext_vector_type(16)));
typedef unsigned u32x2 __attribute__((ext_vector_type(2)));
typedef unsigned u32x4 __attribute__((ext_vector_type(4)));
typedef GAS unsigned gu32;

constexpr int NB = 4, SEQ = 4096, DM = 2048, T = NB * SEQ;
constexpr int HD = 128, NQKV = 6144, DFF = 7168, NEXP = 8, NSLOT_PAD = 2 * T + NEXP * 256;
constexpr float EPS = 1e-6f;
constexpr int NWAVES = 8, NTHR = 512;

__device__ __forceinline__ unsigned f2bf(float f) { unsigned u = __builtin_bit_cast(unsigned, f); return (u + 0x7fffu + ((u >> 16) & 1u)) >> 16; }
__device__ __forceinline__ unsigned pk2(float lo, float hi) { return f2bf(lo) | (f2bf(hi) << 16); }
__device__ __forceinline__ float bf2f(unsigned short h) { return __builtin_bit_cast(float, (unsigned)h << 16); }
__device__ __forceinline__ float bflo(unsigned w) { return __builtin_bit_cast(float, w << 16); }
__device__ __forceinline__ float bfhi(unsigned w) { return __builtin_bit_cast(float, w & 0xffff0000u); }
__device__ __forceinline__ unsigned cvt_pk_bf16(float lo, float hi) { unsigned r; asm volatile("v_cvt_pk_bf16_f32 %0, %1, %2" : "=v"(r) : "v"(lo), "v"(hi)); return r; }
__device__ __forceinline__ float wave_sum(float v) {
#pragma unroll
    for (int o = 1; o < 64; o <<= 1) v += __shfl_xor(v, o);
    return v;
}
__device__ __forceinline__ float fast_exp(float x) { return __builtin_amdgcn_exp2f(x * 1.4426950408889634f); }
__device__ __forceinline__ float fast_sigmoid(float x) { return __builtin_amdgcn_rcpf(1.0f + fast_exp(-x)); }

namespace pg8 {
constexpr int BM = 256, BK = 64, HALF = 128, HTB = HALF * BK * 2, STAGE_BYTES = 8 * HTB, NXCD = 8, WGM = 8;
__host__ __device__ __forceinline__ int lds_byte(int r, int c) { const int st = (r >> 4) * 2 + (c >> 5), rr = r & 15, cc = c & 31, ob = rr * 64 + cc * 2; return st * 1024 + (ob ^ (((ob >> 9) & 1) << 5)); }
__host__ __device__ __forceinline__ void stage_rc(int b, int& R, int& C) { const int st = b / 1024, sb = b % 1024, swz = sb ^ (((sb >> 9) & 1) << 5); R = (st >> 1) * 16 + swz / 64; C = (st & 1) * 32 + (swz % 64) / 2; }
__host__ __device__ __forceinline__ int perm_a64(int r) { return (r & ~63) + 4 * (r & 15) + ((r >> 4) & 3); }
template <class E, class = void> struct aperm_of { static constexpr bool v = false; };
template <class E> struct aperm_of<E, decltype((void)E::APERM)> { static constexpr bool v = E::APERM; };
__host__ __device__ __forceinline__ int perm32(int rho) { const int n = rho >> 4, i = rho & 15; return 8 * (i >> 2) + 4 * n + (i & 3); }

struct Unit { int pm, pn, e, ks, ti; };

struct StaticOrder {
    int nM, nN, nwg, G, c, i0 = 0, i1 = 1 << 30;
    __device__ __forceinline__ void init(int nM_, int nN_, int G_, int c_) { nM = nM_; nN = nN_; nwg = nM * nN; G = G_; c = c_; }
    __device__ __forceinline__ bool unit_at(long L, Unit& u) const {
        if (L >= nwg) return false;
        int wgid = (int)L; { const int q = nwg / NXCD, r = nwg % NXCD, xcd = wgid % NXCD, off = wgid / NXCD; wgid = (xcd < r ? xcd * (q + 1) : r * (q + 1) + (xcd - r) * q) + off; }
        const int nig = WGM * nN, gid = wgid / nig, fm = gid * WGM, gsz = (nM - fm) < WGM ? (nM - fm) : WGM;
        u.pm = fm + ((wgid % nig) % gsz); u.pn = (wgid % nig) / gsz; u.e = 0; u.ks = 0; u.ti = 0; return true;
    }
    __device__ __forceinline__ bool next(int i, Unit& u) const {
        i += i0; if (i >= i1) return false;
        return unit_at((long)i * G + c, u);
    }
};
struct MoeOrder {
    StaticOrder so; int pf[9]; int tail_first = -1, tail_n = 0;
    __device__ __forceinline__ bool next(int i, Unit& u) const {
        if (tail_first >= 0) { const long L2 = (long)i * so.G + so.c; if (L2 >= 4L * tail_n) return false; if (!so.unit_at(tail_first + (L2 >> 2), u)) return false; u.ks = (int)(L2 & 3); }
        else if (!so.next(i, u)) return false;
        int e = 0;
#pragma unroll
        for (int k = 1; k < 8; ++k) e += (u.pm >= pf[k]) ? 1 : 0;
        u.e = e; return true;
    }
};
struct MoeTailOrder {
    StaticOrder so; int pf[9]; int nj;
    __device__ __forceinline__ bool next(int i, Unit& u) const {
        if (i != 0) return false;
        const int x = so.c & 7, r = so.c >> 3; if (r >= 4 * nj) return false;
        if (!so.unit_at(8L * (128 + (r >> 2)) + x, u)) return false;
        u.ks = r & 3; u.ti = x * 8 + (r >> 2);
        int e = 0;
#pragma unroll
        for (int k = 1; k < 8; ++k) e += (u.pm >= pf[k]) ? 1 : 0;
        u.e = e; return true;
    }
};

struct ProbPlain {
    static constexpr bool FP8 = false;
    const char* A; const char* B; unsigned lda, ldb; int nt;
    __device__ __forceinline__ const char* a_base(const Unit& u) const { return A + (size_t)u.pm * BM * lda; }
    __device__ __forceinline__ const char* b_base(const Unit& u) const { return B + (size_t)u.pn * BM * ldb; }
};
struct ProbPlainF8 {
    static constexpr bool FP8 = true;
    const char* A; const char* B; unsigned lda, ldb; int nt;
    __device__ __forceinline__ const char* a_base(const Unit& u) const { return A + (size_t)u.pm * BM * lda; }
    __device__ __forceinline__ const char* b_base(const Unit& u) const { return B + (size_t)u.pn * BM * ldb; }
};
struct ProbGates {
    static constexpr bool FP8 = false;
    const char* A; const char* B; unsigned lda, ldb; int nt;
    __device__ __forceinline__ const char* a_base(const Unit& u) const { return A + (size_t)u.pm * BM * lda + (size_t)(u.pn >> 1) * 512; }
    __device__ __forceinline__ const char* b_base(const Unit& u) const { return B + (size_t)u.pn * BM * ldb; }
};
struct ProbMoeUp {
    static constexpr bool FP8 = true;
    const char* A; const char* B; unsigned lda, ldb; int nt;
    __device__ __forceinline__ const char* a_base(const Unit& u) const { return A + (size_t)u.pm * BM * lda; }
    __device__ __forceinline__ const char* b_base(const Unit& u) const { return B + ((size_t)u.e * (2 * DFF) + (size_t)u.pn * BM) * ldb; }
};
struct ProbMoeDown {
    static constexpr bool FP8 = true;
    const char* A; const char* B; unsigned lda, ldb; int nt;
    __device__ __forceinline__ const char* a_base(const Unit& u) const { return A + (size_t)u.pm * BM * lda + (size_t)u.ks * nt * 128; }
    __device__ __forceinline__ const char* b_base(const Unit& u) const { return B + ((size_t)u.e * DM + (size_t)u.pn * BM) * ldb + (size_t)u.ks * nt * 128; }
};
typedef int v8i32 __attribute__((ext_vector_type(8)));
typedef short s16x16 __attribute__((ext_vector_type(16)));
__device__ __forceinline__ v8i32 cat8(bf16x8 lo, bf16x8 hi) { const s16x16 v = __builtin_shufflevector(lo, hi, 0, 1, 2, 3, 4, 5, 6, 7, 8, 9, 10, 11, 12, 13, 14, 15); return __builtin_bit_cast(v8i32, v); }

template <class Epi, class Sched, class Prob>
__device__ __forceinline__ void gemm_phase(LAS unsigned char* lds, LAS unsigned char* lds_epi, const Prob g, const Sched& S, const Epi& E, int wid) {
    const int lane = (int)__builtin_amdgcn_mbcnt_hi(~0u, __builtin_amdgcn_mbcnt_lo(~0u, 0u)), tid = wid * 64 + lane, wr = wid >> 2, wc = wid & 3, fr = lane & 15, fq = lane >> 4;
    const int nt = g.nt;
    int R0, C0, R1, C1; stage_rc(tid * 16, R0, C0); stage_rc(tid * 16 + 8192, R1, C1);
    const unsigned lda2 = g.lda, ldb2 = g.ldb;
    const int Rb0 = Epi::PERM ? ((R0 & ~31) + perm32(R0 & 31)) : R0, Rb1 = Epi::PERM ? ((R1 & ~31) + perm32(R1 & 31)) : R1;
    const unsigned vB0 = (unsigned)Rb0 * ldb2 + (unsigned)C0 * 2u, vB1 = (unsigned)Rb1 * ldb2 + (unsigned)C1 * 2u;
    const unsigned hstepB = (unsigned)HALF * ldb2;
    const size_t kstep = (size_t)(BK * 2);
    const unsigned ldsw = (unsigned)wid * 1024u;
    const int aoff = lds_byte(wr * 64 + fr, fq * 8), boff = lds_byte(wc * 32 + fr, fq * 8);
#define PG8_SA(b, h) (((b) * 2 + (h)) * HTB)
#define PG8_SB(b, h) ((4 + (b) * 2 + (h)) * HTB)
#define PG8_STAGE(bufoff, gbase, o0, o1) do { \
        __builtin_amdgcn_global_load_lds((const unsigned*)((const char*)(gbase) + (o0)), (LAS unsigned*)(lds + (bufoff) + ldsw), 16, 0, 0); \
        __builtin_amdgcn_global_load_lds((const unsigned*)((const char*)(gbase) + (o1)), (LAS unsigned*)(lds + (bufoff) + ldsw + 8192), 16, 0, 0); } while (0)
#define PG8_LDA(dst, b, h) do { _Pragma("unroll") for (int m = 0; m < 4; ++m) _Pragma("unroll") for (int k = 0; k < 2; ++k) dst[m][k] = *(const LAS bf16x8*)(lds + PG8_SA(b, h) + aoff + m * 2048 + k * 1024); } while (0)
#define PG8_LDB(dst, b, h) do { _Pragma("unroll") for (int n = 0; n < 2; ++n) _Pragma("unroll") for (int k = 0; k < 2; ++k) dst[n][k] = *(const LAS bf16x8*)(lds + PG8_SB(b, h) + boff + n * 2048 + k * 1024); } while (0)
#define PG8_MMA(ai, bj, At, Bt) do { __builtin_amdgcn_s_setprio(1); \
        if constexpr (Prob::FP8) { _Pragma("unroll") for (int m = 0; m < 4; ++m) _Pragma("unroll") for (int n = 0; n < 2; ++n) \
            asm volatile("v_mfma_f32_16x16x128_f8f6f4 %0, %1, %2, %0" : "+v"(acc[ai][bj][m][n]) : "v"(cat8(Bt[n][0], Bt[n][1])), "v"(cat8(At[m][0], At[m][1]))); } \
        else { _Pragma("unroll") for (int m = 0; m < 4; ++m) _Pragma("unroll") for (int n = 0; n < 2; ++n) _Pragma("unroll") for (int k = 0; k < 2; ++k) \
            acc[ai][bj][m][n] = __builtin_amdgcn_mfma_f32_16x16x32_bf16(Bt[n][k], At[m][k], acc[ai][bj][m][n], 0, 0, 0); } \
        __builtin_amdgcn_s_setprio(0); } while (0)
#define PG8_WAIT_V(n) asm volatile("s_waitcnt vmcnt(" #n ")" ::: "memory")
#define PG8_WAIT_L(n) asm volatile("s_waitcnt lgkmcnt(" #n ")" ::: "memory")
#define PG8_BAR __builtin_amdgcn_s_barrier()
#define PG8_SCHED __builtin_amdgcn_sched_barrier(0)
    Unit cur, nxt; int ui = 0; int epi_pm = -1;
    if (!S.next(0, cur)) return;
    const int Ra0 = aperm_of<Epi>::v ? perm_a64(R0) : R0, Ra1 = aperm_of<Epi>::v ? perm_a64(R1) : R1;
    const unsigned cA00 = (unsigned)Ra0 * lda2 + (unsigned)C0 * 2u, cA01 = (unsigned)Ra1 * lda2 + (unsigned)C1 * 2u, cA10 = cA00 + (unsigned)HALF * lda2, cA11 = cA01 + (unsigned)HALF * lda2;
    f32x4 acc[2][2][4][2];
#define PG8_ACC_INIT(unit) do { if constexpr (Epi::ACC_INIT) { E.init(acc, unit, wr, wc, fr, fq); } else { \
        _Pragma("unroll") for (int a = 0; a < 2; ++a) _Pragma("unroll") for (int b = 0; b < 2; ++b) _Pragma("unroll") for (int m = 0; m < 4; ++m) _Pragma("unroll") for (int n = 0; n < 2; ++n) acc[a][b][m][n] = (f32x4){0.f, 0.f, 0.f, 0.f}; } } while (0)
    PG8_ACC_INIT(cur);
    bf16x8 At[4][2], B0[2][2], B1[2][2];
    const char* cA = g.a_base(cur); const char* cB = g.b_base(cur);
    PG8_STAGE(PG8_SB(0, 0), cB, vB0, vB1); PG8_STAGE(PG8_SB(0, 1), cB + hstepB, vB0, vB1); PG8_STAGE(PG8_SA(0, 0), cA, cA00, cA01); PG8_STAGE(PG8_SA(0, 1), cA, cA10, cA11);
    if (wr == 1) PG8_BAR;
    PG8_WAIT_V(2); PG8_BAR;
    PG8_STAGE(PG8_SB(1, 0), cB + kstep, vB0, vB1); PG8_STAGE(PG8_SA(1, 0), cA + kstep, cA00, cA01); PG8_STAGE(PG8_SB(1, 1), cB + hstepB + kstep, vB0, vB1);
    PG8_WAIT_V(6); PG8_BAR;
    for (;;) {
        const bool has_next = S.next(ui + 1, nxt);
        const char* nA = has_next ? g.a_base(nxt) : cA; const char* nB = has_next ? g.b_base(nxt) : cB;
_Pragma("clang loop unroll(disable)")
        for (int t = 0; t < nt; t += 2) {
            const bool last = (t == nt - 2);
            const char* a1 = cA + (size_t)(t + 1) * kstep;
            const char* a2 = last ? nA : cA + (size_t)(t + 2) * kstep; const char* b2 = last ? nB : cB + (size_t)(t + 2) * kstep;
            const char* a3 = a2 + kstep; const char* b3 = b2 + kstep;
            PG8_LDB(B0, 0, 0); PG8_LDB(B1, 0, 1); PG8_SCHED; PG8_LDA(At, 0, 0); PG8_STAGE(PG8_SA(1, 1), a1, cA10, cA11);
            PG8_WAIT_V(8); PG8_WAIT_L(0); PG8_BAR; PG8_MMA(0, 0, At, B0); PG8_MMA(0, 1, At, B1); PG8_BAR; PG8_SCHED;
            PG8_LDA(At, 0, 1); PG8_STAGE(PG8_SB(0, 0), b2, vB0, vB1); PG8_STAGE(PG8_SB(0, 1), b2 + hstepB, vB0, vB1); PG8_STAGE(PG8_SA(0, 0), a2, cA00, cA01);
            PG8_WAIT_V(8); PG8_WAIT_L(0); PG8_BAR; PG8_MMA(1, 0, At, B0); PG8_MMA(1, 1, At, B1); PG8_BAR; PG8_SCHED;
            PG8_LDB(B0, 1, 0); PG8_LDB(B1, 1, 1); PG8_SCHED; PG8_LDA(At, 1, 0); PG8_STAGE(PG8_SA(0, 1), a2, cA10, cA11);
            PG8_WAIT_V(8); PG8_WAIT_L(0); PG8_BAR; PG8_MMA(0, 0, At, B0); PG8_MMA(0, 1, At, B1); PG8_BAR; PG8_SCHED;
            PG8_LDA(At, 1, 1); PG8_STAGE(PG8_SB(1, 0), b3, vB0, vB1); PG8_STAGE(PG8_SB(1, 1), b3 + hstepB, vB0, vB1); PG8_STAGE(PG8_SA(1, 0), a3, cA00, cA01);
            PG8_WAIT_V(8); PG8_WAIT_L(0); PG8_BAR; PG8_MMA(1, 0, At, B0); PG8_MMA(1, 1, At, B1); PG8_BAR; PG8_SCHED;
        }
        if constexpr (Prob::FP8) asm volatile("s_nop 7\n\ts_nop 7\n\ts_nop 7" ::: "memory");
        if (wr == 0) PG8_BAR;
        E(acc, cur, wr, wc, fr, fq, lds_epi, wid, lane, epi_pm);
        if (!has_next) break;
        PG8_ACC_INIT(nxt);
        cur = nxt; cA = nA; cB = nB; ++ui;
        if (wr == 1) PG8_BAR;
    }
    PG8_WAIT_V(0);
    PG8_BAR;
#undef PG8_ACC_INIT
#undef PG8_SA
#undef PG8_SB
#undef PG8_STAGE
#undef PG8_LDA
#undef PG8_LDB
#undef PG8_MMA
#undef PG8_WAIT_V
#undef PG8_WAIT_L
#undef PG8_BAR
#undef PG8_SCHED
}
}
namespace att {
constexpr int PITCH = NQKV;
constexpr int SHM_V = 64 * 128 * 2, SHM_K = 64 * 128 * 2;
constexpr int LDS_Q = 2 * SHM_V + 2 * SHM_K, LDS_BYTES = LDS_Q + NWAVES * 8192;
constexpr int EPI_WS = 0, EPI_FLAG = NWAVES * 64 * 4;
constexpr float SCALE = 0.08838834764831845f;
constexpr float C2 = 1.4426950408889634f * SCALE;
#define KSWZ(row, colB) ((row) * 256 + ((colB) ^ (((row) & 7) << 4)))
#define SBAR() __builtin_amdgcn_sched_barrier(0)
__device__ __forceinline__ int v_st(int k, int c) { const int kk = (k & ~0xC) | ((k & 4) << 1) | ((k & 8) >> 1); return ((kk >> 3) * 4 + (c >> 5)) * 512 + ((kk & 7) * 32 + (c & 31)) * 2; }
__device__ __forceinline__ int v_rd_base(int lane) { return ((lane & 3) << 3) | (((lane >> 2) & 3) << 6) | (((lane >> 4) & 1) << 5) | (((lane >> 5) & 1) << 8); }
constexpr int v_rd_off(int d0, int ks, int half) { return d0 * 512 + ks * 4096 + half * 2048; }
__device__ __forceinline__ int crow(int r, int hi) { return (r & 3) + 8 * (r >> 2) + 4 * hi; }

template <int KB>
__device__ __forceinline__ void qkt(f32x16& p0, f32x16& p1, LAS const unsigned char* K_lds, LAS const unsigned char* q_lds, int r32, int hi) {
    p0 = f32x16{}; p1 = f32x16{};
    LAS const unsigned char* kb[4];
#pragma unroll
    for (int dd = 0; dd < 4; ++dd) kb[dd] = K_lds + KB * SHM_K + KSWZ(r32, (dd * 16 + hi * 8) * 2);
#pragma unroll
    for (int d0 = 0; d0 < 8; ++d0) { LAS const unsigned char* a = kb[d0 & 3] + (d0 >> 2) * 128;
        const bf16x8 b0 = *(LAS const bf16x8*)(a);
        const bf16x8 b1 = *(LAS const bf16x8*)(a + 32 * 256);
        const bf16x8 qv = *(LAS const bf16x8*)(q_lds + d0 * 1024);
        p0 = __builtin_amdgcn_mfma_f32_32x32x16_bf16(b0, qv, p0, 0, 0, 0);
        p1 = __builtin_amdgcn_mfma_f32_32x32x16_bf16(b1, qv, p1, 0, 0, 0);
        if ((d0 & 3) == 3) SBAR(); }
}
template <int VB>
__device__ __forceinline__ void pv_tile(f32x16* o, int vb0, bf16x8 pa0, bf16x8 pa1, bf16x8 pa2, bf16x8 pa3) {
#define TRRD(dst, off) asm volatile("ds_read_b64_tr_b16 %0, %1 offset:%2" : "=&v"(dst) : "v"(vb0), "i"(off) : "memory")
#define PV_D0(d0) do { s16x4 l0, l1, l2, l3, h0, h1, h2, h3; constexpr int b_ = VB * SHM_V + v_rd_off(d0, 0, 0); \
        TRRD(l0, b_); TRRD(h0, b_ + 2048); TRRD(l1, b_ + 4096); TRRD(h1, b_ + 6144); TRRD(l2, b_ + 8192); TRRD(h2, b_ + 10240); TRRD(l3, b_ + 12288); TRRD(h3, b_ + 14336); \
        asm volatile("s_waitcnt lgkmcnt(0)" ::: "memory"); SBAR(); \
        o[d0] = __builtin_amdgcn_mfma_f32_32x32x16_bf16(pa0, (bf16x8){l0[0], l0[1], l0[2], l0[3], h0[0], h0[1], h0[2], h0[3]}, o[d0], 0, 0, 0);   \
        o[d0] = __builtin_amdgcn_mfma_f32_32x32x16_bf16(pa1, (bf16x8){l1[0], l1[1], l1[2], l1[3], h1[0], h1[1], h1[2], h1[3]}, o[d0], 0, 0, 0);   \
        o[d0] = __builtin_amdgcn_mfma_f32_32x32x16_bf16(pa2, (bf16x8){l2[0], l2[1], l2[2], l2[3], h2[0], h2[1], h2[2], h2[3]}, o[d0], 0, 0, 0);   \
        o[d0] = __builtin_amdgcn_mfma_f32_32x32x16_bf16(pa3, (bf16x8){l3[0], l3[1], l3[2], l3[3], h3[0], h3[1], h3[2], h3[3]}, o[d0], 0, 0, 0); } while (0)
    PV_D0(0); PV_D0(1); PV_D0(2); PV_D0(3);
#undef PV_D0
#undef TRRD
}
__device__ __forceinline__ void pack_p(const f32x16& p0, const f32x16& p1, bf16x8& pa0, bf16x8& pa1, bf16x8& pa2, bf16x8& pa3) {
#define PK4(P, B_, OUT) do { unsigned a0 = cvt_pk_bf16(P[B_+0], P[B_+1]), a1 = cvt_pk_bf16(P[B_+2], P[B_+3]);                          \
        unsigned b0 = cvt_pk_bf16(P[B_+4], P[B_+5]), b1 = cvt_pk_bf16(P[B_+6], P[B_+7]);                                             \
        auto r0 = __builtin_amdgcn_permlane32_swap(a0, b0, false, false); auto r1 = __builtin_amdgcn_permlane32_swap(a1, b1, false, false); \
        u32x4 w = {r0[0], r1[0], r0[1], r1[1]}; OUT = *reinterpret_cast<bf16x8*>(&w); } while (0)
    PK4(p0, 0, pa0); PK4(p0, 8, pa1); PK4(p1, 0, pa2); PK4(p1, 8, pa3);
#undef PK4
}
__device__ __forceinline__ float lane_pair_sum(float v) {
    auto rr = __builtin_amdgcn_permlane32_swap(__float_as_uint(v), __float_as_uint(v), false, false);
    return __uint_as_float(rr[0]) + __uint_as_float(rr[1]);
}
__device__ __forceinline__ float lane_pair_max(float v) {
    auto rr = __builtin_amdgcn_permlane32_swap(__float_as_uint(v), __float_as_uint(v), false, false);
    return fmaxf(__uint_as_float(rr[0]), __uint_as_float(rr[1]));
}

#ifndef SB_EXIT_L2
#define SB_EXIT_L2 48.0f
#endif

template <int MODE>
__device__ __forceinline__ void attn_unit(const bf16* __restrict__ qkv, bf16* __restrict__ O, const float* __restrict__ kmean, int b, int h, int qb, LAS unsigned char* ldsl, LAS unsigned char* lepi, int wid) {
    const int lane = (int)__builtin_amdgcn_mbcnt_hi(~0u, __builtin_amdgcn_mbcnt_lo(~0u, 0u)), tid = wid * 64 + lane, r32 = lane & 31, hi = lane >> 5;
    const size_t rowbase = (size_t)b * SEQ;
    const bf16* Qp = qkv + (MODE == 0 ? 0 : 3 * 1024) + h * HD;
    const bf16* Kp = Qp + 1024 + rowbase * PITCH; const bf16* Vp = Qp + 2048 + rowbase * PITCH;
    LAS const unsigned char* K_lds = ldsl + 2 * SHM_V;
    LAS float* ws = (LAS float*)(lepi + EPI_WS) + wid * 64; LAS float* li_l = ws; LAS float* al_l = ws + 32;
    volatile LAS int* flags = (volatile LAS int*)(lepi + EPI_FLAG);
    LAS unsigned char* q_lds = ldsl + LDS_Q + wid * 8192 + lane * 16;
    const int qlo = qb * 256 + wid * 32, qpos = qlo + r32;
#pragma unroll
    for (int d0 = 0; d0 < 8; ++d0) *(LAS bf16x8*)(q_lds + d0 * 1024) = *(const bf16x8*)(Qp + (rowbase + qpos) * PITCH + d0 * 16 + hi * 8);
    const int NT = 4 * (qb + 1);
    const int vb0 = (int)(unsigned)(uintptr_t)ldsl + v_rd_base(lane);
    unsigned koff0, koff1, voff0, voff1;
    { const int b0 = tid * 16, b1 = b0 + 8192;
      { const int row = b0 >> 8, cb = b0 & 255, colB = cb ^ ((row & 7) << 4); koff0 = (unsigned)(row * PITCH + (colB >> 1)) * 2u; }
      { const int row = b1 >> 8, cb = b1 & 255, colB = cb ^ ((row & 7) << 4); koff1 = (unsigned)(row * PITCH + (colB >> 1)) * 2u; }
      { const int st = b0 >> 9, wb = b0 & 511, kk = (st >> 2) * 8 + (wb >> 6), c = (st & 3) * 32 + ((wb & 63) >> 1), k = (kk & ~0xC) | ((kk & 4) << 1) | ((kk & 8) >> 1); voff0 = (unsigned)(k * PITCH + c) * 2u; }
      { const int st = b1 >> 9, wb = b1 & 511, kk = (st >> 2) * 8 + (wb >> 6), c = (st & 3) * 32 + ((wb & 63) >> 1), k = (kk & ~0xC) | ((kk & 4) << 1) | ((kk & 8) >> 1); voff1 = (unsigned)(k * PITCH + c) * 2u; } }
    const unsigned ldsw = (unsigned)wid * 1024u;
#define TILE_KB(t) (MODE == 0 ? 64 * (NT - 1 - (t)) : 64 * (t))
#define DMA_TILE(kb_, bf) do { const char* kg_ = (const char*)(Kp + (size_t)(kb_) * PITCH); const char* vg_ = (const char*)(Vp + (size_t)(kb_) * PITCH); \
        __builtin_amdgcn_global_load_lds((const unsigned*)(vg_ + voff0), (LAS unsigned*)(ldsl + (bf) * SHM_V + ldsw), 16, 0, 0); \
        __builtin_amdgcn_global_load_lds((const unsigned*)(vg_ + voff1), (LAS unsigned*)(ldsl + (bf) * SHM_V + ldsw + 8192), 16, 0, 0); \
        __builtin_amdgcn_global_load_lds((const unsigned*)(kg_ + koff0), (LAS unsigned*)(ldsl + 2 * SHM_V + (bf) * SHM_K + ldsw), 16, 0, 0); \
        __builtin_amdgcn_global_load_lds((const unsigned*)(kg_ + koff1), (LAS unsigned*)(ldsl + 2 * SHM_V + (bf) * SHM_K + ldsw + 8192), 16, 0, 0); } while (0)
    DMA_TILE(TILE_KB(0), 0);
    unsigned selmask = 0u;
    if constexpr (MODE == 1) {
        float gate[15]; float m1 = -__builtin_inff(), m2 = m1, m3 = m1;
#pragma unroll
        for (int j = 0; j < 15; ++j) {
            gate[j] = -__builtin_inff();
            if (j < qb) {
                const float* km = kmean + ((size_t)((b * 8 + h) * 16 + j)) * HD + hi * 8;
                float a = 0.f;
#pragma unroll
                for (int d0 = 0; d0 < 8; ++d0) {
                    const f32x4 k0 = *(const f32x4*)(km + d0 * 16), k1 = *(const f32x4*)(km + d0 * 16 + 4);
                    const u32x4 qw = *(LAS const u32x4*)(q_lds + d0 * 1024);
                    a += bflo(qw[0]) * k0[0] + bfhi(qw[0]) * k0[1] + bflo(qw[1]) * k0[2] + bfhi(qw[1]) * k0[3]
                       + bflo(qw[2]) * k1[0] + bfhi(qw[2]) * k1[1] + bflo(qw[3]) * k1[2] + bfhi(qw[3]) * k1[3];
                }
                const float g = lane_pair_sum(a);
                gate[j] = g;
                const float t1 = fminf(m1, g); m1 = fmaxf(m1, g); const float t2 = fminf(m2, t1); m2 = fmaxf(m2, t1); m3 = fmaxf(m3, t2);
            }
        }
#pragma unroll
        for (int j = 0; j < 15; ++j) if (j < qb && gate[j] >= m3) selmask |= (1u << j);
    }
    float m_reg = -1e30f, l_reg = 0.f, cacc = 0.f; f32x16 o[4] = {};
    asm volatile("s_waitcnt vmcnt(0)" ::: "memory");
    __syncthreads();
    bool stop = false;
#define STEP(t, BUF) do { \
        const int kb_ = TILE_KB(t); const bool more_ = ((t) + 1 < NT); \
        if (more_) DMA_TILE(TILE_KB((t) + 1), (BUF) ^ 1); \
        SBAR(); \
        if constexpr (MODE == 1) { \
            const int jb_ = kb_ >> 8; bool act_; bool own_ = (jb_ == qb); const bool sel_ = ((selmask >> jb_) & 1u) != 0u; \
            if (own_) act_ = (kb_ <= qlo + 31); else act_ = __any(sel_); \
            if (act_) { \
                f32x16 p0, p1; qkt<BUF>(p0, p1, K_lds, q_lds, r32, hi); SBAR(); \
                const float NEG = -__builtin_inff(); \
                if (own_) { if (kb_ + 63 > qlo) { const int dq = qpos - kb_ - 4 * hi; \
                        _Pragma("unroll") for (int r = 0; r < 16; ++r) { const int c = (r & 3) + 8 * (r >> 2); if (c > dq) p0[r] = NEG; if (c + 32 > dq) p1[r] = NEG; } } } \
                else if (!sel_) { _Pragma("unroll") for (int r = 0; r < 16; ++r) { p0[r] = NEG; p1[r] = NEG; } } \
                float pmax = p0[0]; _Pragma("unroll") for (int r = 1; r < 16; ++r) pmax = fmaxf(pmax, p0[r]); _Pragma("unroll") for (int r = 0; r < 16; ++r) pmax = fmaxf(pmax, p1[r]); \
                pmax = lane_pair_max(pmax); \
                float mn, alpha; \
                if (__all((pmax - m_reg) * SCALE <= 8.0f)) { mn = m_reg; alpha = 1.f; } \
                else { mn = fmaxf(m_reg, pmax); alpha = __builtin_amdgcn_exp2f((m_reg - mn) * C2); m_reg = mn; } \
                if (__any(alpha < 1.f)) { if (hi == 0) al_l[r32] = alpha; asm volatile("s_waitcnt lgkmcnt(0)" ::: "memory"); \
                    _Pragma("unroll") for (int d_ = 0; d_ < 4; ++d_) _Pragma("unroll") for (int r = 0; r < 16; ++r) o[d_][r] *= al_l[crow(r, hi)]; } \
                const float mnL = -mn * C2; float ps = 0.f; \
                _Pragma("unroll") for (int r = 0; r < 16; ++r) { p0[r] = __builtin_amdgcn_exp2f(fmaf(p0[r], C2, mnL)); p1[r] = __builtin_amdgcn_exp2f(fmaf(p1[r], C2, mnL)); ps += p0[r] + p1[r]; } \
                ps = lane_pair_sum(ps); l_reg = l_reg * alpha + ps; \
                bf16x8 pa0, pa1, pa2, pa3; pack_p(p0, p1, pa0, pa1, pa2, pa3); SBAR(); \
                pv_tile<BUF>(o, vb0, pa0, pa1, pa2, pa3); \
            } \
        } else { \
            const bool act_ = (kb_ < qlo + 31); \
            if (act_) { \
                f32x16 p0, p1; qkt<BUF>(p0, p1, K_lds, q_lds, r32, hi); SBAR(); \
                f32x16 k0, k1; \
                _Pragma("unroll") for (int r = 0; r < 16; ++r) { \
                    { const float z = p0[r] * C2, e = __builtin_amdgcn_exp2f(-fabsf(z)), sp = fmaxf(z, 0.f) + __builtin_amdgcn_logf(1.0f + e); k0[r] = -sp; p0[r] = z - sp; } \
                    { const float z = p1[r] * C2, e = __builtin_amdgcn_exp2f(-fabsf(z)), sp = fmaxf(z, 0.f) + __builtin_amdgcn_logf(1.0f + e); k1[r] = -sp; p1[r] = z - sp; } } \
                if (kb_ + 63 >= qlo) { const int dq = qpos - kb_ - 4 * hi; const float NEG = -__builtin_inff(); \
                    _Pragma("unroll") for (int r = 0; r < 16; ++r) { const int c = (r & 3) + 8 * (r >> 2); if (c >= dq) { p0[r] = NEG; k0[r] = 0.f; } if (c + 32 >= dq) { p1[r] = NEG; k1[r] = 0.f; } } } \
                SBAR(); float run = cacc; \
                _Pragma("unroll") for (int k = 7; k >= 0; --k) { const int g4 = 4 * (k & 3); \
                    const float s_ = (k < 4) ? ((k0[g4] + k0[g4 + 1]) + (k0[g4 + 2] + k0[g4 + 3])) : ((k1[g4] + k1[g4 + 1]) + (k1[g4 + 2] + k1[g4 + 3])); \
                    auto rr = __builtin_amdgcn_permlane32_swap(__float_as_uint(s_), __float_as_uint(s_), false, false); \
                    const float lo_ = __uint_as_float(rr[0]), hi_ = __uint_as_float(rr[1]); const float sg = run + (hi ? 0.f : hi_); \
                    if (k < 4) { const float e3 = sg, e2 = e3 + k0[g4 + 3], e1 = e2 + k0[g4 + 2], e0 = e1 + k0[g4 + 1]; \
                        p0[g4 + 3] = __builtin_amdgcn_exp2f(p0[g4 + 3] + e3); p0[g4 + 2] = __builtin_amdgcn_exp2f(p0[g4 + 2] + e2); p0[g4 + 1] = __builtin_amdgcn_exp2f(p0[g4 + 1] + e1); p0[g4] = __builtin_amdgcn_exp2f(p0[g4] + e0); } \
                    else { const float e3 = sg, e2 = e3 + k1[g4 + 3], e1 = e2 + k1[g4 + 2], e0 = e1 + k1[g4 + 1]; \
                        p1[g4 + 3] = __builtin_amdgcn_exp2f(p1[g4 + 3] + e3); p1[g4 + 2] = __builtin_amdgcn_exp2f(p1[g4 + 2] + e2); p1[g4 + 1] = __builtin_amdgcn_exp2f(p1[g4 + 1] + e1); p1[g4] = __builtin_amdgcn_exp2f(p1[g4] + e0); } \
                    run += lo_ + hi_; } \
                cacc = run; \
                bf16x8 pa0, pa1, pa2, pa3; pack_p(p0, p1, pa0, pa1, pa2, pa3); SBAR(); \
                pv_tile<BUF>(o, vb0, pa0, pa1, pa2, pa3); \
            } \
            if (SB_EXIT_L2 > 0.f) { const bool done_ = __all(cacc < -SB_EXIT_L2); if (lane == 0) flags[((t) & 1) * 8 + wid] = done_ ? 1 : 0; } \
        } \
        asm volatile("s_waitcnt vmcnt(0)" ::: "memory"); \
        __syncthreads(); \
        if (MODE == 0 && SB_EXIT_L2 > 0.f) { int all_ = 1; _Pragma("unroll") for (int w_ = 0; w_ < 8; ++w_) all_ &= flags[((t) & 1) * 8 + w_]; stop = (all_ != 0); } \
    } while (0)
    for (int t = 0; t < NT; t += 2) {
        STEP(t, 0);
        if (stop) break;
        STEP(t + 1, 1);
        if (stop) break;
    }
#undef STEP
#undef DMA_TILE
#undef TILE_KB
    float rli[16];
    if constexpr (MODE == 1) {
        if (hi == 0) li_l[r32] = l_reg; asm volatile("s_waitcnt lgkmcnt(0)" ::: "memory");
#pragma unroll
        for (int r = 0; r < 16; ++r) rli[r] = __builtin_amdgcn_rcpf(li_l[crow(r, hi)]);
    } else {
#pragma unroll
        for (int r = 0; r < 16; ++r) rli[r] = 1.0f;
    }
    int r32o = r32; asm volatile("" : "+v"(r32o));
    bf16* Ow = O + (rowbase + qlo) * DM + (MODE == 0 ? 0 : 1024) + h * HD + r32o;
#pragma unroll
    for (int r = 0; r < 16; ++r) { const int orow = crow(r, hi);
#pragma unroll
        for (int d0 = 0; d0 < 4; ++d0) { const float v = o[d0][r] * rli[r]; const float vn = __shfl_xor(v, 1);
            if ((r32 & 1) == 0) *(unsigned*)(Ow + (size_t)orow * DM + d0 * 32) = cvt_pk_bf16(v, vn); } }
    __syncthreads();
}
#undef KSWZ
}
namespace epi {
using pg8::Unit;
typedef f32x4 Acc[2][2][4][2];
#define NEXT_ROW(roff, m, LD) do { roff += (size_t)((m) == 3 ? 80 : 16) * (LD); asm volatile("" : "+v"(roff) :: "memory"); } while (0)
#define ST_NT(ptr, val) (*(ptr) = (val))
#define EPI_BAR() do { asm volatile("s_waitcnt lgkmcnt(0)" ::: "memory"); __builtin_amdgcn_s_barrier(); asm volatile("" ::: "memory"); } while (0)

template <int NPARTS>
__device__ __forceinline__ void row_rstd_to_lds(LAS float* S, const float* parts, int pm, int tid, int& cpm) {
    if (cpm == pm) return;
    cpm = pm;
    if (tid < 256) { float v[NPARTS];
#pragma unroll
        for (int p = 0; p < NPARTS; ++p) v[p] = parts[(size_t)p * T + pm * 256 + tid];
        float s = v[0];
#pragma unroll
        for (int p = 1; p < NPARTS; ++p) s += v[p];
        S[tid] = 1.0f / sqrtf(s * (1.0f / DM) + EPS); }
    EPI_BAR();
}

struct EpiQKV {
    static constexpr bool PERM = true, ACC_INIT = false;
    bf16* out; const float* ssq0; const float* gains; const float* rope; float* kmean;
    __device__ __forceinline__ void operator()(Acc& acc, const Unit& u, int wr, int wc, int fr, int fq, LAS unsigned char* le, int wid, int lane, int& cpm) const {
        LAS float* S = (LAS float*)le; LAS float* P = (LAS float*)(le + 1024);
        const int tid = wid * 64 + lane, row0 = u.pm * 256;
        row_rstd_to_lds<1>(S, ssq0, u.pm, tid, cpm);
        const int type = u.pn >> 2;
        const bool is_v = (type == 2 || type == 5);
        float rs[2][4];
#pragma unroll
        for (int ai = 0; ai < 2; ++ai)
#pragma unroll
            for (int m = 0; m < 4; ++m) rs[ai][m] = S[ai * 128 + wr * 64 + m * 16 + fr];
#pragma unroll
        for (int ai = 0; ai < 2; ++ai)
#pragma unroll
            for (int bj = 0; bj < 2; ++bj)
#pragma unroll
                for (int m = 0; m < 4; ++m)
#pragma unroll
                    for (int n = 0; n < 2; ++n) acc[ai][bj][m][n] = acc[ai][bj][m][n] * rs[ai][m];
        if (!is_v) {
#pragma unroll
            for (int ai = 0; ai < 2; ++ai)
#pragma unroll
                for (int m = 0; m < 4; ++m)
#pragma unroll
                    for (int bj = 0; bj < 2; ++bj) {
                        const f32x4 a = acc[ai][bj][m][0], b = acc[ai][bj][m][1];
                        float s = (a[0] * a[0] + a[1] * a[1]) + (a[2] * a[2] + a[3] * a[3]) + (b[0] * b[0] + b[1] * b[1]) + (b[2] * b[2] + b[3] * b[3]);
                        s += __shfl_xor(s, 16); s += __shfl_xor(s, 32);
                        if (fq == 0) P[((ai * 128 + wr * 64 + m * 16 + fr) * 2 + bj) * 4 + wc] = s;
                    }
            EPI_BAR();
            const float* gn = gains + ((type == 0) ? 0 : (type == 1) ? 128 : (type == 3) ? 256 : 384) + wc * 32 + fq * 8;
            const f32x4 g0 = *(const f32x4*)gn, g1 = *(const f32x4*)(gn + 4);
#pragma unroll
            for (int ai = 0; ai < 2; ++ai)
#pragma unroll
                for (int m = 0; m < 4; ++m)
#pragma unroll
                    for (int bj = 0; bj < 2; ++bj) {
                        const f32x4 pp = *(const LAS f32x4*)(P + ((ai * 128 + wr * 64 + m * 16 + fr) * 2 + bj) * 4);
                        const float rn = 1.0f / sqrtf(((pp[0] + pp[1]) + (pp[2] + pp[3])) * (1.0f / HD) + EPS);
                        acc[ai][bj][m][0] = acc[ai][bj][m][0] * rn * g0; acc[ai][bj][m][1] = acc[ai][bj][m][1] * rn * g1;
                    }
            if (type >= 3 && wc == 0) {
#pragma unroll
                for (int ai = 0; ai < 2; ++ai)
#pragma unroll
                    for (int m = 0; m < 4; ++m) {
                        const int pos = (row0 + ai * 128 + wr * 64 + m * 16 + fr) & (SEQ - 1);
                        const float* cp = rope + (size_t)pos * 16 + (fq & 1) * 8;
                        const f32x4 c0 = *(const f32x4*)cp, c1 = *(const f32x4*)(cp + 4), s0 = *(const f32x4*)(cp + SEQ * 16), s1 = *(const f32x4*)(cp + SEQ * 16 + 4);
#pragma unroll
                        for (int bj = 0; bj < 2; ++bj) {
                            f32x4 a = acc[ai][bj][m][0], b = acc[ai][bj][m][1], oa, ob;
#pragma unroll
                            for (int j = 0; j < 4; ++j) { oa[j] = __shfl_xor(a[j], 32); ob[j] = __shfl_xor(b[j], 32); }
                            if (fq < 2) { a = a * c0 - oa * s0; b = b * c1 - ob * s1; } else { a = a * c0 + oa * s0; b = b * c1 + ob * s1; }
                            acc[ai][bj][m][0] = a; acc[ai][bj][m][1] = b;
                        }
                    }
            }
        }
        if (type == 4) {
            float cs[2][2][4];
#pragma unroll
            for (int bj = 0; bj < 2; ++bj)
#pragma unroll
                for (int n = 0; n < 2; ++n)
#pragma unroll
                    for (int j = 0; j < 4; ++j) { float s = 0.f;
#pragma unroll
                        for (int ai = 0; ai < 2; ++ai)
#pragma unroll
                            for (int m = 0; m < 4; ++m) s += acc[ai][bj][m][n][j];
                        s += __shfl_xor(s, 1); s += __shfl_xor(s, 2); s += __shfl_xor(s, 4); s += __shfl_xor(s, 8);
                        cs[bj][n][j] = s; }
            LAS float* KM = P;
            EPI_BAR();
            if (wr == 1 && fr == 0) {
#pragma unroll
                for (int bj = 0; bj < 2; ++bj)
#pragma unroll
                    for (int n = 0; n < 2; ++n) *(LAS f32x4*)(KM + ((wc * 4 + fq) * 16 + bj * 8 + n * 4)) = (f32x4){cs[bj][n][0], cs[bj][n][1], cs[bj][n][2], cs[bj][n][3]}; }
            EPI_BAR();
            if (wr == 0 && fr == 0) { const int b = u.pm >> 4, blk = u.pm & 15;
#pragma unroll
                for (int bj = 0; bj < 2; ++bj) { const int h = 2 * (u.pn - 16) + bj; float* kp = kmean + ((size_t)((b * 8 + h) * 16 + blk)) * HD + wc * 32 + fq * 8;
#pragma unroll
                    for (int n = 0; n < 2; ++n) { const f32x4 o = *(const LAS f32x4*)(KM + ((wc * 4 + fq) * 16 + bj * 8 + n * 4));
                        *(f32x4*)(kp + n * 4) = (f32x4){(cs[bj][n][0] + o[0]) * (1.0f / 256.0f), (cs[bj][n][1] + o[1]) * (1.0f / 256.0f), (cs[bj][n][2] + o[2]) * (1.0f / 256.0f), (cs[bj][n][3] + o[3]) * (1.0f / 256.0f)}; } } }
        }
        size_t roff = (size_t)(row0 + wr * 64 + fr) * NQKV + u.pn * 256 + wc * 32 + fq * 8;
#pragma unroll
        for (int ai = 0; ai < 2; ++ai)
#pragma unroll
            for (int m = 0; m < 4; ++m) { bf16* rowp = out + roff;
#pragma unroll
                for (int bj = 0; bj < 2; ++bj) { const f32x4 v0 = acc[ai][bj][m][0], v1 = acc[ai][bj][m][1];
                    u32x4 w; w.x = cvt_pk_bf16(v0[0], v0[1]); w.y = cvt_pk_bf16(v0[2], v0[3]); w.z = cvt_pk_bf16(v1[0], v1[1]); w.w = cvt_pk_bf16(v1[2], v1[3]);
                    ST_NT((u32x4*)(rowp + bj * 128), w); }
                NEXT_ROW(roff, m, NQKV); }
    }
};

template <bool NEXT, bool F8 = false> struct EpiResid {
    static constexpr bool PERM = false, ACC_INIT = true;
    const bf16* base; float* out; bf16* outb; float* ssq_part;
    __device__ __forceinline__ void init(Acc& acc, const Unit& u, int wr, int wc, int fr, int fq) const {
        const bf16* bp = base + (size_t)(u.pm * 256 + wr * 64 + fr) * DM + u.pn * 256 + wc * 32 + fq * 4;
#pragma unroll
        for (int ai = 0; ai < 2; ++ai)
#pragma unroll
            for (int m = 0; m < 4; ++m)
#pragma unroll
                for (int bj = 0; bj < 2; ++bj)
#pragma unroll
                    for (int n = 0; n < 2; ++n) { const u32x2 w = *(const u32x2*)(bp + (size_t)(ai * 128 + m * 16) * DM + bj * 128 + n * 16); acc[ai][bj][m][n] = (f32x4){bflo(w.x), bfhi(w.x), bflo(w.y), bfhi(w.y)}; if constexpr (F8) acc[ai][bj][m][n] = acc[ai][bj][m][n] * 4096.0f; }
    }
    __device__ __forceinline__ void operator()(Acc& acc, const Unit& u, int wr, int wc, int fr, int fq, LAS unsigned char* le, int wid, int lane, int& cpm) const {
        LAS float* P = (LAS float*)le;
        const int tid = wid * 64 + lane, row0 = u.pm * 256, col0 = u.pn * 256 + wc * 32 + fq * 4;
        size_t roff = (size_t)(row0 + wr * 64 + fr) * DM + col0;
#pragma unroll
        for (int ai = 0; ai < 2; ++ai)
#pragma unroll
            for (int m = 0; m < 4; ++m) { const int rt = ai * 128 + wr * 64 + m * 16 + fr; const size_t off = roff; float s = 0.f;
#pragma unroll
                for (int bj = 0; bj < 2; ++bj)
#pragma unroll
                    for (int n = 0; n < 2; ++n) { f32x4 v = acc[ai][bj][m][n]; if constexpr (F8) v = v * (1.0f / 4096.0f);
                        if constexpr (NEXT) { u32x2 w; w.x = cvt_pk_bf16(v[0], v[1]); w.y = cvt_pk_bf16(v[2], v[3]); *(u32x2*)(outb + off + bj * 128 + n * 16) = w;
                            const float r0 = bflo(w.x), r1 = bfhi(w.x), r2 = bflo(w.y), r3 = bfhi(w.y); s += (r0 * r0 + r1 * r1) + (r2 * r2 + r3 * r3); }
                        else { u32x2 w; w.x = cvt_pk_bf16(v[0], v[1]); w.y = cvt_pk_bf16(v[2], v[3]); *(u32x2*)(outb + off + bj * 128 + n * 16) = w; } }
                if constexpr (NEXT) { s += __shfl_xor(s, 16); s += __shfl_xor(s, 32); if (fq == 0) P[rt * 4 + wc] = s; }
                NEXT_ROW(roff, m, DM); }
        if constexpr (NEXT) { EPI_BAR();
        if (tid < 256) { const f32x4 pp = *(const LAS f32x4*)(P + tid * 4); ssq_part[(size_t)u.pn * T + row0 + tid] = (pp[0] + pp[1]) + (pp[2] + pp[3]); } }
    }
};

template <bool MOE> struct EpiSwiGLU {
    static constexpr bool PERM = true, ACC_INIT = false;
    bf16* out; const float* parts; int nparts; const float* slot_rstd;
    __device__ __forceinline__ void operator()(Acc& acc, const Unit& u, int wr, int wc, int fr, int fq, LAS unsigned char* le, int wid, int lane, int& cpm) const {
        LAS float* S = (LAS float*)le; const int tid = wid * 64 + lane, row0 = u.pm * 256;
        if constexpr (MOE) { if (cpm != u.pm) { cpm = u.pm; if (tid < 256) S[tid] = slot_rstd[row0 + tid]; EPI_BAR(); } }
        else row_rstd_to_lds<8>(S, parts, u.pm, tid, cpm);
        size_t roff = (size_t)(row0 + wr * 64 + fr) * DFF + u.pn * 128 + wc * 32 + fq * 8;
#pragma unroll
        for (int ai = 0; ai < 2; ++ai)
#pragma unroll
            for (int m = 0; m < 4; ++m) { const int rt = ai * 128 + wr * 64 + m * 16 + fr; const float rs = S[rt];
                const f32x4 ga = acc[ai][0][m][0] * rs, gb = acc[ai][0][m][1] * rs, ua = acc[ai][1][m][0] * rs, ub = acc[ai][1][m][1] * rs; f32x4 ha, hb;
#pragma unroll
                for (int j = 0; j < 4; ++j) { ha[j] = ga[j] * fast_sigmoid(ga[j]) * ua[j]; hb[j] = gb[j] * fast_sigmoid(gb[j]) * ub[j]; }
                u32x4 w; w.x = cvt_pk_bf16(ha[0], ha[1]); w.y = cvt_pk_bf16(ha[2], ha[3]); w.z = cvt_pk_bf16(hb[0], hb[1]); w.w = cvt_pk_bf16(hb[2], hb[3]);
                ST_NT((u32x4*)(out + roff), w);
                NEXT_ROW(roff, m, DFF); }
    }
};

__device__ __forceinline__ unsigned pk4_fp8(float a, float b, float c, float d) {
    a = __builtin_amdgcn_fmed3f(a, -448.f, 448.f); b = __builtin_amdgcn_fmed3f(b, -448.f, 448.f); c = __builtin_amdgcn_fmed3f(c, -448.f, 448.f); d = __builtin_amdgcn_fmed3f(d, -448.f, 448.f);
    unsigned w = 0u; w = __builtin_amdgcn_cvt_pk_fp8_f32(a, b, w, false); w = __builtin_amdgcn_cvt_pk_fp8_f32(c, d, w, true); return w;
}
constexpr float W_UP_SCALE = 256.f, W_DN_SCALE = 512.f, H_SCALE = 8.f, Y_SCALE = 16.f;
struct EpiSwiGLUFp8 {
    static constexpr bool PERM = true, ACC_INIT = false;
    unsigned char* out; const float* slot_rstd;
    __device__ __forceinline__ void operator()(Acc& acc, const Unit& u, int wr, int wc, int fr, int fq, LAS unsigned char* le, int wid, int lane, int& cpm) const {
        LAS float* S = (LAS float*)le; const int tid = wid * 64 + lane, row0 = u.pm * 256;
        if (cpm != u.pm) { cpm = u.pm; if (tid < 256) S[tid] = slot_rstd[row0 + tid] * (1.0f / W_UP_SCALE); EPI_BAR(); }
        size_t roff = (size_t)(row0 + wr * 64 + fr) * DFF + u.pn * 128 + wc * 32 + fq * 8;
#pragma unroll
        for (int ai = 0; ai < 2; ++ai)
#pragma unroll
            for (int m = 0; m < 4; ++m) { const int rt = ai * 128 + wr * 64 + m * 16 + fr; const float rs = S[rt];
                const float rl = rs * -1.4426950408889634f, kk = rs * rs * H_SCALE; f32x4 ha, hb;
#pragma unroll
                for (int j = 0; j < 4; ++j) { const float g0 = acc[ai][0][m][0][j], g1 = acc[ai][0][m][1][j];
                    ha[j] = (g0 * acc[ai][1][m][0][j]) * kk * __builtin_amdgcn_rcpf(1.0f + __builtin_amdgcn_exp2f(g0 * rl));
                    hb[j] = (g1 * acc[ai][1][m][1][j]) * kk * __builtin_amdgcn_rcpf(1.0f + __builtin_amdgcn_exp2f(g1 * rl)); }
                u32x2 w; w.x = pk4_fp8(ha[0], ha[1], ha[2], ha[3]); w.y = pk4_fp8(hb[0], hb[1], hb[2], hb[3]);
                ST_NT((u32x2*)(out + roff), w);
                NEXT_ROW(roff, m, DFF); }
    }
};

struct EpiRecIn {
    static constexpr bool PERM = true, ACC_INIT = false;
    bf16* xbr; bf16* gg; const float* parts;
    __device__ __forceinline__ void operator()(Acc& acc, const Unit& u, int wr, int wc, int fr, int fq, LAS unsigned char* le, int wid, int lane, int& cpm) const {
        LAS float* S = (LAS float*)le; const int tid = wid * 64 + lane, row0 = u.pm * 256;
        row_rstd_to_lds<8>(S, parts, u.pm, tid, cpm);
        const bool is_gate = u.pn >= 8; bf16* dst = is_gate ? gg : xbr; const int colt = (u.pn & 7) * 256 + wc * 32 + fq * 8;
        size_t roff = (size_t)(row0 + wr * 64 + fr) * DM + colt;
#pragma unroll
        for (int ai = 0; ai < 2; ++ai)
#pragma unroll
            for (int m = 0; m < 4; ++m) { const int rt = ai * 128 + wr * 64 + m * 16 + fr; const float rs = S[rt];
#pragma unroll
                for (int bj = 0; bj < 2; ++bj) { f32x4 v0 = acc[ai][bj][m][0] * rs, v1 = acc[ai][bj][m][1] * rs;
                    if (is_gate) {
#pragma unroll
                        for (int j = 0; j < 4; ++j) { { const float x = v0[j]; v0[j] = x * fast_sigmoid(1.5957691216057308f * (x + 0.044715f * x * x * x)); }
                                                      { const float x = v1[j]; v1[j] = x * fast_sigmoid(1.5957691216057308f * (x + 0.044715f * x * x * x)); } } }
                    u32x4 w; w.x = cvt_pk_bf16(v0[0], v0[1]); w.y = cvt_pk_bf16(v0[2], v0[3]); w.z = cvt_pk_bf16(v1[0], v1[1]); w.w = cvt_pk_bf16(v1[2], v1[3]);
                    ST_NT((u32x4*)(dst + roff + bj * 128), w); }
                NEXT_ROW(roff, m, DM); }
    }
};

#define DPP_SHR(x, ctrl) __builtin_bit_cast(float, __builtin_amdgcn_update_dpp(0, __builtin_bit_cast(int, (x)), (ctrl), 0xf, 0xf, true))
struct EpiGates {
    static constexpr bool PERM = false, ACC_INIT = false, APERM = true;
    const bf16* xc; const float* b_a; const float* b_i; const float* spl; unsigned* au; float* scanA; float* scanH;
    __device__ __forceinline__ void operator()(Acc& acc, const Unit& u, int wr, int wc, int fr, int fq, LAS unsigned char* le, int, int, int&) const {
        const int row0 = u.pm * 256, ch0 = (u.pn >> 1) * 256 + (u.pn & 1) * 128 + wc * 32 + fq * 4;
        size_t roff = (size_t)(row0 + wr * 64 + 4 * fr) * DM + ch0;
        LAS float* X = (LAS float*)le;
        u32x2 xpre[2][4][2];
#pragma unroll
        for (int ai = 0; ai < 2; ++ai)
#pragma unroll
            for (int m = 0; m < 4; ++m)
#pragma unroll
                for (int n = 0; n < 2; ++n) xpre[ai][m][n] = *(const u32x2*)(xc + roff + (size_t)(ai * 128 + m) * DM + n * 16);
        float RA[2][2][4], RH[2][2][4];
#pragma unroll
        for (int ai = 0; ai < 2; ++ai) {
#pragma unroll
            for (int m = 0; m < 4; ++m) {
#pragma unroll
                for (int n = 0; n < 2; ++n) { const size_t off = roff + n * 16;
                    const f32x4 ba = *(const f32x4*)(b_a + ch0 + n * 16), bi = *(const f32x4*)(b_i + ch0 + n * 16), sl = *(const f32x4*)(spl + ch0 + n * 16);
                    const u32x2 xw = xpre[ai][m][n]; const float xv[4] = {bflo(xw.x), bfhi(xw.x), bflo(xw.y), bfhi(xw.y)};
                    const f32x4 ra = acc[ai][0][m][n] + ba, ri = acc[ai][1][m][n] + bi; u32x4 pk;
#pragma unroll
                    for (int j = 0; j < 4; ++j) { const float r = fast_sigmoid(ra[j]), ig = fast_sigmoid(ri[j]);
                        const float la = bflo(cvt_pk_bf16(-8.0f * r * sl[j], 0.f));
                        const float a = fast_exp(la); const float x2 = 2.0f * la;
                        const float ser = -x2 * (1.0f + x2 * (0.5f + x2 * (1.0f / 6.0f + x2 * (1.0f / 24.0f + x2 * (1.0f / 120.0f)))));
                        const float om = (x2 > -0.3f) ? ser : (1.0f - a * a);
                        const unsigned w = cvt_pk_bf16(la, __builtin_amdgcn_sqrtf(om) * (ig * xv[j])); pk[j] = w;
                        const float uu = bfhi(w);
                        if (m == 0) { RA[ai][n][j] = a; RH[ai][n][j] = uu; } else { RH[ai][n][j] = a * RH[ai][n][j] + uu; RA[ai][n][j] = RA[ai][n][j] * a; } }
                    ST_NT((u32x4*)(au + off), pk); }
                roff += (size_t)(m == 3 ? 125 : 1) * DM; asm volatile("" : "+v"(roff) :: "memory"); }
#pragma unroll
            for (int n = 0; n < 2; ++n)
#pragma unroll
                for (int j = 0; j < 4; ++j) { float A = RA[ai][n][j], H = RH[ai][n][j];
                    { const float Ap = DPP_SHR(A, 0x111), Hp = DPP_SHR(H, 0x111); H = A * Hp + H; A = Ap * A; }
                    { const float Ap = DPP_SHR(A, 0x112), Hp = DPP_SHR(H, 0x112); H = A * Hp + H; A = Ap * A; }
                    { const float Ap = DPP_SHR(A, 0x114), Hp = DPP_SHR(H, 0x114); H = A * Hp + H; A = Ap * A; }
                    { const float Ap = DPP_SHR(A, 0x118), Hp = DPP_SHR(H, 0x118); H = A * Hp + H; A = Ap * A; }
                    RA[ai][n][j] = A; RH[ai][n][j] = H; }
            if (wr == 1 && fr == 15) {
#pragma unroll
                for (int n = 0; n < 2; ++n)
#pragma unroll
                    for (int j = 0; j < 4; ++j) { LAS float* xp = X + ((((ai * 4 + wc) * 4 + fq) * 2 + n) * 4 + j) * 2; xp[0] = RA[ai][n][j]; xp[1] = RH[ai][n][j]; } }
        }
        EPI_BAR();
        if (wr == 0 && fr == 15) { const int b = u.pm >> 4, c2 = (u.pm & 15) * 2;
#pragma unroll
            for (int ai = 0; ai < 2; ++ai)
#pragma unroll
                for (int n = 0; n < 2; ++n) { f32x4 oa, oh;
#pragma unroll
                    for (int j = 0; j < 4; ++j) { const LAS float* xp = X + ((((ai * 4 + wc) * 4 + fq) * 2 + n) * 4 + j) * 2; const float A2 = xp[0], H2 = xp[1];
                        oa[j] = RA[ai][n][j] * A2; oh[j] = A2 * RH[ai][n][j] + H2; }
                    const size_t o = (size_t)(b * 32 + c2 + ai) * DM + ch0 + n * 16; *(f32x4*)(scanA + o) = oa; *(f32x4*)(scanH + o) = oh; } }
    }
};
#define DPP_SHR_ID(x, idv, ctrl) __builtin_bit_cast(float, __builtin_amdgcn_update_dpp(__builtin_bit_cast(int, (float)(idv)), __builtin_bit_cast(int, (x)), (ctrl), 0xf, 0xf, false))
struct EpiGatesScan {
    static constexpr bool PERM = false, ACC_INIT = false, APERM = true;
    const bf16* xc; const float* b_a; const float* b_i; const float* spl; const bf16* gg; bf16* yb; float* agg; unsigned* flags;
    __device__ __forceinline__ void operator()(Acc& acc, const Unit& u, int wr, int wc, int fr_, int fq_, LAS unsigned char* le, int wid, int lane, int&) const {
        asm volatile("" : "+v"(lane));
        const int fr = lane & 15, fq = lane >> 4;
        const int row0 = u.pm * 256, chb = (u.pn >> 1) * 256 + (u.pn & 1) * 128, ch0 = chb + wc * 32 + fq * 4, tid = wid * 64 + lane;
        size_t roff = (size_t)(row0 + wr * 64 + 4 * fr) * DM + ch0;
        LAS float* X = (LAS float*)le;
        LAS float* C0 = X + 1024;
        u32x2 xpre[2][4][2];
#pragma unroll
        for (int ai = 0; ai < 2; ++ai)
#pragma unroll
            for (int m = 0; m < 4; ++m)
#pragma unroll
                for (int n = 0; n < 2; ++n) xpre[ai][m][n] = *(const u32x2*)(xc + roff + (size_t)(ai * 128 + m) * DM + n * 16);
        float EA[2][2][4], EH[2][2][4];
#pragma unroll
        for (int ai = 0; ai < 2; ++ai) {
#pragma unroll
            for (int m = 0; m < 4; ++m) {
#pragma unroll
                for (int n = 0; n < 2; ++n) {
                    const f32x4 ba = *(const f32x4*)(b_a + ch0 + n * 16), bi = *(const f32x4*)(b_i + ch0 + n * 16), sl = *(const f32x4*)(spl + ch0 + n * 16);
                    const u32x2 xw = xpre[ai][m][n]; const float xv[4] = {bflo(xw.x), bfhi(xw.x), bflo(xw.y), bfhi(xw.y)};
                    const f32x4 ra = acc[ai][0][m][n] + ba, ri = acc[ai][1][m][n] + bi;
#pragma unroll
                    for (int j = 0; j < 4; ++j) { const float r = fast_sigmoid(ra[j]), ig = fast_sigmoid(ri[j]);
                        const float la = -8.0f * r * sl[j];
                        const float a = fast_exp(la); const float x2 = 2.0f * la;
                        const float ser = -x2 * (1.0f + x2 * (0.5f + x2 * (1.0f / 6.0f + x2 * (1.0f / 24.0f + x2 * (1.0f / 120.0f)))));
                        const float om = (x2 > -0.3f) ? ser : (1.0f - a * a);
                        const float uu = __builtin_amdgcn_sqrtf(om) * (ig * xv[j]);
                        if (m == 0) { acc[ai][0][m][n][j] = a; acc[ai][1][m][n][j] = uu; }
                        else { acc[ai][1][m][n][j] = a * acc[ai][1][m - 1][n][j] + uu; acc[ai][0][m][n][j] = acc[ai][0][m - 1][n][j] * a; } } } }
#pragma unroll
            for (int n = 0; n < 2; ++n)
#pragma unroll
                for (int j = 0; j < 4; ++j) { float A = acc[ai][0][3][n][j], H = acc[ai][1][3][n][j];
                    { const float Ap = DPP_SHR_ID(A, 1.0f, 0x111), Hp = DPP_SHR_ID(H, 0.0f, 0x111); H = A * Hp + H; A = Ap * A; }
                    { const float Ap = DPP_SHR_ID(A, 1.0f, 0x112), Hp = DPP_SHR_ID(H, 0.0f, 0x112); H = A * Hp + H; A = Ap * A; }
                    { const float Ap = DPP_SHR_ID(A, 1.0f, 0x114), Hp = DPP_SHR_ID(H, 0.0f, 0x114); H = A * Hp + H; A = Ap * A; }
                    { const float Ap = DPP_SHR_ID(A, 1.0f, 0x118), Hp = DPP_SHR_ID(H, 0.0f, 0x118); H = A * Hp + H; A = Ap * A; }
                    EA[ai][n][j] = DPP_SHR_ID(A, 1.0f, 0x111); EH[ai][n][j] = DPP_SHR_ID(H, 0.0f, 0x111);
                    if (fr == 15) { LAS float* xp = X + (((ai * 2 + wr) * 128) + wc * 32 + n * 16 + fq * 4 + j) * 2; xp[0] = A; xp[1] = H; } }
        }
        u32x2 gpre[2][4][2];
#pragma unroll
        for (int m = 0; m < 4; ++m)
#pragma unroll
            for (int n = 0; n < 2; ++n) gpre[0][m][n] = *(const u32x2*)(gg + roff + (size_t)m * DM + n * 16);
        EPI_BAR();
        if (tid < 128) { float TA = 1.f, TH = 0.f;
#pragma unroll
            for (int blk = 0; blk < 4; ++blk) { const f32x2 ah = *(const LAS f32x2*)(X + (blk * 128 + tid) * 2); TH = ah.x * TH + ah.y; TA = TA * ah.x; }
            __hip_atomic_store((unsigned long long*)(agg + ((size_t)u.pm * DM + chb + tid) * 2), __builtin_bit_cast(unsigned long long, (f32x2){TA, TH}), __ATOMIC_RELAXED, __HIP_MEMORY_SCOPE_AGENT);
            asm volatile("s_waitcnt vmcnt(0)" ::: "memory"); }
        EPI_BAR();
        if (tid == 0) __hip_atomic_store(flags + u.pm * 16 + u.pn, 1u, __ATOMIC_RELAXED, __HIP_MEMORY_SCOPE_AGENT);
        if (tid < 128) { const int pm0 = u.pm & ~15, np = u.pm & 15; float h0 = 0.f;
            { const int q = lane & 15; unsigned sp = 0;
                for (;;) { const unsigned f = (q < np) ? __hip_atomic_load(flags + (pm0 + q) * 16 + u.pn, __ATOMIC_RELAXED, __HIP_MEMORY_SCOPE_AGENT) : 1u;
                    if (__builtin_amdgcn_ballot_w64(f == 0u) == 0ull) break;
                    __builtin_amdgcn_s_sleep(1); if (++sp > (1u << 14)) break; } }
            asm volatile("" ::: "memory");
            f32x2 ahs[15];
#pragma unroll
            for (int q = 0; q < 15; ++q) { const int qq = q < np ? q : 0;
                ahs[q] = __builtin_bit_cast(f32x2, __hip_atomic_load((unsigned long long*)(agg + ((size_t)(pm0 + qq) * DM + chb + tid) * 2), __ATOMIC_RELAXED, __HIP_MEMORY_SCOPE_AGENT)); }
#pragma unroll
            for (int q = 0; q < 15; ++q) if (q < np) h0 = ahs[q].x * h0 + ahs[q].y;
            C0[tid] = h0; }
        EPI_BAR();
#pragma unroll
        for (int ai = 0; ai < 2; ++ai) { float cl[2][4];
            if (ai == 0) {
#pragma unroll
                for (int m = 0; m < 4; ++m)
#pragma unroll
                    for (int n = 0; n < 2; ++n) gpre[1][m][n] = *(const u32x2*)(gg + roff + (size_t)(128 + m) * DM + n * 16); }
#pragma unroll
            for (int n = 0; n < 2; ++n)
#pragma unroll
                for (int j = 0; j < 4; ++j) { const int c = wc * 32 + n * 16 + fq * 4 + j; float s = C0[c];
                    if (ai == 1) { const f32x2 b0 = *(const LAS f32x2*)(X + (0 * 128 + c) * 2), b1 = *(const LAS f32x2*)(X + (1 * 128 + c) * 2); s = b0.x * s + b0.y; s = b1.x * s + b1.y; }
                    if (wr == 1) { const f32x2 b2 = *(const LAS f32x2*)(X + ((ai * 2) * 128 + c) * 2); s = b2.x * s + b2.y; }
                    cl[n][j] = EA[ai][n][j] * s + EH[ai][n][j]; }
#pragma unroll
            for (int m = 0; m < 4; ++m) {
#pragma unroll
                for (int n = 0; n < 2; ++n) { const u32x2 gw = gpre[ai][m][n]; const float gv[4] = {bflo(gw.x), bfhi(gw.x), bflo(gw.y), bfhi(gw.y)}; float y[4];
#pragma unroll
                    for (int j = 0; j < 4; ++j) y[j] = (acc[ai][0][m][n][j] * cl[n][j] + acc[ai][1][m][n][j]) * gv[j];
                    u32x2 w; w.x = cvt_pk_bf16(y[0], y[1]); w.y = cvt_pk_bf16(y[2], y[3]);
                    *(u32x2*)(yb + roff + n * 16) = w; }
                roff += (size_t)(m == 3 ? 125 : 1) * DM; asm volatile("" : "+v"(roff) :: "memory"); } }
    }
};

struct EpiSwiGLUDenseF8 {
    static constexpr bool PERM = true, ACC_INIT = false;
    unsigned char* out; const float* parts;
    __device__ __forceinline__ void operator()(Acc& acc, const Unit& u, int wr, int wc, int fr, int fq, LAS unsigned char* le, int wid, int lane, int& cpm) const {
        LAS float* S = (LAS float*)le; const int tid = wid * 64 + lane, row0 = u.pm * 256;
        row_rstd_to_lds<8>(S, parts, u.pm, tid, cpm);
        size_t roff = (size_t)(row0 + wr * 64 + fr) * DFF + u.pn * 128 + wc * 32 + fq * 8;
#pragma unroll
        for (int ai = 0; ai < 2; ++ai)
#pragma unroll
            for (int m = 0; m < 4; ++m) { const int rt = ai * 128 + wr * 64 + m * 16 + fr; const float rs = S[rt];
                const float rl = rs * -1.4426950408889634f, kk = rs * rs * H_SCALE; f32x4 ha, hb;
#pragma unroll
                for (int j = 0; j < 4; ++j) { const float g0 = acc[ai][0][m][0][j], g1 = acc[ai][0][m][1][j];
                    ha[j] = (g0 * acc[ai][1][m][0][j]) * kk * __builtin_amdgcn_rcpf(1.0f + __builtin_amdgcn_exp2f(g0 * rl));
                    hb[j] = (g1 * acc[ai][1][m][1][j]) * kk * __builtin_amdgcn_rcpf(1.0f + __builtin_amdgcn_exp2f(g1 * rl)); }
                u32x2 w; w.x = pk4_fp8(ha[0], ha[1], ha[2], ha[3]); w.y = pk4_fp8(hb[0], hb[1], hb[2], hb[3]);
                ST_NT((u32x2*)(out + roff), w);
                NEXT_ROW(roff, m, DFF); }
    }
};
struct EpiRecInConv {
    static constexpr bool PERM = true, ACC_INIT = false, APERM = true;
    bf16* xc; bf16* gg; const float* parts; const float* cw; const float* cb; unsigned* halo; unsigned* flags;
    __device__ __forceinline__ void operator()(Acc& acc, const Unit& u, int wr, int wc, int fr_, int fq_, LAS unsigned char* le, int wid, int lane, int& cpm) const {
        asm volatile("" : "+v"(lane));
        const int fr = lane & 15, fq = lane >> 4;
        LAS float* S = (LAS float*)le; LAS unsigned short* LB = (LAS unsigned short*)(le + 1024);
        const int tid = wid * 64 + lane, row0 = u.pm * 256;
        row_rstd_to_lds<8>(S, parts, u.pm, tid, cpm);
        const bool is_gate = u.pn >= 8; const int tc = wc * 32 + fq * 8, colt = (u.pn & 7) * 256 + tc;
        const size_t roff = (size_t)(row0 + wr * 64 + 4 * fr) * DM + colt;
#pragma unroll
        for (int ai = 0; ai < 2; ++ai)
#pragma unroll
            for (int m = 0; m < 4; ++m) { const float rs = S[ai * 128 + wr * 64 + 4 * fr + m];
#pragma unroll
                for (int bj = 0; bj < 2; ++bj) { acc[ai][bj][m][0] = acc[ai][bj][m][0] * rs; acc[ai][bj][m][1] = acc[ai][bj][m][1] * rs; } }
        if (is_gate) {
#pragma unroll
            for (int ai = 0; ai < 2; ++ai)
#pragma unroll
                for (int m = 0; m < 4; ++m)
#pragma unroll
                    for (int bj = 0; bj < 2; ++bj) { f32x4 v0 = acc[ai][bj][m][0], v1 = acc[ai][bj][m][1];
#pragma unroll
                        for (int j = 0; j < 4; ++j) { { const float x = v0[j]; v0[j] = x * fast_sigmoid(1.5957691216057308f * (x + 0.044715f * x * x * x)); }
                                                      { const float x = v1[j]; v1[j] = x * fast_sigmoid(1.5957691216057308f * (x + 0.044715f * x * x * x)); } }
                        u32x4 w; w.x = cvt_pk_bf16(v0[0], v0[1]); w.y = cvt_pk_bf16(v0[2], v0[3]); w.z = cvt_pk_bf16(v1[0], v1[1]); w.w = cvt_pk_bf16(v1[2], v1[3]);
                        *(u32x4*)(gg + roff + (size_t)(ai * 128 + m) * DM + bj * 128) = w; }
            return; }
        if (fr == 15) {
#pragma unroll
            for (int ai = 0; ai < 2; ++ai) { const int blk = ai * 2 + wr;
#pragma unroll
                for (int m = 1; m < 4; ++m)
#pragma unroll
                    for (int bj = 0; bj < 2; ++bj) { const f32x4 v0 = acc[ai][bj][m][0], v1 = acc[ai][bj][m][1];
                        u32x4 w; w.x = cvt_pk_bf16(v0[0], v0[1]); w.y = cvt_pk_bf16(v0[2], v0[3]); w.z = cvt_pk_bf16(v1[0], v1[1]); w.w = cvt_pk_bf16(v1[2], v1[3]);
                        if (blk < 3) *(LAS u32x4*)(LB + ((blk + 1) * 3 + (m - 1)) * 256 + bj * 128 + tc) = w;
                        else { unsigned* hp = halo + ((size_t)((u.pm * 8 + u.pn) * 3 + (m - 1))) * 128 + (bj * 128 + tc) / 2;
                            __hip_atomic_store((unsigned long long*)hp, (unsigned long long)w.x | ((unsigned long long)w.y << 32), __ATOMIC_RELAXED, __HIP_MEMORY_SCOPE_AGENT);
                            __hip_atomic_store((unsigned long long*)(hp + 2), (unsigned long long)w.z | ((unsigned long long)w.w << 32), __ATOMIC_RELAXED, __HIP_MEMORY_SCOPE_AGENT); } } } }
        asm volatile("s_waitcnt vmcnt(0)" ::: "memory");
        EPI_BAR();
        if (tid == 0) __hip_atomic_store(flags + u.pm * 8 + u.pn, 1u, __ATOMIC_RELAXED, __HIP_MEMORY_SCOPE_AGENT);
        if (tid < 192) { unsigned long long v = 0ull;
            if ((u.pm & 15) != 0) { unsigned sp = 0;
                while (__hip_atomic_load(flags + (u.pm - 1) * 8 + u.pn, __ATOMIC_RELAXED, __HIP_MEMORY_SCOPE_AGENT) == 0u) { __builtin_amdgcn_s_sleep(1); if (++sp > (1u << 14)) break; }
                asm volatile("" ::: "memory");
                v = __hip_atomic_load((unsigned long long*)(halo + (size_t)((u.pm - 1) * 8 + u.pn) * 3 * 128 + tid * 2), __ATOMIC_RELAXED, __HIP_MEMORY_SCOPE_AGENT); }
            *(LAS unsigned long long*)(LB + tid * 4) = v; }
        EPI_BAR();
#pragma unroll
        for (int ai = 0; ai < 2; ++ai) { const int blkp = ai * 2 + wr;
#pragma unroll
            for (int bj = 0; bj < 2; ++bj) { const int gc = colt + bj * 128;
                float P1[8], P2[8], P3[8], X0[8], X1[8], X2[8], X3[8];
#pragma unroll
                for (int n = 0; n < 2; ++n)
#pragma unroll
                    for (int j = 0; j < 4; ++j) { const float a0 = acc[ai][bj][0][n][j], a1 = acc[ai][bj][1][n][j], a2 = acc[ai][bj][2][n][j], a3 = acc[ai][bj][3][n][j];
                        X0[4 * n + j] = a0; X1[4 * n + j] = a1; X2[4 * n + j] = a2; X3[4 * n + j] = a3;
                        P1[4 * n + j] = DPP_SHR_ID(a1, 0.0f, 0x111); P2[4 * n + j] = DPP_SHR_ID(a2, 0.0f, 0x111); P3[4 * n + j] = DPP_SHR_ID(a3, 0.0f, 0x111); }
                if (fr == 0) {
                    const u32x4 q1 = *(const LAS u32x4*)(LB + (blkp * 3 + 0) * 256 + bj * 128 + tc), q2 = *(const LAS u32x4*)(LB + (blkp * 3 + 1) * 256 + bj * 128 + tc), q3 = *(const LAS u32x4*)(LB + (blkp * 3 + 2) * 256 + bj * 128 + tc);
                    P1[0] = bflo(q1.x); P1[1] = bfhi(q1.x); P1[2] = bflo(q1.y); P1[3] = bfhi(q1.y); P1[4] = bflo(q1.z); P1[5] = bfhi(q1.z); P1[6] = bflo(q1.w); P1[7] = bfhi(q1.w);
                    P2[0] = bflo(q2.x); P2[1] = bfhi(q2.x); P2[2] = bflo(q2.y); P2[3] = bfhi(q2.y); P2[4] = bflo(q2.z); P2[5] = bfhi(q2.z); P2[6] = bflo(q2.w); P2[7] = bfhi(q2.w);
                    P3[0] = bflo(q3.x); P3[1] = bfhi(q3.x); P3[2] = bflo(q3.y); P3[3] = bfhi(q3.y); P3[4] = bflo(q3.z); P3[5] = bfhi(q3.z); P3[6] = bflo(q3.w); P3[7] = bfhi(q3.w); }
                float Y0[8], Y1[8], Y2[8], Y3[8];
#pragma unroll
                for (int n = 0; n < 2; ++n) { const f32x4 w0 = *(const f32x4*)(cw + gc + 4 * n), w1 = *(const f32x4*)(cw + DM + gc + 4 * n), w2 = *(const f32x4*)(cw + 2 * DM + gc + 4 * n), w3 = *(const f32x4*)(cw + 3 * DM + gc + 4 * n), bb = *(const f32x4*)(cb + gc + 4 * n);
#pragma unroll
                    for (int j = 0; j < 4; ++j) { const int k = 4 * n + j;
                        Y0[k] = bb[j] + w0[j] * P1[k] + w1[j] * P2[k] + w2[j] * P3[k] + w3[j] * X0[k];
                        Y1[k] = bb[j] + w0[j] * P2[k] + w1[j] * P3[k] + w2[j] * X0[k] + w3[j] * X1[k];
                        Y2[k] = bb[j] + w0[j] * P3[k] + w1[j] * X0[k] + w2[j] * X1[k] + w3[j] * X2[k];
                        Y3[k] = bb[j] + w0[j] * X0[k] + w1[j] * X1[k] + w2[j] * X2[k] + w3[j] * X3[k]; } }
                { u32x4 w; w.x = cvt_pk_bf16(Y0[0], Y0[1]); w.y = cvt_pk_bf16(Y0[2], Y0[3]); w.z = cvt_pk_bf16(Y0[4], Y0[5]); w.w = cvt_pk_bf16(Y0[6], Y0[7]); *(u32x4*)(xc + roff + (size_t)(ai * 128 + 0) * DM + bj * 128) = w; }
                { u32x4 w; w.x = cvt_pk_bf16(Y1[0], Y1[1]); w.y = cvt_pk_bf16(Y1[2], Y1[3]); w.z = cvt_pk_bf16(Y1[4], Y1[5]); w.w = cvt_pk_bf16(Y1[6], Y1[7]); *(u32x4*)(xc + roff + (size_t)(ai * 128 + 1) * DM + bj * 128) = w; }
                { u32x4 w; w.x = cvt_pk_bf16(Y2[0], Y2[1]); w.y = cvt_pk_bf16(Y2[2], Y2[3]); w.z = cvt_pk_bf16(Y2[4], Y2[5]); w.w = cvt_pk_bf16(Y2[6], Y2[7]); *(u32x4*)(xc + roff + (size_t)(ai * 128 + 2) * DM + bj * 128) = w; }
                { u32x4 w; w.x = cvt_pk_bf16(Y3[0], Y3[1]); w.y = cvt_pk_bf16(Y3[2], Y3[3]); w.z = cvt_pk_bf16(Y3[4], Y3[5]); w.w = cvt_pk_bf16(Y3[6], Y3[7]); *(u32x4*)(xc + roff + (size_t)(ai * 128 + 3) * DM + bj * 128) = w; } } }
    }
};
struct EpiMoeDown {
    static constexpr bool PERM = true, ACC_INIT = false;
    unsigned char* y; float oscale;
    __device__ __forceinline__ void operator()(Acc& acc, const Unit& u, int wr, int wc, int fr, int fq, LAS unsigned char*, int, int, int&) const {
        size_t roff = (size_t)(u.pm * 256 + wr * 64 + fr) * DM + u.pn * 256 + wc * 32 + fq * 8;
#pragma unroll
        for (int ai = 0; ai < 2; ++ai)
#pragma unroll
            for (int m = 0; m < 4; ++m) {
#pragma unroll
                for (int bj = 0; bj < 2; ++bj) { const f32x4 v0 = acc[ai][bj][m][0] * oscale, v1 = acc[ai][bj][m][1] * oscale;
                    u32x2 w; w.x = pk4_fp8(v0[0], v0[1], v0[2], v0[3]); w.y = pk4_fp8(v1[0], v1[1], v1[2], v1[3]);
                    *(u32x2*)(y + roff + bj * 128) = w; }
                NEXT_ROW(roff, m, DM); }
    }
};
struct EpiMoeDownTail {
    static constexpr bool PERM = true, ACC_INIT = false;
    unsigned char* y; float oscale; float* part; unsigned* flg;
    __device__ __forceinline__ void operator()(Acc& acc, const Unit& u, int wr, int wc, int fr, int fq, LAS unsigned char*, int wid, int lane, int&) const {
        const int tid = wid * 64 + lane;
        if (u.ks < 3) { float* p = part + (size_t)(u.ti * 3 + u.ks) * (32 * 512 * 4) + tid * 4;
#pragma unroll
            for (int ai = 0; ai < 2; ++ai)
#pragma unroll
                for (int bj = 0; bj < 2; ++bj)
#pragma unroll
                    for (int m = 0; m < 4; ++m)
#pragma unroll
                        for (int n = 0; n < 2; ++n) *(f32x4*)(p + (size_t)(((ai * 2 + bj) * 4 + m) * 2 + n) * (512 * 4)) = acc[ai][bj][m][n];
            asm volatile("s_waitcnt vmcnt(0)" ::: "memory");
            EPI_BAR();
            if (tid == 0) __hip_atomic_fetch_add(flg + u.ti, 1u, __ATOMIC_RELAXED, __HIP_MEMORY_SCOPE_AGENT);
            return; }
        if (tid == 0) { unsigned sp = 0; while (__hip_atomic_load(flg + u.ti, __ATOMIC_RELAXED, __HIP_MEMORY_SCOPE_AGENT) < 3u) { __builtin_amdgcn_s_sleep(1); if (++sp > (1u << 14)) break; } }
        EPI_BAR();
        __builtin_amdgcn_fence(__ATOMIC_ACQUIRE, "agent");
#pragma unroll
        for (int q = 0; q < 3; ++q) { const float* p = part + (size_t)(u.ti * 3 + q) * (32 * 512 * 4) + tid * 4;
#pragma unroll
            for (int ai = 0; ai < 2; ++ai)
#pragma unroll
                for (int bj = 0; bj < 2; ++bj)
#pragma unroll
                    for (int m = 0; m < 4; ++m)
#pragma unroll
                        for (int n = 0; n < 2; ++n) acc[ai][bj][m][n] += *(const f32x4*)(p + (size_t)(((ai * 2 + bj) * 4 + m) * 2 + n) * (512 * 4)); }
        size_t roff = (size_t)(u.pm * 256 + wr * 64 + fr) * DM + u.pn * 256 + wc * 32 + fq * 8;
#pragma unroll
        for (int ai = 0; ai < 2; ++ai)
#pragma unroll
            for (int m = 0; m < 4; ++m) {
#pragma unroll
                for (int bj = 0; bj < 2; ++bj) { const f32x4 v0 = acc[ai][bj][m][0] * oscale, v1 = acc[ai][bj][m][1] * oscale;
                    u32x2 w; w.x = pk4_fp8(v0[0], v0[1], v0[2], v0[3]); w.y = pk4_fp8(v1[0], v1[1], v1[2], v1[3]);
                    *(u32x2*)(y + roff + bj * 128) = w; }
                NEXT_ROW(roff, m, DM); }
    }
};
}
constexpr size_t MiB = 1u << 20;
constexpr size_t WS_CTL = 0, CTL_ZERO_BYTES = 1 * MiB;
constexpr size_t WS_SSQ0 = 1 * MiB;
constexpr size_t WS_SSQ1 = WS_SSQ0 + 64 * 1024;
constexpr size_t WS_SSQ2 = WS_SSQ1 + 512 * 1024;
constexpr size_t WS_SSQ3 = WS_SSQ2 + 512 * 1024;
constexpr size_t WS_KMEAN = WS_SSQ3 + 512 * 1024;
constexpr size_t WS_ROPE = WS_KMEAN + 256 * 1024;
constexpr size_t WS_SPL = WS_ROPE + 512 * 1024;
constexpr size_t WS_RSTD3 = WS_SPL + 8 * 1024;
constexpr size_t WS_TOKE = WS_RSTD3 + 64 * 1024;
constexpr size_t WS_TOKW = WS_TOKE + 64 * 1024;
constexpr size_t WS_CNTC = WS_TOKW + 128 * 1024;
constexpr size_t WS_SLOTT = WS_CNTC + 8 * 1024;
constexpr size_t WS_SLOTW = WS_SLOTT + 144 * 1024;
constexpr size_t WS_TPREF = WS_SLOTW + 144 * 1024;
constexpr size_t WS_GAINS = WS_TPREF + 1024;
constexpr size_t WS_TOKS = WS_GAINS + 4096;
constexpr size_t WS_SLOTR = WS_TOKS + 128 * 1024;
constexpr size_t WS_SCANA = 8 * MiB, WS_SCANH = 9 * MiB, WS_SCANC = 10 * MiB;
static_assert(WS_SLOTR + 144 * 1024 <= WS_SCANA, "small arrays");
constexpr size_t WS_WQKV = 32 * MiB, WS_WO = 56 * MiB, WS_WGU = 64 * MiB, WS_WDN = 120 * MiB, WS_WIN = 148 * MiB, WS_WAI = 164 * MiB, WS_WO2 = 166 * MiB;
constexpr size_t WS_EGU = 176 * MiB, WS_EDN = 624 * MiB;
constexpr size_t WS_XB = 848 * MiB;
constexpr size_t WS_XR = 912 * MiB;
constexpr size_t WS_ARENA = 1040 * MiB;
constexpr size_t WS_QKV = WS_ARENA, WS_O = WS_ARENA + 192 * MiB;
constexpr size_t WS_H = WS_ARENA;
constexpr size_t WS_XBR = WS_ARENA, WS_GG = WS_ARENA + 64 * MiB, WS_XC = WS_ARENA + 128 * MiB, WS_AA = WS_ARENA + 192 * MiB, WS_UU = WS_ARENA + 320 * MiB, WS_Y = WS_ARENA + 448 * MiB;
constexpr size_t WS_PART = WS_ARENA + 256 * MiB;
constexpr size_t WS_HE = WS_ARENA;
constexpr size_t WS_XG = WS_ARENA + 512 * MiB;
constexpr size_t WS_END = WS_XG + 136 * MiB;
static_assert((size_t)NSLOT_PAD * DFF * 2 <= 512 * MiB && (size_t)T * DFF * 2 <= 512 * MiB && (size_t)NSLOT_PAD * DM * 2 <= 136 * MiB, "arena");
constexpr int CW_TMO = 0, CW_BAR = 4096, CW_XRANK = 8192, CW_SCANF = 12288, CW_TAILF = 13312, CW_CONVF = 13440;

constexpr int RING_OFF = 0, RING_BYTES = 131072, EPI_OFF = 131072, EPI_BYTES = 12288, MISC_OFF = EPI_OFF + EPI_BYTES, LDS_BYTES = 147456;
static_assert(MISC_OFF + 128 <= LDS_BYTES && att::LDS_BYTES <= RING_BYTES, "LDS map");

#define XB_TMO      128
#define XB_XCNT(j)  (256  + 64 * (j))
#define XB_XSUB(j)  (1280 + 64 * (j))
#define XB_XGEN(j)  (2304 + 64 * (j))
#define XB_TOP      3328
#define XB_TOPGEN   3392
#define XCD_BAR_WORDS 3456
#define XB_SPIN_CAP (1u << 18)
__device__ __forceinline__ unsigned xb_ld(unsigned* p)              { return __hip_atomic_load(p, __ATOMIC_RELAXED, __HIP_MEMORY_SCOPE_AGENT); }
__device__ __forceinline__ unsigned xb_add(unsigned* p, unsigned v) { return __hip_atomic_fetch_add(p, v, __ATOMIC_RELAXED, __HIP_MEMORY_SCOPE_AGENT); }
__device__ __forceinline__ unsigned xb_xcc_id() { return (unsigned)__builtin_amdgcn_s_getreg((3 << 11) | 20) & 0xFu; }
#define XB_SPIN(cond, bar) do { unsigned _sp = 0; while (cond) { __builtin_amdgcn_s_sleep(1); \
    if ((++_sp & 255u) == 0u) { if (xb_ld(&(bar)[XB_TMO])) break; if (_sp > XB_SPIN_CAP) { atomicAdd(&(bar)[XB_TMO], 1u); break; } } } } while (0)
struct XcdBarrier { unsigned* bar; unsigned x; volatile LAS unsigned* st; int wave; };
__device__ __forceinline__ bool xb_leader(int wave) { return wave == 0 && __builtin_amdgcn_mbcnt_hi(~0u, __builtin_amdgcn_mbcnt_lo(~0u, 0u)) == 0u; }
__device__ __forceinline__ XcdBarrier xcd_barrier_post(unsigned* bar, volatile LAS unsigned* st, int wave) {
    XcdBarrier b; b.bar = bar; b.x = xb_xcc_id(); b.st = st; b.wave = wave;
    if (xb_leader(wave)) (void)xb_add(&bar[XB_XCNT(b.x)], 1u);
    return b;
}
__device__ __forceinline__ void xcd_barrier_complete(unsigned* bar, unsigned x, unsigned& nloc, unsigned& nx) {
    const unsigned G = gridDim.x * gridDim.y * gridDim.z;
    unsigned sum, cnt, mine, sp = 0u;
    for (;;) {
        sum = 0u; cnt = 0u; mine = 0u;
#pragma unroll
        for (unsigned j = 0; j < 16; ++j) { const unsigned c = xb_ld(&bar[XB_XCNT(j)]); sum += c; cnt += (c > 0u) ? 1u : 0u; mine = (j == x) ? c : mine; }
        if (sum == G) break;
        __builtin_amdgcn_s_sleep(1);
        if ((++sp & 255u) == 0u) { if (xb_ld(&bar[XB_TMO])) break; if (sp > XB_SPIN_CAP) { atomicAdd(&bar[XB_TMO], 1u); break; } }
    }
    nloc = mine > 0u ? mine : 1u; nx = cnt > 0u ? cnt : 1u;
}
__device__ __forceinline__ void xcd_barrier(const XcdBarrier& b) {
    asm volatile("s_waitcnt vmcnt(0)" ::: "memory");
    __syncthreads();
    if (xb_leader(b.wave)) {
        unsigned* bar = b.bar;
        __builtin_amdgcn_s_waitcnt(0);
        unsigned nloc = b.st[0], nx = b.st[1];
        if (nloc == 0u) { xcd_barrier_complete(bar, b.x, nloc, nx); b.st[0] = nloc; b.st[1] = nx; }
        const unsigned old = xb_add(&bar[XB_XSUB(b.x)], 1u);
        const unsigned gen = old / nloc;
        if (old + 1u == (gen + 1u) * nloc) {
            __builtin_amdgcn_fence(__ATOMIC_RELEASE, "agent");
            asm volatile("s_waitcnt vmcnt(0)" ::: "memory");
            const unsigned og = xb_add(&bar[XB_TOP], 1u);
            const unsigned tg = og / nx;
            if (og + 1u == (tg + 1u) * nx) xb_add(&bar[XB_TOPGEN], 1u);
            else XB_SPIN(xb_ld(&bar[XB_TOPGEN]) == tg, bar);
            __builtin_amdgcn_fence(__ATOMIC_ACQUIRE, "agent");
            xb_add(&bar[XB_XGEN(b.x)], 1u);
            asm volatile("s_waitcnt vmcnt(0)" ::: "memory");
        } else {
            XB_SPIN(xb_ld(&bar[XB_XGEN(b.x)]) == gen, bar);
            __builtin_amdgcn_fence(__ATOMIC_ACQUIRE, "agent");
            asm volatile("s_waitcnt vmcnt(0)" ::: "memory");
        }
    }
    __syncthreads();
}

#define LDS_WAIT() asm volatile("s_waitcnt lgkmcnt(0)" ::: "memory")
__device__ __forceinline__ void transpose_item(const float* W, int ldw, int k0, int n0, const float* gain, bf16* WT, int ldwt, int drow0, LAS float* scr, int lane) {
    const int n4 = lane & 7, kr = lane >> 3;
#pragma unroll
    for (int i = 0; i < 8; ++i) { const int kk = 8 * i + kr; f32x4 v = *(const f32x4*)(W + (size_t)(k0 + kk) * ldw + n0 + 4 * n4);
        if (gain) v = v * gain[k0 + kk];
        LAS float* d = scr + kk * 33 + 4 * n4; d[0] = v[0]; d[1] = v[1]; d[2] = v[2]; d[3] = v[3]; }
    LDS_WAIT(); asm volatile("" ::: "memory");
    const int c = lane & 7;
#pragma unroll
    for (int j = 0; j < 4; ++j) { const int n = (lane >> 3) + 8 * j; const LAS float* s = scr + (8 * c) * 33 + n;
        u32x4 o; o.x = pk2(s[0 * 33], s[1 * 33]); o.y = pk2(s[2 * 33], s[3 * 33]); o.z = pk2(s[4 * 33], s[5 * 33]); o.w = pk2(s[6 * 33], s[7 * 33]);
        *(u32x4*)(WT + (size_t)(drow0 + n) * ldwt + k0 + 8 * c) = o; }
    LDS_WAIT(); asm volatile("" ::: "memory");
}
__device__ __forceinline__ void transpose_item_fp8(const float* W, int ldw, int k0, int n0, const float* gain, float scale, unsigned char* WT, int ldwt, int drow0, LAS float* scr, int lane) {
    const int n4 = lane & 7, kr = lane >> 3;
#pragma unroll
    for (int i = 0; i < 8; ++i) { const int kk = 8 * i + kr; f32x4 v = *(const f32x4*)(W + (size_t)(k0 + kk) * ldw + n0 + 4 * n4);
        v = v * (gain ? gain[k0 + kk] * scale : scale);
        LAS float* d = scr + kk * 33 + 4 * n4; d[0] = v[0]; d[1] = v[1]; d[2] = v[2]; d[3] = v[3]; }
    LDS_WAIT(); asm volatile("" ::: "memory");
    const int c = lane & 7;
#pragma unroll
    for (int j = 0; j < 4; ++j) { const int n = (lane >> 3) + 8 * j; const LAS float* s = scr + (8 * c) * 33 + n;
        u32x2 o; o.x = epi::pk4_fp8(s[0 * 33], s[1 * 33], s[2 * 33], s[3 * 33]); o.y = epi::pk4_fp8(s[4 * 33], s[5 * 33], s[6 * 33], s[7 * 33]);
        *(u32x2*)(WT + (size_t)(drow0 + n) * ldwt + k0 + 8 * c) = o; }
    LDS_WAIT(); asm volatile("" ::: "memory");
}
__device__ __forceinline__ bool transpose_group_fp8(int& it, const float* W, size_t wstride, int nmat, int K, int N, const float* gain, float scale, unsigned char* WT, size_t tstride, int mode, LAS float* scr, int lane) {
    const int nblk = N / 32, per = (K / 64) * nblk, tot = per * nmat;
    if (it >= tot) { it -= tot; return false; }
    const int mat = it / per, r = it % per, kb = r / nblk, nb = r % nblk, n0 = 32 * nb;
    const int drow0 = (mode == 0) ? n0 : (256 * (n0 / 128) + (n0 % 128) + (mode == 2 ? 128 : 0));
    transpose_item_fp8(W + (size_t)mat * wstride, N, 64 * kb, n0, gain, scale, WT + (size_t)mat * tstride, K, drow0, scr, lane);
    return true;
}
__device__ __forceinline__ bool transpose_group(int& it, const float* W, size_t wstride, int nmat, int K, int N, const float* gain, bf16* WT, size_t tstride, int mode, LAS float* scr, int lane) {
    const int nblk = N / 32, per = (K / 64) * nblk, tot = per * nmat;
    if (it >= tot) { it -= tot; return false; }
    const int mat = it / per, r = it % per, kb = r / nblk, nb = r % nblk, n0 = 32 * nb;
    const int drow0 = (mode == 0) ? n0 : (256 * (n0 / 128) + (n0 % 128) + (mode == 2 ? 128 : 0));
    transpose_item(W + (size_t)mat * wstride, N, 64 * kb, n0, gain, WT + (size_t)mat * tstride, K, drow0, scr, lane);
    return true;
}
__device__ __forceinline__ void sincos_f64(double x, double& s, double& c) {
    const double TWO_PI = 6.283185307179586476925286766559, INV_2PI = 0.15915494309189533576888376337251;
    const double n = __builtin_rint(x * INV_2PI); const double r = __builtin_fma(-n, TWO_PI, x), r2 = r * r;
    double ts = r, tc = 1.0; s = r; c = 1.0;
#pragma unroll
    for (int k = 1; k <= 14; ++k) { tc = -tc * r2 / (double)((2 * k - 1) * (2 * k)); ts = -ts * r2 / (double)((2 * k) * (2 * k + 1)); c += tc; s += ts; }
}

struct TItem { const float* src; const float* gain; unsigned char* dst; int ldw, ldwt, fp8; float scale; };
__device__ __forceinline__ bool titem_group(int& it, TItem& t, const float* W, size_t wstride, int nmat, int K, int N, const float* gain, float scale, void* WT, size_t tstride_bytes, int mode, int fp8) {
    const int nblk = N / 64, per = (K / 64) * nblk, tot = per * nmat;
    if (it >= tot) { it -= tot; return false; }
    const int mat = it / per, r = it % per, k0 = 64 * (r / nblk), n0 = 64 * (r % nblk), esz = (fp8 == 1) ? 1 : 2;
    const int drow0 = (mode == 0) ? n0 : (256 * (n0 / 128) + (n0 % 128) + (mode == 2 ? 128 : 0));
    t.src = W + (size_t)mat * wstride + (size_t)k0 * N + n0; t.gain = gain ? gain + k0 : nullptr;
    t.dst = (unsigned char*)WT + (size_t)mat * tstride_bytes + ((size_t)drow0 * K + k0) * esz; t.ldw = N; t.ldwt = K * esz; t.fp8 = fp8; t.scale = scale; return true;
}
__device__ __forceinline__ void titem_load(const TItem& t, f32x4 (&v)[2][8], f32x4 (&g)[2], int lane) {
    const int n4 = lane & 7, kr = lane >> 3;
    const float* gp = t.gain ? t.gain : t.src;
#pragma unroll
    for (int h = 0; h < 2; ++h)
#pragma unroll
        for (int i = 0; i < 8; ++i) v[h][i] = *(const f32x4*)(t.src + (size_t)(8 * kr + i) * t.ldw + 32 * h + 4 * n4);
    g[0] = *(const f32x4*)(gp + 8 * kr); g[1] = *(const f32x4*)(gp + 8 * kr + 4);
}
__device__ __forceinline__ void titem_process(const TItem& t, const f32x4 (&v)[2][8], const f32x4 (&g)[2], int lane) {
    const int n4 = lane & 7, kr = lane >> 3;
    float s[8];
#pragma unroll
    for (int j = 0; j < 8; ++j) s[j] = t.gain ? g[j >> 2][j & 3] * t.scale : t.scale;
    if (t.fp8 == 1) {
#pragma unroll
        for (int h = 0; h < 2; ++h)
#pragma unroll
            for (int i = 0; i < 4; ++i) { u32x2 o; o.x = epi::pk4_fp8(v[h][0][i] * s[0], v[h][1][i] * s[1], v[h][2][i] * s[2], v[h][3][i] * s[3]); o.y = epi::pk4_fp8(v[h][4][i] * s[4], v[h][5][i] * s[5], v[h][6][i] * s[6], v[h][7][i] * s[7]);
                __builtin_nontemporal_store(o, (u32x2*)(t.dst + (size_t)(32 * h + 4 * n4 + i) * t.ldwt + 8 * kr)); }
    } else {
#pragma unroll
        for (int h = 0; h < 2; ++h)
#pragma unroll
            for (int i = 0; i < 4; ++i) { u32x4 o; o.x = cvt_pk_bf16(v[h][0][i] * s[0], v[h][1][i] * s[1]); o.y = cvt_pk_bf16(v[h][2][i] * s[2], v[h][3][i] * s[3]); o.z = cvt_pk_bf16(v[h][4][i] * s[4], v[h][5][i] * s[5]); o.w = cvt_pk_bf16(v[h][6][i] * s[6], v[h][7][i] * s[7]);
                u32x4* dp = (u32x4*)(t.dst + (size_t)(32 * h + 4 * n4 + i) * t.ldwt + 16 * kr); if (t.fp8 == 2) __builtin_nontemporal_store(o, dp); else *dp = o; }
    }
}

struct Args { const float* in[27]; float* out; unsigned char* ws; int ph_lo, ph_hi; };
constexpr int NPHASE = 19;
#ifndef MK_PER_PHASE
#define MK_PER_PHASE 0
#endif

__global__ void __launch_bounds__(NTHR, 2) fwd_kernel(Args args) {
    extern __shared__ __attribute__((aligned(16))) unsigned char lds_raw[];
    LAS unsigned char* lds = (LAS unsigned char*)lds_raw;
    volatile LAS unsigned* MISC = (volatile LAS unsigned*)(lds + MISC_OFF);
    const int G = gridDim.x, wg = blockIdx.x, GT = G * NTHR, NGW = G * NWAVES;
    const int wave_s = __builtin_amdgcn_readfirstlane(threadIdx.x >> 6);
#define x_in (AP->in[0])
#define ev_attn_norm (AP->in[1])
#define ev_w_in (AP->in[2])
#define ev_qn_sb (AP->in[3])
#define ev_kn_sb (AP->in[4])
#define ev_qn_mb (AP->in[5])
#define ev_kn_mb (AP->in[6])
#define ev_w_o (AP->in[7])
#define ev_ffn_norm (AP->in[8])
#define ev_w_gate (AP->in[9])
#define ev_w_up (AP->in[10])
#define ev_w_down (AP->in[11])
#define od_rec_norm (AP->in[12])
#define od_w_in (AP->in[13])
#define od_conv_w (AP->in[14])
#define od_conv_b (AP->in[15])
#define od_w_a (AP->in[16])
#define od_b_a (AP->in[17])
#define od_w_i (AP->in[18])
#define od_b_i (AP->in[19])
#define od_lambda (AP->in[20])
#define od_w_o (AP->in[21])
#define od_ffn_norm (AP->in[22])
#define od_router (AP->in[23])
#define od_we_gate (AP->in[24])
#define od_we_up (AP->in[25])
#define od_we_down (AP->in[26])
#define ssq0 ((float*)(AP->ws + WS_SSQ0))
#define ssq1 ((float*)(AP->ws + WS_SSQ1))
#define ssq2 ((float*)(AP->ws + WS_SSQ2))
#define ssq3 ((float*)(AP->ws + WS_SSQ3))
#define kmean ((float*)(AP->ws + WS_KMEAN))
#define rope ((float*)(AP->ws + WS_ROPE))
#define spl ((float*)(AP->ws + WS_SPL))
#define rstd3 ((float*)(AP->ws + WS_RSTD3))
#define tok_e ((int*)(AP->ws + WS_TOKE))
#define tok_w ((float*)(AP->ws + WS_TOKW))
#define tok_slot ((int*)(AP->ws + WS_TOKS))
#define cnt_chunk ((int*)(AP->ws + WS_CNTC))
#define slot_tok ((int*)(AP->ws + WS_SLOTT))
#define slot_w ((float*)(AP->ws + WS_SLOTW))
#define tpref ((int*)(AP->ws + WS_TPREF))
#define gains ((float*)(AP->ws + WS_GAINS))
#define slot_rstd ((float*)(AP->ws + WS_SLOTR))
#define XG ((bf16*)(AP->ws + WS_XG))
#define scanA ((float*)(AP->ws + WS_SCANA))
#define scanH ((float*)(AP->ws + WS_SCANH))
#define scanC ((float*)(AP->ws + WS_SCANC))
#define Wqkv ((bf16*)(AP->ws + WS_WQKV))
#define Wo ((bf16*)(AP->ws + WS_WO))
#define Wgu ((bf16*)(AP->ws + WS_WGU))
#define Wdn ((bf16*)(AP->ws + WS_WDN))
#define Win ((bf16*)(AP->ws + WS_WIN))
#define Wai ((bf16*)(AP->ws + WS_WAI))
#define Wo2 ((bf16*)(AP->ws + WS_WO2))
#define Egu ((bf16*)(AP->ws + WS_EGU))
#define Edn ((bf16*)(AP->ws + WS_EDN))
#define XB ((bf16*)(AP->ws + WS_XB))
#define XR ((float*)(AP->ws + WS_XR))
#define QKV ((bf16*)(AP->ws + WS_QKV))
#define OB ((bf16*)(AP->ws + WS_O))
#define HB ((bf16*)(AP->ws + WS_H))
#define XBR ((bf16*)(AP->ws + WS_XBR))
#define GG ((bf16*)(AP->ws + WS_GG))
#define XC ((bf16*)(AP->ws + WS_XC))
#define AA ((float*)(AP->ws + WS_AA))
#define UU ((float*)(AP->ws + WS_UU))
#define YB ((bf16*)(AP->ws + WS_Y))
#define HE ((bf16*)(AP->ws + WS_HE))
#define out (AP->out)
    typedef const __attribute__((address_space(4))) Args* ArgsP;
#define PHASE_ARGS() ArgsP AP = (ArgsP)__builtin_amdgcn_kernarg_segment_ptr(); asm volatile("" : "+s"(AP))
    gu32* ctl; { PHASE_ARGS(); ctl = (gu32*)(AP->ws + WS_CTL); }
#define PHASE_IDS() const int lane = (int)__builtin_amdgcn_mbcnt_hi(~0u, __builtin_amdgcn_mbcnt_lo(~0u, 0u)), wave = wave_s, tid = wave * 64 + lane, gtid = wg * NTHR + tid, gw = wg * NWAVES + wave; (void)gtid; (void)gw
    for (int u = threadIdx.x; u < (LDS_BYTES - MISC_OFF) / 4; u += NTHR) ((LAS unsigned*)(lds + MISC_OFF))[u] = 0u;
    __syncthreads();
    XcdBarrier bar; bar.bar = (unsigned*)(ctl + CW_BAR); bar.x = 0; bar.st = nullptr; bar.wave = wave_s;
    if (!MK_PER_PHASE) bar = xcd_barrier_post((unsigned*)(ctl + CW_BAR), MISC + 8, wave_s);
    if (!MK_PER_PHASE && xb_leader(wave_s)) { const unsigned xcc = xb_xcc_id(); const unsigned rk = xb_add((unsigned*)(ctl + CW_XRANK + 64 * (xcc & 7u)), 1u); MISC[16] = rk * 8u + (xcc & 7u); }
    int vwg = wg; bool xloc = false;
    const int lo = args.ph_lo, hi = args.ph_hi;
#ifndef PHMASK
#define PHMASK 0x7ffff
#endif
#define IN(k) (((PHMASK >> (k)) & 1) && lo <= (k) && (k) < hi)
#ifndef PROBE_XBAR
#define PROBE_XBAR 0
#endif
#define SEAM(k) do { if (IN(k) && IN((k) + 1)) { xcd_barrier(bar); for (int xb_ = 0; xb_ < PROBE_XBAR; ++xb_) xcd_barrier(bar); } } while (0)
#ifndef PHREP
#define PHREP 0
#endif
#define NREP(k) ((((PHREP) >> (k)) & 1) ? 2 : 1)
    LAS unsigned char* ring = lds + RING_OFF; LAS unsigned char* lepi = lds + EPI_OFF;

    constexpr int PER_FF = (DM / 64) * (DFF / 64), PER_DN = (DFF / 64) * (DM / 64), NEXP_ITEMS = 16 * PER_FF + 8 * PER_DN;
    constexpr int NITEMS = (DM / 64) * (NQKV / 64) + (DM / 64) * (DM / 64) + 2 * PER_FF + PER_DN + (DM / 64) * (2 * DM / 64) + 16 * (256 / 64) * (256 / 64) + (DM / 64) * (DM / 64) + NEXP_ITEMS;
#define TDECODE(itv, t) do { int it_ = (itv); \
            if (titem_group(it_, t, od_we_gate, (size_t)DM * DFF, 8, DM, DFF, od_ffn_norm, epi::W_UP_SCALE, Egu, (size_t)2 * DFF * DM, 1, 1)) break; \
            if (titem_group(it_, t, od_we_up, (size_t)DM * DFF, 8, DM, DFF, od_ffn_norm, epi::W_UP_SCALE, Egu, (size_t)2 * DFF * DM, 2, 1)) break; \
            if (titem_group(it_, t, od_we_down, (size_t)DFF * DM, 8, DFF, DM, nullptr, epi::W_DN_SCALE, Edn, (size_t)DM * DFF, 0, 1)) break; \
            if (titem_group(it_, t, ev_w_in, 0, 1, DM, NQKV, ev_attn_norm, 1.0f, Wqkv, 0, 0, 0)) break; \
            if (titem_group(it_, t, ev_w_o, 0, 1, DM, DM, nullptr, 1.0f, Wo, 0, 0, 2)) break; \
            if (titem_group(it_, t, ev_w_gate, 0, 1, DM, DFF, ev_ffn_norm, 1.0f, Wgu, 0, 1, 2)) break; \
            if (titem_group(it_, t, ev_w_up, 0, 1, DM, DFF, ev_ffn_norm, 1.0f, Wgu, 0, 2, 2)) break; \
            if (titem_group(it_, t, ev_w_down, 0, 1, DFF, DM, nullptr, epi::W_DN_SCALE, Wdn, 0, 0, 1)) break; \
            if (titem_group(it_, t, od_w_in, 0, 1, DM, 2 * DM, od_rec_norm, 1.0f, Win, 0, 0, 2)) break; \
            if (titem_group(it_, t, od_w_a, (size_t)256 * 256, 8, 256, 256, nullptr, 1.0f, Wai, (size_t)512 * 256 * 2, 1, 0)) break; \
            if (titem_group(it_, t, od_w_i, (size_t)256 * 256, 8, 256, 256, nullptr, 1.0f, Wai, (size_t)512 * 256 * 2, 2, 0)) break; \
            titem_group(it_, t, od_w_o, 0, 1, DM, DM, nullptr, 1.0f, Wo2, 0, 0, 2); } while (0)
#define CONVERT_RANGE(first_, last_) do { \
            TItem tA, tB; f32x4 vA[2][8], vB[2][8]; f32x4 gA[2], gB[2]; \
            int it = (first_) + gw; \
            if (it < (last_)) { \
                TDECODE(it, tA); titem_load(tA, vA, gA, lane); \
                for (;;) {                                                     \
                    int itB = it + NGW; const bool hasB = itB < (last_); if (!hasB) itB = it; \
                    TDECODE(itB, tB); titem_load(tB, vB, gB, lane); \
                    titem_process(tA, vA, gA, lane); \
                    if (!hasB) break; \
                    it = itB + NGW; const bool hasA = it < (last_); if (!hasA) it = itB; \
                    TDECODE(it, tA); titem_load(tA, vA, gA, lane); \
                    titem_process(tB, vB, gB, lane); \
                    if (!hasA) break; \
                } } } while (0)
    for (int rep_ = 0; rep_ < NREP(0); ++rep_) { if (rep_ > 0 && !MK_PER_PHASE) xcd_barrier(bar);
    if (IN(0)) { PHASE_ARGS(); PHASE_IDS();
#ifdef PROBE_CONV_IN_P0
        CONVERT_RANGE(0, NITEMS);
#else
        CONVERT_RANGE(NEXP_ITEMS, NITEMS);
#endif
        for (int m = gw; m < T; m += NGW) {
            const f32x4* xr = (const f32x4*)(x_in + (size_t)m * DM) + lane; f32x4 v[8]; float s = 0.f;
#pragma unroll
            for (int j = 0; j < 8; ++j) { v[j] = __builtin_nontemporal_load(xr + 64 * j); s += (v[j][0] * v[j][0] + v[j][1] * v[j][1]) + (v[j][2] * v[j][2] + v[j][3] * v[j][3]); }
            s = wave_sum(s); if (lane == 0) ssq0[m] = s;
            u32x2* o8 = (u32x2*)(XB + (size_t)m * DM) + lane;
#pragma unroll
            for (int j = 0; j < 8; ++j) { u32x2 w; w.x = cvt_pk_bf16(v[j][0], v[j][1]); w.y = cvt_pk_bf16(v[j][2], v[j][3]); o8[64 * j] = w; }
        }
        for (int idx = gtid; idx < SEQ * 16; idx += GT) {
            const double invf[16] = {1.0, 0.44036660267178046, 0.19392274474868576, 0.08539710028576561, 0.03760603093086393, 0.016560440080994446, 0.007292664737217109, 0.003211445994752591,
                                     0.001414213562373095, 0.000622772421914596, 0.0002742481756762073, 0.00012076973741146504, 5.318295896944988e-05, 2.341999896140934e-05, 1.031338537721246e-05, 4.5416704806078695e-06};
            const int pos = idx >> 4, i = idx & 15; double f = invf[0];
#pragma unroll
            for (int k = 1; k < 16; ++k) f = (i == k) ? invf[k] : f;
            double s, c; sincos_f64((double)pos * f, s, c);
            rope[idx] = (float)c; rope[SEQ * 16 + idx] = (float)s;
        }
        for (int c = gtid; c < DM; c += GT) { const float l = od_lambda[c]; spl[c] = (l > 15.f) ? expf(-l) : log1pf(expf(-l)); }
        if (gtid < HD) { gains[gtid] = ev_qn_sb[gtid]; gains[128 + gtid] = ev_kn_sb[gtid]; gains[256 + gtid] = ev_qn_mb[gtid]; gains[384 + gtid] = ev_kn_mb[gtid]; }
    }
    }
    SEAM(0);
    if (!MK_PER_PHASE && lo == 0) {
        bool ok = (G % 8) == 0;
#pragma unroll
        for (int j = 0; j < 8; ++j) ok = ok && (__hip_atomic_load((unsigned*)(ctl + CW_XRANK + 64 * j), __ATOMIC_RELAXED, __HIP_MEMORY_SCOPE_AGENT) == (unsigned)(G / 8));
        const int cand = __builtin_amdgcn_readfirstlane((int)MISC[16]);
        vwg = (ok && cand < G) ? cand : wg; xloc = ok && cand < G;
    }

    for (int rep_ = 0; rep_ < NREP(1); ++rep_) { if (rep_ > 0 && !MK_PER_PHASE) xcd_barrier(bar);
    if (IN(1)) { PHASE_ARGS();
        pg8::ProbPlain g{(const char*)XB, (const char*)Wqkv, (unsigned)DM * 2u, (unsigned)DM * 2u, DM / 64}; pg8::StaticOrder S; S.init(T / 256, NQKV / 256, G, vwg);
        epi::EpiQKV E{QKV, ssq0, gains, rope, kmean};
        pg8::gemm_phase(ring, lepi, g, S, E, wave_s);
    }
    }
    SEAM(1);

    for (int rep_ = 0; rep_ < NREP(3); ++rep_) { if (rep_ > 0 && !MK_PER_PHASE) xcd_barrier(bar);
    if (IN(3)) { PHASE_ARGS(); PHASE_IDS();
        const int half = (wg >> 3) & 1;
#ifndef PROBE_CONV_IN_P0
        if (half == 1) { CONVERT_RANGE(0, NEXP_ITEMS); __syncthreads(); }
#endif
#ifdef PROBE_ATT2
        int nrp_ = 2; asm volatile("" : "+s"(nrp_));
        for (int rp_ = 0; rp_ < nrp_; ++rp_) {
#endif
        for (int p = wg; p < 256; p += G) { const int bh = p >> 3, k = p & 7, b = bh >> 3, h = bh & 7;
            for (int s = 0; s < 2; ++s) att::attn_unit<1>(QKV, OB, kmean, b, h, s ? 15 - k : k, ring, lepi, wave_s); }
        for (int p = wg; p < 256; p += G) { const int bh = p >> 3, k = p & 7, b = bh >> 3, h = bh & 7;
            for (int s = 0; s < 2; ++s) att::attn_unit<0>(QKV, OB, kmean, b, h, s ? 15 - k : k, ring, lepi, wave_s); }
#ifdef PROBE_ATT2
        }
#endif
#ifndef PROBE_CONV_IN_P0
        if (half == 0) { __syncthreads(); CONVERT_RANGE(0, NEXP_ITEMS); }
#endif
    }
    }
    SEAM(3);

    for (int rep_ = 0; rep_ < NREP(4); ++rep_) { if (rep_ > 0 && !MK_PER_PHASE) xcd_barrier(bar);
    if (IN(4)) { PHASE_ARGS();
        pg8::ProbPlain g{(const char*)OB, (const char*)Wo, (unsigned)DM * 2u, (unsigned)DM * 2u, DM / 64}; pg8::StaticOrder S; S.init(T / 256, DM / 256, G, vwg);
        epi::EpiResid<true> E{XB, nullptr, XB, ssq1};
        pg8::gemm_phase(ring, lepi, g, S, E, wave_s);
    }
    }
    SEAM(4);

    for (int rep_ = 0; rep_ < NREP(5); ++rep_) { if (rep_ > 0 && !MK_PER_PHASE) xcd_barrier(bar);
    if (IN(5)) { PHASE_ARGS();
        pg8::ProbPlain g{(const char*)XB, (const char*)Wgu, (unsigned)DM * 2u, (unsigned)DM * 2u, DM / 64}; pg8::StaticOrder S; S.init(T / 256, 2 * DFF / 256, G, vwg);
        epi::EpiSwiGLUDenseF8 E{(unsigned char*)HB, ssq1};
#ifdef PROBE_SPLIT5
        S.i1 = 7; pg8::gemm_phase(ring, lepi, g, S, E, wave_s); if (PROBE_SPLIT5 == 1) xcd_barrier(bar); S.i0 = 7; S.i1 = 1 << 30; pg8::gemm_phase(ring, lepi, g, S, E, wave_s);
#else
        pg8::gemm_phase(ring, lepi, g, S, E, wave_s);
#endif
    }
    }
    SEAM(5);

    for (int rep_ = 0; rep_ < NREP(6); ++rep_) { if (rep_ > 0 && !MK_PER_PHASE) xcd_barrier(bar);
    if (IN(6)) { PHASE_ARGS();
        pg8::ProbPlainF8 g{(const char*)HB, (const char*)Wdn, (unsigned)DFF, (unsigned)DFF, DFF / 128}; pg8::StaticOrder S; S.init(T / 256, DM / 256, G, vwg);
        epi::EpiResid<true, true> E{XB, nullptr, XB, ssq2};
        pg8::gemm_phase(ring, lepi, g, S, E, wave_s);
    }
    }
    SEAM(6);

    for (int rep_ = 0; rep_ < NREP(7); ++rep_) { if (rep_ > 0 && !MK_PER_PHASE) xcd_barrier(bar);
    if (IN(7)) { PHASE_ARGS();
        pg8::ProbPlain g{(const char*)XB, (const char*)Win, (unsigned)DM * 2u, (unsigned)DM * 2u, DM / 64}; pg8::StaticOrder S; S.init(T / 256, 2 * DM / 256, G, vwg);
        epi::EpiRecInConv E{XC, GG, ssq2, od_conv_w, od_conv_b, (unsigned*)(AP->ws + WS_SCANH), (unsigned*)(ctl + CW_CONVF)};
        pg8::gemm_phase(ring, lepi, g, S, E, wave_s);
    }
    }
    SEAM(7);


    for (int rep_ = 0; rep_ < NREP(9); ++rep_) { if (rep_ > 0 && !MK_PER_PHASE) xcd_barrier(bar);
    if (IN(9)) { PHASE_ARGS();
        pg8::ProbGates g{(const char*)XC, (const char*)Wai, (unsigned)DM * 2u, 512u, 4}; pg8::StaticOrder S; S.init(T / 256, 16, G, vwg);
        epi::EpiGatesScan E{XC, od_b_a, od_b_i, spl, GG, YB, scanA, (unsigned*)(ctl + CW_SCANF)};
        pg8::gemm_phase(ring, lepi, g, S, E, wave_s);
    }
    }
    SEAM(9);


    for (int rep_ = 0; rep_ < NREP(13); ++rep_) { if (rep_ > 0 && !MK_PER_PHASE) xcd_barrier(bar);
    if (IN(13)) { PHASE_ARGS();
        pg8::ProbPlain g{(const char*)YB, (const char*)Wo2, (unsigned)DM * 2u, (unsigned)DM * 2u, DM / 64}; pg8::StaticOrder S; S.init(T / 256, DM / 256, G, vwg);
        epi::EpiResid<false> E{XB, nullptr, XB, nullptr};
        pg8::gemm_phase(ring, lepi, g, S, E, wave_s);
    }
    }
    SEAM(13);

    for (int rep_ = 0; rep_ < NREP(14); ++rep_) { if (rep_ > 0 && !MK_PER_PHASE) xcd_barrier(bar);
    if (IN(14)) { PHASE_ARGS(); PHASE_IDS();
        LAS float* Rg = (LAS float*)ring;
        LAS int* lcnt = (LAS int*)lepi;
        for (int i = tid; i < DM * 8; i += NTHR) { const int k = i >> 3, e = i & 7; Rg[e * DM + k] = od_ffn_norm[k] * od_router[i]; }
        for (int c = wg; c < T / 64; c += G) {
            if (tid < 8) lcnt[tid] = 0;
            __syncthreads();
            const int t0 = c * 64 + wave * 8;
            float acc[8][8], ssq[8];
#pragma unroll
            for (int q = 0; q < 8; ++q) { ssq[q] = 0.f;
#pragma unroll
                for (int e = 0; e < 8; ++e) acc[q][e] = 0.f; }
#pragma unroll 2
            for (int i = 0; i < 16; ++i) { const int k = 2 * lane + 128 * i; f32x2 rv[8]; unsigned xw[8];
#pragma unroll
                for (int e = 0; e < 8; ++e) rv[e] = *(const LAS f32x2*)(Rg + e * DM + k);
#pragma unroll
                for (int q = 0; q < 8; ++q) xw[q] = *(const unsigned*)(XB + (size_t)(t0 + q) * DM + k);
#pragma unroll
                for (int q = 0; q < 8; ++q) { const float x0 = bflo(xw[q]), x1 = bfhi(xw[q]); ssq[q] += x0 * x0 + x1 * x1;
#pragma unroll
                    for (int e = 0; e < 8; ++e) acc[q][e] += x0 * rv[e].x + x1 * rv[e].y; } }
#pragma unroll
            for (int q = 0; q < 8; ++q) { const float sq = wave_sum(ssq[q]); const float rs = 1.0f / sqrtf(sq * (1.0f / DM) + EPS);
                float lg[8];
#pragma unroll
                for (int e = 0; e < 8; ++e) lg[e] = wave_sum(acc[q][e]) * rs;
                int i0 = 0; float v0 = lg[0];
#pragma unroll
                for (int e = 1; e < 8; ++e) if (lg[e] > v0) { v0 = lg[e]; i0 = e; }
                int i1 = -1; float v1 = -__builtin_inff();
#pragma unroll
                for (int e = 0; e < 8; ++e) if (e != i0 && lg[e] > v1) { v1 = lg[e]; i1 = e; }
                if (lane == 0) { const int t = t0 + q; const float w0 = 1.0f / (1.0f + expf(v1 - v0));
                    tok_e[t] = i0 | (i1 << 8); tok_w[2 * t] = w0; tok_w[2 * t + 1] = 1.0f - w0; rstd3[t] = rs;
                    atomicAdd((int*)&lcnt[i0], 1); atomicAdd((int*)&lcnt[i1], 1); } }
            __syncthreads();
            if (tid < 8) cnt_chunk[c * 8 + tid] = lcnt[tid];
            __syncthreads();
        }
    }
    }
    SEAM(14);

    for (int rep_ = 0; rep_ < NREP(15); ++rep_) { if (rep_ > 0 && !MK_PER_PHASE) xcd_barrier(bar);
    if (IN(15)) { PHASE_ARGS(); PHASE_IDS();
        LAS int* li = (LAS int*)lepi;
        for (int c = wg; c < T / 64; c += G) {
            LAS int* lcnt = li + 256; LAS int* lte = li + 2304; LAS float* ltw = (LAS float*)(li + 2368); LAS float* lrs = (LAS float*)(li + 2496);
            for (int i = tid; i < (T / 64) * 8; i += NTHR) lcnt[i] = cnt_chunk[i];
            if (tid < 64) { lte[tid] = tok_e[c * 64 + tid]; lrs[tid] = rstd3[c * 64 + tid]; } else if (tid < 192) ltw[tid - 64] = tok_w[c * 128 + tid - 64];
            __syncthreads();
            if (tid < 8) { int run = 0, mine = 0; for (int cc = 0; cc < T / 64; ++cc) { if (cc == c) mine = run; run += lcnt[cc * 8 + tid]; } li[tid] = run; li[8 + tid] = mine; }
            __syncthreads();
            if (tid == 0) { int s = 0; for (int e = 0; e < 8; ++e) { li[16 + e] = s; s += ((li[e] + 255) >> 8) << 8; } li[24] = s; }
            __syncthreads();
            LAS int* lslot = li + 32;
            if (tid < 8) { const int e = tid; int pos = li[16 + e] + li[8 + e];
                for (int q = 0; q < 64; ++q) { const int t = c * 64 + q; const int pe = lte[q];
                    if ((pe & 255) == e) { slot_tok[pos] = t; slot_w[pos] = ltw[2 * q]; slot_rstd[pos] = lrs[q]; lslot[2 * q] = pos; ++pos; }
                    if ((pe >> 8) == e) { slot_tok[pos] = t; slot_w[pos] = ltw[2 * q + 1]; slot_rstd[pos] = lrs[q]; lslot[2 * q + 1] = pos; ++pos; } } }
            __syncthreads();
            if (tid < 128) tok_slot[c * 128 + tid] = lslot[tid];
            for (int q = wave; q < 64; q += NWAVES) {
                const u32x4* src = (const u32x4*)(XB + (size_t)(c * 64 + q) * DM) + lane; u32x2* d0 = (u32x2*)((unsigned char*)XG + (size_t)lslot[2 * q] * DM) + lane; u32x2* d1 = (u32x2*)((unsigned char*)XG + (size_t)lslot[2 * q + 1] * DM) + lane;
#pragma unroll
                for (int j = 0; j < 4; ++j) { const u32x4 v = src[64 * j]; u32x2 w; w.x = epi::pk4_fp8(bflo(v.x), bfhi(v.x), bflo(v.y), bfhi(v.y)); w.y = epi::pk4_fp8(bflo(v.z), bfhi(v.z), bflo(v.w), bfhi(v.w)); d0[64 * j] = w; d1[64 * j] = w; } }
            if (c == 0) {
                if (tid < 9) tpref[tid] = li[16 + tid] >> 8;
                for (int e = 0; e < 8; ++e) { const int a = li[16 + e] + li[e], z = li[16 + e + 1]; for (int s = a + tid; s < z; s += NTHR) { slot_tok[s] = 0; slot_w[s] = 0.f; slot_rstd[s] = 0.f; } }
            }
            __syncthreads();
        }
    }
    }
    SEAM(15);

    for (int rep_ = 0; rep_ < NREP(16); ++rep_) { if (rep_ > 0 && !MK_PER_PHASE) xcd_barrier(bar);
    if (IN(16)) { PHASE_ARGS();
        pg8::MoeOrder S;
#pragma unroll
        for (int k = 0; k < 9; ++k) S.pf[k] = __builtin_amdgcn_readfirstlane(tpref[k]);
        S.so.init(S.pf[8], 2 * DFF / 256, G, vwg);
        pg8::ProbMoeUp g{(const char*)XG, (const char*)Egu, (unsigned)DM, (unsigned)DM, DM / 128};
        epi::EpiSwiGLUFp8 E{(unsigned char*)HE, slot_rstd};
        pg8::gemm_phase(ring, lepi, g, S, E, wave_s);
    }
    }
    SEAM(16);

    for (int rep_ = 0; rep_ < NREP(17); ++rep_) { if (rep_ > 0 && !MK_PER_PHASE) xcd_barrier(bar);
    if (IN(17)) { PHASE_ARGS();
        pg8::MoeOrder S;
#pragma unroll
        for (int k = 0; k < 9; ++k) S.pf[k] = __builtin_amdgcn_readfirstlane(tpref[k]);
        S.so.init(S.pf[8], DM / 256, G, vwg);
        pg8::ProbMoeDown g{(const char*)HE, (const char*)Edn, (unsigned)DFF, (unsigned)DFF, DFF / 128};
        epi::EpiMoeDown E{(unsigned char*)XG, epi::Y_SCALE / (epi::W_DN_SCALE * epi::H_SCALE)};
        const int nj = S.pf[8] - 128;
        const bool use_tail = xloc && G == 256 && nj >= 1 && nj <= 8 && !MK_PER_PHASE;
        if (use_tail) S.so.i1 = 4;
        pg8::gemm_phase(ring, lepi, g, S, E, wave_s);
        if (use_tail) {
            pg8::MoeTailOrder ST; ST.so = S.so; ST.so.i1 = 1 << 30; ST.nj = nj;
#pragma unroll
            for (int k = 0; k < 9; ++k) ST.pf[k] = S.pf[k];
            pg8::ProbMoeDown g4{(const char*)HE, (const char*)Edn, (unsigned)DFF, (unsigned)DFF, DFF / 128 / 4};
            epi::EpiMoeDownTail ET{(unsigned char*)XG, epi::Y_SCALE / (epi::W_DN_SCALE * epi::H_SCALE), (float*)(AP->ws + WS_PART), (unsigned*)(ctl + CW_TAILF)};
            pg8::gemm_phase(ring, lepi, g4, ST, ET, wave_s);
        }
    }
    }
    SEAM(17);

    if (IN(18)) { PHASE_ARGS(); PHASE_IDS();
        for (int idx = gtid; idx < T * (DM / 8); idx += GT) { const int t = idx >> 8, c0 = (idx & 255) * 8;
            const int s0 = tok_slot[2 * t], s1 = tok_slot[2 * t + 1]; const float w0 = tok_w[2 * t] * (1.0f / epi::Y_SCALE), w1 = tok_w[2 * t + 1] * (1.0f / epi::Y_SCALE);
            const u32x2 a = *(const u32x2*)((const unsigned char*)XG + (size_t)s0 * DM + c0), b = *(const u32x2*)((const unsigned char*)XG + (size_t)s1 * DM + c0); const u32x4 x = *(const u32x4*)(XB + (size_t)t * DM + c0);
            const f32x2 a0 = __builtin_amdgcn_cvt_pk_f32_fp8((int)a.x, false), a1 = __builtin_amdgcn_cvt_pk_f32_fp8((int)a.x, true), a2 = __builtin_amdgcn_cvt_pk_f32_fp8((int)a.y, false), a3 = __builtin_amdgcn_cvt_pk_f32_fp8((int)a.y, true);
            const f32x2 b0 = __builtin_amdgcn_cvt_pk_f32_fp8((int)b.x, false), b1 = __builtin_amdgcn_cvt_pk_f32_fp8((int)b.x, true), b2 = __builtin_amdgcn_cvt_pk_f32_fp8((int)b.y, false), b3 = __builtin_amdgcn_cvt_pk_f32_fp8((int)b.y, true);
            f32x4 o0, o1;
            o0[0] = bflo(x.x) + (w0 * a0[0] + w1 * b0[0]); o0[1] = bfhi(x.x) + (w0 * a0[1] + w1 * b0[1]); o0[2] = bflo(x.y) + (w0 * a1[0] + w1 * b1[0]); o0[3] = bfhi(x.y) + (w0 * a1[1] + w1 * b1[1]);
            o1[0] = bflo(x.z) + (w0 * a2[0] + w1 * b2[0]); o1[1] = bfhi(x.z) + (w0 * a2[1] + w1 * b2[1]); o1[2] = bflo(x.w) + (w0 * a3[0] + w1 * b3[0]); o1[3] = bfhi(x.w) + (w0 * a3[1] + w1 * b3[1]);
            float* op = out + (size_t)t * DM + c0; *(f32x4*)op = o0; *(f32x4*)(op + 4) = o1; }
    }
#undef IN
#undef SEAM
#undef PHASE_IDS
#undef tok_slot
#undef TDECODE
#undef CONVERT_RANGE
#undef PHASE_ARGS
#undef x_in
#undef ev_attn_norm
#undef ev_w_in
#undef ev_qn_sb
#undef ev_kn_sb
#undef ev_qn_mb
#undef ev_kn_mb
#undef ev_w_o
#undef ev_ffn_norm
#undef ev_w_gate
#undef ev_w_up
#undef ev_w_down
#undef od_rec_norm
#undef od_w_in
#undef od_conv_w
#undef od_conv_b
#undef od_w_a
#undef od_b_a
#undef od_w_i
#undef od_b_i
#undef od_lambda
#undef od_w_o
#undef od_ffn_norm
#undef od_router
#undef od_we_gate
#undef od_we_up
#undef od_we_down
#undef ssq0
#undef ssq1
#undef ssq2
#undef ssq3
#undef kmean
#undef rope
#undef spl
#undef rstd3
#undef tok_e
#undef tok_w
#undef cnt_chunk
#undef slot_tok
#undef slot_w
#undef tpref
#undef gains
#undef slot_rstd
#undef XG
#undef scanA
#undef scanH
#undef scanC
#undef Wqkv
#undef Wo
#undef Wgu
#undef Wdn
#undef Win
#undef Wai
#undef Wo2
#undef Egu
#undef Edn
#undef XB
#undef XR
#undef QKV
#undef OB
#undef HB
#undef XBR
#undef GG
#undef XC
#undef AA
#undef UU
#undef YB
#undef HE
#undef out
}

extern "C" void kernel_launch(void* const* d_in, const int* in_sizes, int n_in, void* d_out, int out_size, void* d_ws, size_t ws_size, hipStream_t stream) {
    static int grid = 0;
    if (grid == 0) {
        if (n_in != 27 || in_sizes[0] != T * DM || out_size != T * DM || ws_size < WS_END) {
            fprintf(stderr, "kernel_launch: built for 27 inputs, x/out of %d floats, >= %zu bytes of workspace; got n_in %d, in0 %d, out %d, ws %zu; nothing launched\n", T * DM, (size_t)WS_END, n_in, n_in > 0 ? in_sizes[0] : -1, out_size, ws_size);
            grid = -1; return; }
        int dev = 0, cus = 0, per_cu = 0;
        if (hipGetDevice(&dev) != hipSuccess || hipDeviceGetAttribute(&cus, hipDeviceAttributeMultiprocessorCount, dev) != hipSuccess) { fprintf(stderr, "kernel_launch: device query failed\n"); grid = -1; return; }
        if (hipFuncSetAttribute((const void*)fwd_kernel, hipFuncAttributeMaxDynamicSharedMemorySize, LDS_BYTES) != hipSuccess) { fprintf(stderr, "kernel_launch: hipFuncSetAttribute failed\n"); grid = -1; return; }
        if (hipOccupancyMaxActiveBlocksPerMultiprocessor(&per_cu, (const void*)fwd_kernel, NTHR, LDS_BYTES) != hipSuccess || per_cu < 1)
            fprintf(stderr, "kernel_launch: note: occupancy query reports %d workgroups per CU\n", per_cu);
        (void)hipGetLastError();
        grid = cus;
    }
    if (grid < 0) return;
    if (hipMemsetAsync((char*)d_ws + WS_CTL, 0, CTL_ZERO_BYTES, stream) != hipSuccess) { fprintf(stderr, "kernel_launch: memset failed\n"); return; }
    Args a{};
    for (int i = 0; i < 27; ++i) a.in[i] = (const float*)d_in[i];
    a.out = (float*)d_out; a.ws = (unsigned char*)d_ws;
#if MK_PER_PHASE
    for (int p = 0; p < NPHASE; ++p) { a.ph_lo = p; a.ph_hi = p + 1; hipLaunchKernelGGL(fwd_kernel, dim3(grid), dim3(NTHR), LDS_BYTES, stream, a); }
#else
    a.ph_lo = 0; a.ph_hi = NPHASE;
    hipLaunchKernelGGL(fwd_kernel, dim3(grid), dim3(NTHR), LDS_BYTES, stream, a);
#endif
    const hipError_t le = hipPeekAtLastError();
    if (le != hipSuccess) fprintf(stderr, "kernel_launch: launch failed: %s\n", hipGetErrorName(le));
}
```
